# Optimizing an MI355X kernel written in HIP

```python
import jax, jax.numpy as jnp
from jax import lax
import numpy as np

D_MODEL = 1024
BATCH = 8
SEQ = 4096
DEPTH = 4

GRID_W = 64
CTX_LEN = 256
N_MIXERS = 3
CHUNK = 128
A_WIDTH = 2 * D_MODEL
A_GROUPS = 8
B_GROUPS = 4
HEAD_DIM = 128
N_HEADS = D_MODEL // HEAD_DIM
N_KV_HEADS = 2
Q_BLOCK = 128
ROPE_THETA = 10000.0
D_FF = 4 * D_MODEL
NORM_EPS = 1e-6
LN_EPS = 1e-5
N_A = len(range(0, DEPTH, N_MIXERS))
N_B = len(range(1, DEPTH, N_MIXERS))
N_C = len(range(2, DEPTH, N_MIXERS))

kernel_name = "hybrid_gmlp_fnet_gqa_prefix_dit"


def rms_norm(x, g):
    xf = x.astype(jnp.float32)
    y = xf * lax.rsqrt(jnp.mean(xf * xf, axis=-1, keepdims=True) + NORM_EPS)
    return (y * g.astype(jnp.float32)).astype(x.dtype)


def layer_norm(x, g):
    xf = x.astype(jnp.float32)
    mu = jnp.mean(xf, axis=-1, keepdims=True)
    var = jnp.mean(jnp.square(xf - mu), axis=-1, keepdims=True)
    return ((xf - mu) * lax.rsqrt(var + LN_EPS) * g.astype(jnp.float32)).astype(x.dtype)


def ada_mod(cond, w, b):
    return jnp.split(jax.nn.silu(cond) @ w + b, 6, axis=-1)


def modulate(h, shift, scale):
    return h * (1.0 + scale) + shift


def chunk_gmlp(h, w_in, ln_g, w_s, b_s, w_out):
    bsz, length, _ = h.shape
    u, v = jnp.split(jax.nn.gelu(h @ w_in), 2, axis=-1)
    v = layer_norm(v, ln_g)
    v = v.reshape(bsz, length // CHUNK, CHUNK, A_GROUPS, A_WIDTH // A_GROUPS)
    sv = jnp.einsum('gpq,bnqgc->bnpgc', w_s, v) + b_s.T[:, :, None]
    return (u * sv.reshape(bsz, length, A_WIDTH)) @ w_out


def fourier_mix(h, w_out):
    bsz, length, d = h.shape
    hg = h.astype(jnp.float32).reshape(bsz, length, B_GROUPS, d // B_GROUPS)
    y = jnp.fft.fftn(hg, axes=(1, 3), norm="ortho").real
    return y.reshape(bsz, length, d).astype(h.dtype) @ w_out


def axial_rope(rows):
    t = jnp.arange(rows * GRID_W)
    row = (t // GRID_W).astype(jnp.float32)
    col = (t % GRID_W).astype(jnp.float32)
    n_freq = HEAD_DIM // 4
    inv = ROPE_THETA ** (-jnp.arange(n_freq, dtype=jnp.float32) / n_freq)
    ang = jnp.concatenate([row[:, None] * inv, col[:, None] * inv], axis=-1)
    return jnp.cos(ang), jnp.sin(ang)


def apply_rope(x, cos, sin):
    x1, x2 = jnp.split(x, 2, axis=-1)
    cs = cos[None, :, None, :].astype(x.dtype)
    sn = sin[None, :, None, :].astype(x.dtype)
    return jnp.concatenate([x1 * cs - x2 * sn, x1 * sn + x2 * cs], axis=-1)


def attend(q, keys, vals):
    bsz, lq = q.shape[:2]
    qg = q.reshape(bsz, lq, N_KV_HEADS, N_HEADS // N_KV_HEADS, HEAD_DIM)
    s = jnp.einsum('bqkrd,bskd->bkrqs', qg, keys).astype(jnp.float32) * (HEAD_DIM ** -0.5)
    p = jax.nn.softmax(s, axis=-1).astype(vals.dtype)
    o = jnp.einsum('bkrqs,bskd->bqkrd', p, vals)
    return o.reshape(bsz, lq, N_HEADS * HEAD_DIM)


def gqa_attention(h, hc, w_qkv, q_g, k_g, w_o, cos, sin, need_ctx_out):
    hq = N_HEADS * HEAD_DIM
    hk = N_KV_HEADS * HEAD_DIM
    w_q, w_k, w_v = w_qkv[:, :hq], w_qkv[:, hq:hq + hk], w_qkv[:, hq + hk:]

    def q_proj(z):
        bsz, length, _ = z.shape
        return rms_norm((z @ w_q).reshape(bsz, length, N_HEADS, HEAD_DIM), q_g)

    def kv_proj(z):
        bsz, length, _ = z.shape
        k = rms_norm((z @ w_k).reshape(bsz, length, N_KV_HEADS, HEAD_DIM), k_g)
        v = (z @ w_v).reshape(bsz, length, N_KV_HEADS, HEAD_DIM)
        return k, v

    q = apply_rope(q_proj(h), cos, sin)
    k, v = kv_proj(h)
    k = apply_rope(k, cos, sin)
    kc, vc = kv_proj(hc)
    keys = jnp.concatenate([kc, k], axis=1)
    vals = jnp.concatenate([vc, v], axis=1)

    bsz, length = q.shape[:2]
    nb = length // Q_BLOCK
    qb = jnp.moveaxis(q.reshape(bsz, nb, Q_BLOCK, N_HEADS, HEAD_DIM), 1, 0)
    ob = lax.map(lambda blk: attend(blk, keys, vals), qb)
    y = jnp.moveaxis(ob, 0, 1).reshape(bsz, length, hq) @ w_o

    yc = attend(q_proj(hc), kc, vc) @ w_o if need_ctx_out else None
    return y, yc


def channel_mlp(h, w1, w2):
    return jnp.square(jax.nn.relu(h @ w1)) @ w2


def setup_inputs(seed: int = 0) -> dict:
    key = jax.random.key(seed)
    ks = jax.random.split(key, 20)
    f32 = jnp.float32
    D = D_MODEL

    def nrm(k, shape, scale):
        return jax.random.normal(k, shape, f32) * scale

    return {
        "x": nrm(ks[0], (BATCH, SEQ, D), 1.0),
        "c": nrm(ks[1], (BATCH, D), 1.0),
        "ctx": nrm(ks[2], (BATCH, CTX_LEN, D), 1.0),
        "c_ctx": nrm(ks[3], (D,), 1.0),
        "ada_w": nrm(ks[4], (DEPTH, D, 6 * D), 0.5 * D ** -0.5),
        "ada_b": nrm(ks[5], (DEPTH, 6 * D), 0.02),
        "norm_g": 1.0 + nrm(ks[6], (DEPTH, 4, D), 0.02),
        "mlp_w1": nrm(ks[7], (DEPTH, D, D_FF), D ** -0.5),
        "mlp_w2": nrm(ks[8], (DEPTH, D_FF, D), D_FF ** -0.5),
        "a_w_in": nrm(ks[9], (N_A, D, 2 * A_WIDTH), D ** -0.5),
        "a_ln_g": 1.0 + nrm(ks[10], (N_A, A_WIDTH), 0.02),
        "a_w_s": nrm(ks[11], (N_A, A_GROUPS, CHUNK, CHUNK), CHUNK ** -0.5),
        "a_b_s": 1.0 + nrm(ks[12], (N_A, A_GROUPS, CHUNK), 0.02),
        "a_w_out": nrm(ks[13], (N_A, A_WIDTH, D), A_WIDTH ** -0.5),
        "b_w_out": nrm(ks[14], (N_B, D, D), D ** -0.5),
        "c_w_qkv": nrm(ks[15], (N_C, D, (N_HEADS + 2 * N_KV_HEADS) * HEAD_DIM), D ** -0.5),
        "c_q_g": 1.0 + nrm(ks[16], (N_C, HEAD_DIM), 0.02),
        "c_k_g": 1.0 + nrm(ks[17], (N_C, HEAD_DIM), 0.02),
        "c_w_o": nrm(ks[18], (N_C, N_HEADS * HEAD_DIM, D), (N_HEADS * HEAD_DIM) ** -0.5),
    }


def reference(x, c, ctx, c_ctx, ada_w, ada_b, norm_g, mlp_w1, mlp_w2, a_w_in, a_ln_g, a_w_s, a_b_s, a_w_out,
              b_w_out, c_w_qkv, c_q_g, c_k_g, c_w_o):
    rows = x.shape[1] // GRID_W
    cos, sin = axial_rope(rows)
    attn_layers = [i for i in range(DEPTH) if i % N_MIXERS == 2]
    last_ctx_read = attn_layers[-1] if attn_layers else -1

    for i in range(DEPTH):
        kind, j = i % N_MIXERS, i // N_MIXERS
        ctx_in = i <= last_ctx_read
        ctx_out = i < last_ctx_read

        sh1, sc1, g1, sh2, sc2, g2 = [m[:, None, :] for m in ada_mod(c, ada_w[i], ada_b[i])]
        h = modulate(rms_norm(x, norm_g[i, 0]), sh1, sc1)
        hc = None
        if ctx_in:
            csh1, csc1, cg1, csh2, csc2, cg2 = ada_mod(c_ctx, ada_w[i], ada_b[i])
            hc = modulate(rms_norm(ctx, norm_g[i, 0]), csh1, csc1)

        if kind == 0:
            y = chunk_gmlp(h, a_w_in[j], a_ln_g[j], a_w_s[j], a_b_s[j], a_w_out[j])
            yc = chunk_gmlp(hc, a_w_in[j], a_ln_g[j], a_w_s[j], a_b_s[j], a_w_out[j]) if ctx_out else None
        elif kind == 1:
            y = fourier_mix(h, b_w_out[j])
            yc = fourier_mix(hc, b_w_out[j]) if ctx_out else None
        else:
            y, yc = gqa_attention(h, hc, c_w_qkv[j], c_q_g[j], c_k_g[j], c_w_o[j], cos, sin, ctx_out)

        x = x + g1 * rms_norm(y, norm_g[i, 1])
        hm = modulate(rms_norm(x, norm_g[i, 2]), sh2, sc2)
        x = x + g2 * rms_norm(channel_mlp(hm, mlp_w1[i], mlp_w2[i]), norm_g[i, 3])

        if ctx_out:
            ctx = ctx + cg1 * rms_norm(yc, norm_g[i, 1])
            hcm = modulate(rms_norm(ctx, norm_g[i, 2]), csh2, csc2)
            ctx = ctx + cg2 * rms_norm(channel_mlp(hcm, mlp_w1[i], mlp_w2[i]), norm_g[i, 3])

    return x
```

```cpp
#include <hip/hip_runtime.h>
#ifndef DRY_ALL
#define DRY_ALL 0
#endif
#ifndef NT_STORES
#define NT_STORES 0
#endif
#ifndef SYNC_REP
#define SYNC_REP 1
#endif
#ifndef REPEAT_MASK
#define REPEAT_MASK 0ULL
#endif
#include <hip/hip_cooperative_groups.h>
#include <cstdio>
#include <cstdint>
namespace cg = cooperative_groups;

#define LAS __attribute__((address_space(3)))
typedef unsigned short bf16_t;
typedef short bf16x8 __attribute__((ext_vector_type(8)));
typedef short s16x4 __attribute__((ext_vector_type(4)));
typedef float f32x4 __attribute__((ext_vector_type(4)));
typedef float f32x16 __attribute__((ext_vector_type(16)));
typedef unsigned u32x4 __attribute__((ext_vector_type(4)));
typedef unsigned u32x2 __attribute__((ext_vector_type(2)));

constexpr int DM = 1024, NBATCH = 8, SEQ = 4096, CTXL = 256;
constexpr int RL = NBATCH * SEQ;
constexpr int RC = NBATCH * CTXL;
constexpr int RT = RL + RC;
constexpr int SKV = CTXL + SEQ;
constexpr int ZJ = 4352;
constexpr float NORM_EPS = 1e-6f, LN_EPS = 1e-5f;

constexpr size_t MiB = 1u << 20;
constexpr size_t WS_MOD = 0;
constexpr size_t WS_BAR = 901120;
constexpr size_t WS_XS1 = 1 * MiB;
constexpr size_t WS_XS2 = 2 * MiB;
constexpr size_t WS_CNT = 3 * MiB;
constexpr size_t CNT_BYTES = (size_t)34 * 2 * 136 * 256;
constexpr size_t WS_CC = 10 * MiB;
constexpr size_t WS_SC = WS_CC + 131072;
constexpr size_t WS_DFTC = WS_SC + 131072;
constexpr size_t WS_AWS = 11 * MiB;
constexpr size_t WS_W1T = 12 * MiB;
constexpr size_t WS_W2T = 44 * MiB;
constexpr size_t WS_AWINT = 76 * MiB;
constexpr size_t WS_AWOUTT = 92 * MiB;
constexpr size_t WS_BWOUTT = 100 * MiB;
constexpr size_t WS_QKVT = 102 * MiB;
constexpr size_t WS_WOT = 105 * MiB;
constexpr size_t WS_YH = 107 * MiB;
constexpr size_t WS_BIG = 175 * MiB;
constexpr size_t WS_X16 = 447 * MiB;
constexpr size_t WS_END = 511 * MiB;
constexpr size_t OUT_PART = 0;
constexpr size_t OUT_STATS = 32 * MiB;
constexpr size_t OUT_XC = 41 * MiB;
constexpr size_t BIG_Z = 0;
constexpr size_t BIG_DFTL = 68 * MiB;
constexpr size_t BIG_RT = 102 * MiB;
constexpr size_t BIG_RTC = 170 * MiB;
constexpr size_t BIG_Y2 = 178 * MiB;
constexpr size_t BIG_RAW = 0;
constexpr size_t BIG_K = 204 * MiB;
constexpr size_t BIG_V = 221 * MiB;
constexpr size_t BIG_Q = 0;
constexpr size_t BIG_O = 68 * MiB;

constexpr int LDS_BYTES = 141312;
constexpr int LDS_XP_OFF = 131072 + 1024, LDS_XS_OFF = 131072 + 5120, LDS_XF_OFF = 131072 + 6144;

typedef __bf16 bf16v2_t __attribute__((ext_vector_type(2)));
typedef float f32v2_t __attribute__((ext_vector_type(2)));
__device__ __forceinline__ unsigned cvt_pk_bf16(float lo, float hi) { const f32v2_t v = {lo, hi}; const bf16v2_t b = __builtin_convertvector(v, bf16v2_t); return __builtin_bit_cast(unsigned, b); }
__device__ __forceinline__ bf16_t f2bf(float f) { return (bf16_t)(cvt_pk_bf16(f, 0.f) & 0xffffu); }
__device__ __forceinline__ float bflo(unsigned w) { return __uint_as_float(w << 16); }
__device__ __forceinline__ float bfhi(unsigned w) { return __uint_as_float(w & 0xffff0000u); }
__device__ __forceinline__ float wave_sum(float v) {
#pragma unroll
    for (int o = 1; o < 64; o <<= 1) v += __shfl_xor(v, o);
    return v;
}
__device__ __forceinline__ float gelu_tanh(float x) {
    const float z2 = 1.5957691216057308f * (x + 0.044715f * x * x * x);
    const float e = __builtin_amdgcn_exp2f(-z2 * 1.4426950408889634f);
    return x * __builtin_amdgcn_rcpf(1.0f + e);
}

__device__ __forceinline__ f32x4 gelu_tanh4(f32x4 x) {
    f32x4 t = x * x; t = t * 0.044715f + 1.0f; t = t * x;
    const f32x4 a = t * (-2.3022082f);
    f32x4 e; e[0] = __builtin_amdgcn_exp2f(a[0]); e[1] = __builtin_amdgcn_exp2f(a[1]); e[2] = __builtin_amdgcn_exp2f(a[2]); e[3] = __builtin_amdgcn_exp2f(a[3]);
    const f32x4 d = e + 1.0f;
    f32x4 r; r[0] = __builtin_amdgcn_rcpf(d[0]); r[1] = __builtin_amdgcn_rcpf(d[1]); r[2] = __builtin_amdgcn_rcpf(d[2]); r[3] = __builtin_amdgcn_rcpf(d[3]);
    return x * r;
}
__device__ __forceinline__ f32x4 relu2_4(f32x4 x) {
    f32x4 m; m[0] = fmaxf(x[0], 0.f); m[1] = fmaxf(x[1], 0.f); m[2] = fmaxf(x[2], 0.f); m[3] = fmaxf(x[3], 0.f);
    return x * m;
}

namespace pg8 {
constexpr int BM = 256, BK = 64, HALF = 128, HTB = HALF * BK * 2, STAGE_BYTES = 8 * HTB, NXCD = 8, WGM = 8;
__host__ __device__ __forceinline__ int lds_byte(int r, int c) { const int st = (r >> 4) * 2 + (c >> 5), rr = r & 15, cc = c & 31, ob = rr * 64 + cc * 2; return st * 1024 + (ob ^ (((ob >> 9) & 1) << 5)); }
__host__ __device__ __forceinline__ void stage_rc(int b, int& R, int& C) { const int st = b / 1024, sb = b % 1024, swz = sb ^ (((sb >> 9) & 1) << 5); R = (st >> 1) * 16 + swz / 64; C = (st & 1) * 32 + (swz % 64) / 2; }
__host__ __device__ __forceinline__ int perm32(int rho) { const int n = rho >> 4, i = rho & 15; return 8 * (i >> 2) + 4 * n + (i & 3); }

struct GJob {
    const bf16_t* A; const bf16_t* A2; const bf16_t* B; void* C; float* stats;
    unsigned a2mask; int lda; int b_bs_hi, b_bs_lo, bdiv, b_pn_mod, ldb;
    int c_bs, ldc, out_f32, act; float scale;
    int stats_pn0;
    int nM, nN, nB, K;
    float* part; int split_pm0, ksplit;
    int fused, has_next, gate_off, shift_off, scale_off, x_mode;
    const float* xsrc; float* xdst; bf16_t* Hout; const float* gn_post; const float* gn_next; const float* modL; const float* modN;
    unsigned* slot1; unsigned* slot2; unsigned* cnt1; unsigned* cnt2; int kf; int dry;
    bf16_t* Kd; bf16_t* Vd; const float* qg; const float* kg;
};
#define JI(f) (__builtin_amdgcn_readfirstlane((int)(J->f)))
#define JF32(f) (__int_as_float(__builtin_amdgcn_readfirstlane(__float_as_int(J->f))))
template <class T> __device__ __forceinline__ T* jptr(const LAS void* p) {
    const LAS unsigned* q = (const LAS unsigned*)p; const unsigned lo = (unsigned)__builtin_amdgcn_readfirstlane((int)q[0]), hi = (unsigned)__builtin_amdgcn_readfirstlane((int)q[1]);
    typedef __attribute__((address_space(1))) T GT;
    GT* g = (GT*)(((unsigned long long)hi << 32) | lo); return (T*)g;
}
struct Unit { const char* a; const char* b; int bt, pm, pn, ks, nt; };

#define RFL(x) (UNIFORM ? __builtin_amdgcn_readfirstlane(x) : (x))
template <bool UNIFORM> __device__ __forceinline__ bool unit_next(const LAS GJob* J, int i, int G, int c, Unit& u) {
    const int nMall = JI(nM), nN = JI(nN), split_pm0 = JI(split_pm0), ksplit = JI(ksplit);
    const int nM = split_pm0 < nMall ? split_pm0 : nMall;
    const int per = nM * nN, nreg = per * JI(nB), nsplit = (nMall - nM) * nN * ksplit;
    const long L = (long)i * G + c; if (L >= nreg + nsplit) return false;
    const int lda = JI(lda), ldb = JI(ldb), K = JI(K);
    if (L >= nreg) {
        const int s = (int)L - nreg, ks = RFL(s % ksplit), t = s / ksplit;
        u.pn = RFL(t % nN); u.pm = RFL(nM + t / nN); u.bt = 0; u.ks = ks; u.nt = RFL((K / ksplit) / BK);
        u.a = (const char*)(jptr<const bf16_t>(&J->A) + (long)u.pm * 256 * lda + ks * (K / ksplit));
        u.b = (const char*)(jptr<const bf16_t>(&J->B) + (long)u.pn * 256 * ldb + ks * (K / ksplit));
        return true;
    }
    int wgid = (int)L; { const int nwg = nreg, q = nwg / NXCD, r = nwg % NXCD, xcd = wgid % NXCD, off = wgid / NXCD; wgid = (xcd < r ? xcd * (q + 1) : r * (q + 1) + (xcd - r) * q) + off; }
    const int bt = RFL(wgid / per), w = wgid % per;
    const int nig = WGM * nN, gid = w / nig, fm = gid * WGM, gsz = (nM - fm) < WGM ? (nM - fm) : WGM;
    u.pm = RFL(fm + ((w % nig) % gsz)); u.pn = RFL((w % nig) / gsz); u.bt = bt; u.ks = -1; u.nt = K / BK;
    const bf16_t* Ab = (((unsigned)JI(a2mask) >> u.pn) & 1u) ? jptr<const bf16_t>(&J->A2) : jptr<const bf16_t>(&J->A);
    u.a = (const char*)(Ab + (long)u.pm * 256 * lda);
    { const int kf = JI(kf); if (kf > 0) { const int part = bt & 1; u.a += (size_t)part * kf * 2; u.nt = part ? (K - kf) / BK : kf / BK; } }
    const int bdiv = JI(bdiv);
    const int bhi = RFL(bt / bdiv), blo = RFL(bt % bdiv), pnm = RFL(u.pn % JI(b_pn_mod));
    u.b = (const char*)(jptr<const bf16_t>(&J->B) + (long)bhi * JI(b_bs_hi) + (long)blo * JI(b_bs_lo) + (long)pnm * 256 * ldb);
    return true;
}

#undef RFL
constexpr int UT_MAX = 16, UT_STRIDE = 12;
__device__ __forceinline__ void unit_table_build(LAS unsigned* tab, const LAS GJob* J, int G, int c, int tid) {
    if (tid < UT_MAX) {
        Unit u; u.a = nullptr; u.b = nullptr; u.bt = 0; u.pm = 0; u.pn = 0; u.ks = -1; u.nt = 4;
        const bool ok = unit_next<false>(J, tid, G, c, u);
        LAS unsigned* e = tab + tid * UT_STRIDE;
        const unsigned long long pa = (unsigned long long)u.a, pb = (unsigned long long)u.b;
        e[0] = (unsigned)pa; e[1] = (unsigned)(pa >> 32); e[2] = (unsigned)pb; e[3] = (unsigned)(pb >> 32);
        e[4] = (unsigned)u.bt; e[5] = (unsigned)u.pm; e[6] = (unsigned)u.pn; e[7] = (unsigned)u.ks; e[8] = (unsigned)u.nt; e[9] = ok ? 1u : 0u;
    }
}
__device__ __forceinline__ bool unit_fetch(const LAS unsigned* tab, int i, Unit& u) {
    if (i >= UT_MAX) return false;
    const LAS unsigned* e = tab + i * UT_STRIDE;
    if (__builtin_amdgcn_readfirstlane((int)e[9]) == 0) return false;
    u.a = jptr<const char>(e); u.b = jptr<const char>(e + 2);
    u.bt = __builtin_amdgcn_readfirstlane((int)e[4]); u.pm = __builtin_amdgcn_readfirstlane((int)e[5]); u.pn = __builtin_amdgcn_readfirstlane((int)e[6]);
    u.ks = __builtin_amdgcn_readfirstlane((int)e[7]); u.nt = __builtin_amdgcn_readfirstlane((int)e[8]);
    return true;
}

__device__ __forceinline__ void epilogue(const LAS GJob* J, const f32x4 (&acc)[2][2][4][2], const Unit& u, int wr, int wc, int fr, int fq) {
    asm volatile("" : "+v"(fr), "+v"(fq));
    const int row0 = u.pm * BM + wr * 64 + fr, col0 = u.pn * BM + wc * 32 + 8 * fq;
    float* const stats = jptr<float>(&J->stats); const int stats_pn0 = JI(stats_pn0);
    const bool do_stats = (stats != nullptr) && (u.pn >= stats_pn0);
    const float sc = JF32(scale); const bool has_scale = (sc != 1.0f); const int act = JI(act), out_f32 = JI(out_f32), ldc = JI(ldc); const bool nostore = (REPEAT_MASK != 0ULL) && (JI(dry) == 2);
    char* const Cb = jptr<char>(&J->C) + ((size_t)u.bt * JI(c_bs) << (out_f32 ? 2 : 1));
    if (u.ks >= 0) {
        const int nMall = JI(nM), sp0 = JI(split_pm0);
        bf16_t* const part = (bf16_t*)jptr<float>(&J->part) + (size_t)u.ks * (nMall - sp0) * BM * ldc;
#pragma unroll
        for (int ai = 0; ai < 2; ++ai)
#pragma unroll
            for (int m = 0; m < 4; ++m) {
                const int row = row0 + ai * HALF + m * 16;
#pragma unroll
                for (int bj = 0; bj < 2; ++bj) { bf16_t* p = part + (size_t)(row - sp0 * BM) * ldc + col0 + bj * HALF; const f32x4 a0 = acc[ai][bj][m][0], a1 = acc[ai][bj][m][1];
                    u32x4 w; w.x = cvt_pk_bf16(a0[0], a0[1]); w.y = cvt_pk_bf16(a0[2], a0[3]); w.z = cvt_pk_bf16(a1[0], a1[1]); w.w = cvt_pk_bf16(a1[2], a1[3]); *(u32x4*)p = w; }
            }
        return;
    }
#pragma unroll
    for (int ai = 0; ai < 2; ++ai)
#pragma unroll
        for (int m = 0; m < 4; ++m) {
            const int row = row0 + ai * HALF + m * 16;
            float ssum = 0.f, ssq = 0.f;
#pragma unroll
            for (int bj = 0; bj < 2; ++bj) {
                f32x4 v0 = acc[ai][bj][m][0], v1 = acc[ai][bj][m][1];
                if (has_scale) { v0 = v0 * sc; v1 = v1 * sc; }
                if (act == 1) { v0 = gelu_tanh4(v0); v1 = gelu_tanh4(v1); }
                else if (act == 2) { v0 = relu2_4(v0); v1 = relu2_4(v1); }
                if (do_stats) {
#pragma unroll
                    for (int e = 0; e < 4; ++e) { ssum += v0[e] + v1[e]; ssq += v0[e] * v0[e] + v1[e] * v1[e]; }
                }
                const size_t off = (size_t)row * ldc + col0 + bj * HALF;
                if (out_f32) { float* p = (float*)Cb + off; *(f32x4*)p = v0; *(f32x4*)(p + 4) = v1; }
                else { u32x4 w; w.x = cvt_pk_bf16(v0[0], v0[1]); w.y = cvt_pk_bf16(v0[2], v0[3]); w.z = cvt_pk_bf16(v1[0], v1[1]); w.w = cvt_pk_bf16(v1[2], v1[3]);
                       if (REPEAT_MASK != 0ULL && nostore) { asm volatile("" :: "v"(w.x), "v"(w.y), "v"(w.z), "v"(w.w)); } else
                       if (NT_STORES) __builtin_nontemporal_store(w, (u32x4*)((bf16_t*)Cb + off)); else *(u32x4*)((bf16_t*)Cb + off) = w; }
            }
            if (do_stats) {
                ssum += __shfl_xor(ssum, 16); ssum += __shfl_xor(ssum, 32); ssq += __shfl_xor(ssq, 16); ssq += __shfl_xor(ssq, 32);
                if (fq == 0) { float* s = stats + ((size_t)row * 32 + (u.pn - stats_pn0) * 4 + wc) * 2; s[0] = ssum; s[1] = ssq; }
            }
        }
}

__device__ __forceinline__ void row_exchange(LAS unsigned char* lds, const float (&q)[2][4], unsigned* slot, unsigned* cnt, const Unit& u, int wr, int wc, int fr, int fq, int wid, int lane) {
    LAS float* P = (LAS float*)(lds + 131072 + 1024); LAS float* S = (LAS float*)(lds + 131072 + 5120);
#pragma unroll
    for (int ai = 0; ai < 2; ++ai)
#pragma unroll
        for (int m = 0; m < 4; ++m) { float t = q[ai][m]; t += __shfl_xor(t, 16); t += __shfl_xor(t, 32); if (fq == 0) P[(ai * HALF + wr * 64 + m * 16 + fr) * 4 + wc] = t; }
    asm volatile("s_waitcnt lgkmcnt(0)" ::: "memory"); __builtin_amdgcn_s_barrier(); asm volatile("" ::: "memory");
    const int row = wid * 32 + (lane & 31);
    unsigned* myslot = slot + ((size_t)(u.pm * BM + row) * 4);
    if (lane < 32) { const float t = (P[row * 4 + 0] + P[row * 4 + 1]) + (P[row * 4 + 2] + P[row * 4 + 3]);
        __hip_atomic_store(myslot + u.pn, __float_as_uint(t), __ATOMIC_RELAXED, __HIP_MEMORY_SCOPE_AGENT); }
    asm volatile("s_waitcnt vmcnt(0)" ::: "memory");
    if (lane == 0) __hip_atomic_fetch_add(cnt + 64 * u.pm, 1u, __ATOMIC_RELAXED, __HIP_MEMORY_SCOPE_AGENT);
    if (wid == 0) {
        for (int spin = 0; spin < (1 << 20); ++spin) {
            if ((unsigned)__builtin_amdgcn_readfirstlane((int)__hip_atomic_load(cnt + 64 * u.pm, __ATOMIC_RELAXED, __HIP_MEMORY_SCOPE_AGENT)) >= 32u) break;
            __builtin_amdgcn_s_sleep(2);
        }
        __builtin_amdgcn_fence(__ATOMIC_ACQUIRE, "agent");
    }
    asm volatile("s_waitcnt vmcnt(0) lgkmcnt(0)" ::: "memory"); __builtin_amdgcn_s_barrier(); asm volatile("" ::: "memory");
    if (lane < 32) { float t = 0.f;
#pragma unroll
        for (int k = 0; k < 4; ++k) t += __uint_as_float(__hip_atomic_load(myslot + k, __ATOMIC_RELAXED, __HIP_MEMORY_SCOPE_AGENT));
        S[row] = rsqrtf(t * (1.0f / 1024.0f) + 1e-6f); }
    asm volatile("s_waitcnt lgkmcnt(0)" ::: "memory"); __builtin_amdgcn_s_barrier(); asm volatile("" ::: "memory");
}
__device__ __forceinline__ void epilogue_fused(const LAS GJob* J, f32x4 (&acc)[2][2][4][2], const Unit& u, LAS unsigned char* lds, int wr, int wc, int fr, int fq, int wid, int lane) {
    const int row0 = u.pm * BM + wr * 64 + fr, col0 = u.pn * BM + wc * 32 + 8 * fq;
    const int bidx = (u.pm * BM) >> 12;
    const LAS float* S = (const LAS float*)(lds + 131072 + 5120);
    const unsigned lo4 = (unsigned)(row0 * DM + col0) * 4u, lo2 = (unsigned)(row0 * DM + col0) * 2u;
#define XOFF(ai, m, bj, n) ((unsigned)((((ai) * HALF + (m) * 16) * DM + (bj) * HALF + 4 * (n)) * 4))
    float q[2][4];
#pragma unroll
    for (int ai = 0; ai < 2; ++ai)
#pragma unroll
        for (int m = 0; m < 4; ++m) { float t = 0.f;
#pragma unroll
            for (int bj = 0; bj < 2; ++bj)
#pragma unroll
                for (int n = 0; n < 2; ++n) { const f32x4 y = acc[ai][bj][m][n]; t += (y[0] * y[0] + y[1] * y[1]) + (y[2] * y[2] + y[3] * y[3]); }
            q[ai][m] = t; }
    const char* xs = (const char*)jptr<const float>(&J->xsrc);
    const bool dst32 = (JI(x_mode) & 2) != 0;
    u32x4 xq[2][4];
#define XLOADH(bj) do { _Pragma("unroll") for (int ai = 0; ai < 2; ++ai) _Pragma("unroll") for (int m = 0; m < 4; ++m) xq[ai][m] = *(const u32x4*)(xs + XOFF(ai, m, bj, 0) / 2 + lo2); } while (0)
    XLOADH(0);
    row_exchange(lds, q, jptr<unsigned>(&J->slot1), jptr<unsigned>(&J->cnt1), u, wr, wc, fr, fq, wid, lane);
    {
        const float* gate = jptr<const float>(&J->modL) + bidx * 6144 + JI(gate_off) + col0; const float* gnp = jptr<const float>(&J->gn_post) + col0;
        char* xd = (char*)jptr<float>(&J->xdst);
#pragma unroll
        for (int ai = 0; ai < 2; ++ai)
#pragma unroll
            for (int m = 0; m < 4; ++m) q[ai][m] = 0.f;
#pragma unroll
        for (int bj = 0; bj < 2; ++bj) {
            const f32x4 gt0 = *(const f32x4*)(gate + bj * HALF), gt1 = *(const f32x4*)(gate + bj * HALF + 4), gp0 = *(const f32x4*)(gnp + bj * HALF), gp1 = *(const f32x4*)(gnp + bj * HALF + 4);
#pragma unroll
            for (int ai = 0; ai < 2; ++ai)
#pragma unroll
                for (int m = 0; m < 4; ++m) {
                    const float rs = S[ai * HALF + wr * 64 + m * 16 + fr]; const u32x4 w = xq[ai][m];
                    const f32x4 x0 = (f32x4){bflo(w.x), bfhi(w.x), bflo(w.y), bfhi(w.y)}, x1 = (f32x4){bflo(w.z), bfhi(w.z), bflo(w.w), bfhi(w.w)};
                    const f32x4 xn0 = x0 + gt0 * ((acc[ai][bj][m][0] * rs) * gp0), xn1 = x1 + gt1 * ((acc[ai][bj][m][1] * rs) * gp1);
                    acc[ai][bj][m][0] = xn0; acc[ai][bj][m][1] = xn1;
                    q[ai][m] += ((xn0[0] * xn0[0] + xn0[1] * xn0[1]) + (xn0[2] * xn0[2] + xn0[3] * xn0[3])) + ((xn1[0] * xn1[0] + xn1[1] * xn1[1]) + (xn1[2] * xn1[2] + xn1[3] * xn1[3])); }
            asm volatile("" ::: "memory");
            if (bj == 0) XLOADH(1);
            if (dst32) {
#pragma unroll
                for (int ai = 0; ai < 2; ++ai)
#pragma unroll
                    for (int m = 0; m < 4; ++m) { *(f32x4*)(xd + XOFF(ai, m, bj, 0) + lo4) = acc[ai][bj][m][0]; *(f32x4*)(xd + XOFF(ai, m, bj, 1) + lo4) = acc[ai][bj][m][1]; }
            } else {
#pragma unroll
                for (int ai = 0; ai < 2; ++ai)
#pragma unroll
                    for (int m = 0; m < 4; ++m) { const f32x4 a0 = acc[ai][bj][m][0], a1 = acc[ai][bj][m][1];
                        u32x4 w; w.x = cvt_pk_bf16(a0[0], a0[1]); w.y = cvt_pk_bf16(a0[2], a0[3]); w.z = cvt_pk_bf16(a1[0], a1[1]); w.w = cvt_pk_bf16(a1[2], a1[3]);
                        *(u32x4*)(xd + XOFF(ai, m, bj, 0) / 2 + lo2) = w; }
            }
        }
    }
#undef XLOADH
    if (!JI(has_next)) return;
    row_exchange(lds, q, jptr<unsigned>(&J->slot2), jptr<unsigned>(&J->cnt2), u, wr, wc, fr, fq, wid, lane);
    {
        const float* modN = jptr<const float>(&J->modN) + bidx * 6144 + col0; const float* shp = modN + JI(shift_off); const float* scp = modN + JI(scale_off); const float* gnn = jptr<const float>(&J->gn_next) + col0;
        char* H = (char*)jptr<bf16_t>(&J->Hout);
#pragma unroll
        for (int bj = 0; bj < 2; ++bj) {
            const f32x4 gn0 = *(const f32x4*)(gnn + bj * HALF), gn1 = *(const f32x4*)(gnn + bj * HALF + 4), sh0 = *(const f32x4*)(shp + bj * HALF), sh1 = *(const f32x4*)(shp + bj * HALF + 4);
            const f32x4 sc0 = *(const f32x4*)(scp + bj * HALF) + 1.0f, sc1 = *(const f32x4*)(scp + bj * HALF + 4) + 1.0f;
#pragma unroll
            for (int ai = 0; ai < 2; ++ai)
#pragma unroll
                for (int m = 0; m < 4; ++m) {
                    const float rs = S[ai * HALF + wr * 64 + m * 16 + fr];
                    const f32x4 h0 = ((acc[ai][bj][m][0] * rs) * gn0) * sc0 + sh0, h1 = ((acc[ai][bj][m][1] * rs) * gn1) * sc1 + sh1;
                    u32x4 w; w.x = cvt_pk_bf16(h0[0], h0[1]); w.y = cvt_pk_bf16(h0[2], h0[3]); w.z = cvt_pk_bf16(h1[0], h1[1]); w.w = cvt_pk_bf16(h1[2], h1[3]);
                    *(u32x4*)(H + XOFF(ai, m, bj, 0) / 2 + lo2) = w; }
        }
    }
#undef XOFF
}

__device__ __forceinline__ void epilogue_qkv(const LAS GJob* J, const f32x4 (&acc)[2][2][4][2], const Unit& u, LAS unsigned char* lds, int wr, int wc, int fr, int fq) {
    asm volatile("" : "+v"(fr), "+v"(fq));
    LAS float* P = (LAS float*)(lds + 131072 + 1024);
    const bool is_v = (u.pn == 5), is_k = (u.pn == 4);
    if (!is_v) {
#pragma unroll
        for (int ai = 0; ai < 2; ++ai)
#pragma unroll
            for (int m = 0; m < 4; ++m)
#pragma unroll
                for (int bj = 0; bj < 2; ++bj) { const f32x4 a = acc[ai][bj][m][0], b = acc[ai][bj][m][1];
                    float t = ((a[0] * a[0] + a[1] * a[1]) + (a[2] * a[2] + a[3] * a[3])) + ((b[0] * b[0] + b[1] * b[1]) + (b[2] * b[2] + b[3] * b[3]));
                    t += __shfl_xor(t, 16); t += __shfl_xor(t, 32);
                    if (fq == 0) P[((ai * HALF + wr * 64 + m * 16 + fr) * 2 + bj) * 4 + wc] = t; }
    }
    asm volatile("s_waitcnt lgkmcnt(0)" ::: "memory"); __builtin_amdgcn_s_barrier(); asm volatile("" ::: "memory");
    const int d0 = 16 * wc + 4 * fq;
    bf16_t* const Qd = jptr<bf16_t>(&J->C); bf16_t* const Kd = jptr<bf16_t>(&J->Kd); bf16_t* const Vd = jptr<bf16_t>(&J->Vd);
    const float* g = is_k ? jptr<const float>(&J->kg) : jptr<const float>(&J->qg);
    f32x4 g1 = (f32x4){1.f, 1.f, 1.f, 1.f}, g2 = g1; float inv[4] = {0.f, 0.f, 0.f, 0.f};
    if (!is_v) { g1 = *(const f32x4*)(g + d0); g2 = *(const f32x4*)(g + 64 + d0);
#pragma unroll
        for (int e = 0; e < 4; ++e) inv[e] = exp2f(-(float)((d0 + e) & 31) * (13.287712379549449f / 32.0f)); }
#pragma unroll
    for (int ai = 0; ai < 2; ++ai)
#pragma unroll
        for (int m = 0; m < 4; ++m) {
            const int trow = ai * HALF + wr * 64 + m * 16 + fr, row = u.pm * BM + trow;
            const bool lat = row < RL; const int b = lat ? (row >> 12) : ((row - RL) >> 8), t = lat ? (row & 4095) : ((row - RL) & 255), pos = lat ? (CTXL + t) : t;
            const size_t kvoff = ((size_t)b * SKV + pos) * 256;
            if (is_v) {
#pragma unroll
                for (int bj = 0; bj < 2; ++bj) { const f32x4 a = acc[ai][bj][m][0], c = acc[ai][bj][m][1];
                    u32x4 w; w.x = cvt_pk_bf16(a[0], a[1]); w.y = cvt_pk_bf16(a[2], a[3]); w.z = cvt_pk_bf16(c[0], c[1]); w.w = cvt_pk_bf16(c[2], c[3]);
                    *(u32x4*)(Vd + kvoff + bj * HALF + 32 * wc + 8 * fq) = w; }
            } else {
                f32x4 cs = (f32x4){1.f, 1.f, 1.f, 1.f}, sn = (f32x4){0.f, 0.f, 0.f, 0.f};
                if (lat) { const float p = (d0 < 32) ? (float)(t >> 6) : (float)(t & 63);
#pragma unroll
                    for (int e = 0; e < 4; ++e) { float rev = (p * inv[e]) * 0.15915494309189535f; rev -= floorf(rev); sn[e] = __builtin_amdgcn_sinf(rev); cs[e] = __builtin_amdgcn_cosf(rev); } }
#pragma unroll
                for (int bj = 0; bj < 2; ++bj) {
                    const f32x4 pr = *(const LAS f32x4*)(P + (trow * 2 + bj) * 4);
                    const float rs = rsqrtf(((pr[0] + pr[1]) + (pr[2] + pr[3])) * (1.0f / 128.0f) + NORM_EPS);
                    const f32x4 y1 = (acc[ai][bj][m][0] * rs) * g1, y2 = (acc[ai][bj][m][1] * rs) * g2;
                    const f32x4 o1 = y1 * cs - y2 * sn, o2 = y1 * sn + y2 * cs;
                    u32x2 w1, w2; w1.x = cvt_pk_bf16(o1[0], o1[1]); w1.y = cvt_pk_bf16(o1[2], o1[3]); w2.x = cvt_pk_bf16(o2[0], o2[1]); w2.y = cvt_pk_bf16(o2[2], o2[3]);
                    if (is_k) { bf16_t* d = Kd + kvoff + bj * HALF + d0; *(u32x2*)d = w1; *(u32x2*)(d + 64) = w2; }
                    else if (lat) { bf16_t* d = Qd + (size_t)row * 1024 + (2 * u.pn + bj) * HALF + d0; *(u32x2*)d = w1; *(u32x2*)(d + 64) = w2; }
                }
            }
        }
}

__device__ __forceinline__ void gemm_phase(LAS unsigned char* lds, const LAS GJob* J, int G, int cidx, const int tid) {
    const int wid = __builtin_amdgcn_readfirstlane(tid >> 6), lane = tid & 63, wr = wid >> 2, wc = wid & 3, fr = lane & 15, fq = lane >> 4;
    const int lda = JI(lda), ldb = JI(ldb);
    unsigned voffA[2], voffB[2];
#pragma unroll
    for (int i = 0; i < 2; ++i) { int R, C; stage_rc(tid * 16 + i * 8192, R, C); const int Rb = (R & ~31) + perm32(R & 31);
        voffA[i] = (unsigned)(R * lda + C) * 2u; voffB[i] = (unsigned)(Rb * ldb + C) * 2u; }
    const size_t kstep = (size_t)(BK * 2);
    const size_t hsA = (size_t)HALF * lda * 2, hsB = (size_t)HALF * ldb * 2;
    const unsigned ldsw = (unsigned)wid * 1024u;
    const int aoff = lds_byte(wr * 64 + fr, fq * 8), boff = lds_byte(wc * 32 + fr, fq * 8);
#define PG8_SA(b, h) (((b) * 2 + (h)) * HTB)
#define PG8_SB(b, h) ((4 + (b) * 2 + (h)) * HTB)
#define PG8_STAGE(bufoff, gbase, voff) do { _Pragma("unroll") for (int _i = 0; _i < 2; ++_i) \
        __builtin_amdgcn_global_load_lds((const unsigned*)((const char*)(gbase) + (voff)[_i]), (LAS unsigned*)(lds + (bufoff) + ldsw + _i * 8192), 16, 0, 0); } while (0)
#define PG8_LDA(dst, b, h) do { _Pragma("unroll") for (int m = 0; m < 4; ++m) _Pragma("unroll") for (int k = 0; k < 2; ++k) dst[m][k] = *(const LAS bf16x8*)(lds + PG8_SA(b, h) + aoff + m * 2048 + k * 1024); } while (0)
#define PG8_LDB(dst, b, h) do { _Pragma("unroll") for (int n = 0; n < 2; ++n) _Pragma("unroll") for (int k = 0; k < 2; ++k) dst[n][k] = *(const LAS bf16x8*)(lds + PG8_SB(b, h) + boff + n * 2048 + k * 1024); } while (0)
#define PG8_MMA(ai, bj, At, Bt) do { __builtin_amdgcn_s_setprio(1); _Pragma("unroll") for (int m = 0; m < 4; ++m) _Pragma("unroll") for (int n = 0; n < 2; ++n) _Pragma("unroll") for (int k = 0; k < 2; ++k) \
        acc[ai][bj][m][n] = __builtin_amdgcn_mfma_f32_16x16x32_bf16(Bt[n][k], At[m][k], acc[ai][bj][m][n], 0, 0, 0); __builtin_amdgcn_s_setprio(0); } while (0)
#define PG8_WAIT_V(n) asm volatile("s_waitcnt vmcnt(" #n ")" ::: "memory")
#define PG8_WAIT_L(n) asm volatile("s_waitcnt lgkmcnt(" #n ")" ::: "memory")
#define PG8_BAR __builtin_amdgcn_s_barrier()
#define PG8_SCHED __builtin_amdgcn_sched_barrier(0)
    Unit cur, nxt; int ui = 0;
    LAS unsigned* const utab = (LAS unsigned*)(lds + 131072 + 9216);
    unit_table_build(utab, J, G, cidx, tid);
    asm volatile("s_waitcnt lgkmcnt(0)" ::: "memory"); __builtin_amdgcn_s_barrier(); asm volatile("" ::: "memory");
    if (!unit_fetch(utab, 0, cur)) return;
    f32x4 acc[2][2][4][2];
#pragma unroll
    for (int a = 0; a < 2; ++a)
#pragma unroll
        for (int b = 0; b < 2; ++b)
#pragma unroll
            for (int m = 0; m < 4; ++m)
#pragma unroll
                for (int n = 0; n < 2; ++n) acc[a][b][m][n] = (f32x4){0.f, 0.f, 0.f, 0.f};
    bf16x8 At[4][2], B0[2][2], B1[2][2];
    const char* cA = cur.a; const char* cB = cur.b;
    PG8_STAGE(PG8_SB(0, 0), cB, voffB); PG8_STAGE(PG8_SB(0, 1), cB + hsB, voffB); PG8_STAGE(PG8_SA(0, 0), cA, voffA); PG8_STAGE(PG8_SA(0, 1), cA + hsA, voffA);
    if (wr == 1) PG8_BAR;
    PG8_WAIT_V(2); PG8_BAR;
    PG8_STAGE(PG8_SB(1, 0), cB + kstep, voffB); PG8_STAGE(PG8_SA(1, 0), cA + kstep, voffA); PG8_STAGE(PG8_SB(1, 1), cB + hsB + kstep, voffB);
    PG8_WAIT_V(6); PG8_BAR;
    for (;;) {
        const bool has_next = unit_fetch(utab, ui + 1, nxt);
        const char* nA = has_next ? nxt.a : cA; const char* nB = has_next ? nxt.b : cB;
        const int nt = cur.nt;
        for (int t = 0; t < nt; t += 2) {
            const bool last = (t == nt - 2);
            const char* a1 = cA + (size_t)(t + 1) * kstep;
            const char* a2 = last ? nA : cA + (size_t)(t + 2) * kstep; const char* b2 = last ? nB : cB + (size_t)(t + 2) * kstep;
            const char* a3 = a2 + kstep; const char* b3 = b2 + kstep;
            PG8_LDB(B0, 0, 0); PG8_LDB(B1, 0, 1); PG8_SCHED; PG8_LDA(At, 0, 0); PG8_STAGE(PG8_SA(1, 1), a1 + hsA, voffA);
            PG8_WAIT_V(8); PG8_WAIT_L(0); PG8_BAR; PG8_MMA(0, 0, At, B0); PG8_MMA(0, 1, At, B1); PG8_BAR; PG8_SCHED;
            PG8_LDA(At, 0, 1); PG8_STAGE(PG8_SB(0, 0), b2, voffB); PG8_STAGE(PG8_SB(0, 1), b2 + hsB, voffB); PG8_STAGE(PG8_SA(0, 0), a2, voffA);
            PG8_WAIT_V(8); PG8_WAIT_L(0); PG8_BAR; PG8_MMA(1, 0, At, B0); PG8_MMA(1, 1, At, B1); PG8_BAR; PG8_SCHED;
            PG8_LDB(B0, 1, 0); PG8_LDB(B1, 1, 1); PG8_SCHED; PG8_LDA(At, 1, 0); PG8_STAGE(PG8_SA(0, 1), a2 + hsA, voffA);
            PG8_WAIT_V(8); PG8_WAIT_L(0); PG8_BAR; PG8_MMA(0, 0, At, B0); PG8_MMA(0, 1, At, B1); PG8_BAR; PG8_SCHED;
            PG8_LDA(At, 1, 1); PG8_STAGE(PG8_SB(1, 0), b3, voffB); PG8_STAGE(PG8_SB(1, 1), b3 + hsB, voffB); PG8_STAGE(PG8_SA(1, 0), a3, voffA);
            PG8_WAIT_V(8); PG8_WAIT_L(0); PG8_BAR; PG8_MMA(1, 0, At, B0); PG8_MMA(1, 1, At, B1); PG8_BAR; PG8_SCHED;
        }
        if (wr == 0) PG8_BAR;
        if (REPEAT_MASK != 0ULL && JI(dry) == 1) {   } else
#ifndef NO_FUSED
#ifndef NO_FUSEDEPI
        if (JI(fused) && cur.ks < 0) epilogue_fused(J, acc, cur, lds, wr, wc, fr, fq, wid, lane);
        else
#endif
        if (false) {}
        else
#endif
        epilogue(J, acc, cur, wr, wc, fr, fq);
        if (!has_next) break;
#pragma unroll
        for (int a = 0; a < 2; ++a)
#pragma unroll
            for (int b = 0; b < 2; ++b)
#pragma unroll
                for (int m = 0; m < 4; ++m)
#pragma unroll
                    for (int n = 0; n < 2; ++n) acc[a][b][m][n] = (f32x4){0.f, 0.f, 0.f, 0.f};
        cur = nxt; cA = nA; cB = nB; ++ui;
        if (wr == 1) PG8_BAR;
    }
    PG8_WAIT_V(0);
    PG8_BAR;
#undef PG8_SA
#undef PG8_SB
#undef PG8_STAGE
#undef PG8_LDA
#undef PG8_LDB
#undef PG8_MMA
#undef PG8_WAIT_V
#undef PG8_WAIT_L
#undef PG8_BAR
#undef PG8_SCHED
}
}
using pg8::GJob;

namespace att {
constexpr int D = 128, NW = 8, QBLK = 32, KVBLK = 64;
constexpr float SCALE = 0.088388347648318440f;
constexpr float THR = 8.f;
constexpr int LDQ = 1024, LDK = 256, LDO = 1024;
constexpr size_t SHM_V = KVBLK * D * 2, SHM_K = KVBLK * D * 2, SHM_ATTN = 2 * SHM_V + 2 * SHM_K + NW * 64 * 4;
#define KSWZ(row, colB) ((row) * 256 + ((colB) ^ (((row) & 7) << 4)))
#define SBAR() __builtin_amdgcn_sched_barrier(0)
__device__ __forceinline__ int crow(int r, int hi) { return (r & 3) + 8 * (r >> 2) + 4 * hi; }
__device__ __forceinline__ void partialSM(f32x16& p0, f32x16& p1, float& m_reg, float& mn, float& alpha) {
  constexpr float C = SCALE * 1.4426950408889634f;
  float pmax = p0[0]; for (int r = 1; r < 16; ++r) pmax = fmaxf(pmax, p0[r]); for (int r = 0; r < 16; ++r) pmax = fmaxf(pmax, p1[r]);
  { auto rr = __builtin_amdgcn_permlane32_swap(__float_as_uint(pmax), __float_as_uint(pmax), false, false);
    pmax = fmaxf(__uint_as_float(rr[0]), __uint_as_float(rr[1])); }
  if (__builtin_expect(__all(pmax - m_reg <= THR / SCALE), 1)) { mn = m_reg; alpha = 1.f; }
  else { mn = fmaxf(m_reg, pmax); alpha = __builtin_amdgcn_exp2f((m_reg - mn) * C); m_reg = mn; }
  float mnC = -mn * C;
  for (int r = 0; r < 16; ++r) p0[r] = fmaf(p0[r], C, mnC); for (int r = 0; r < 16; ++r) p1[r] = fmaf(p1[r], C, mnC);
  for (int r = 0; r < 16; ++r) p0[r] = __builtin_amdgcn_exp2f(p0[r]);
}
__device__ __forceinline__ void finishSM(f32x16& p0, f32x16& p1, float alpha, float& l_reg, bf16x8& pa0, bf16x8& pa1, bf16x8& pa2, bf16x8& pa3) {
  for (int r = 0; r < 16; ++r) p1[r] = __builtin_amdgcn_exp2f(p1[r]);
  float ps = 0; for (int r = 0; r < 16; ++r) ps += p0[r]; for (int r = 0; r < 16; ++r) ps += p1[r];
  { auto rr = __builtin_amdgcn_permlane32_swap(__float_as_uint(ps), __float_as_uint(ps), false, false);
    ps = __uint_as_float(rr[0]) + __uint_as_float(rr[1]); }
  l_reg = l_reg * alpha + ps;
#define PK4(P, BASE, OUT) do { unsigned a0 = cvt_pk_bf16(P[BASE + 0], P[BASE + 1]), a1 = cvt_pk_bf16(P[BASE + 2], P[BASE + 3]);   \
    unsigned b0 = cvt_pk_bf16(P[BASE + 4], P[BASE + 5]), b1 = cvt_pk_bf16(P[BASE + 6], P[BASE + 7]);                              \
    auto r0 = __builtin_amdgcn_permlane32_swap(a0, b0, false, false); auto r1 = __builtin_amdgcn_permlane32_swap(a1, b1, false, false); \
    u32x4 w = {r0[0], r1[0], r0[1], r1[1]}; OUT = *reinterpret_cast<bf16x8*>(&w); } while (0)
  PK4(p0, 0, pa0); PK4(p0, 8, pa1); PK4(p1, 0, pa2); PK4(p1, 8, pa3);
#undef PK4
}
__device__ __forceinline__ void qkt(f32x16& p0, f32x16& p1, const bf16_t* Ks, const bf16x8* qr, int r32, int hi) {
  p0 = f32x16{}; p1 = f32x16{};
  for (int d0 = 0; d0 < 8; ++d0) { int cb = (d0 * 16 + hi * 8) * 2;
    bf16x8 b0 = *reinterpret_cast<const bf16x8*>((const char*)Ks + KSWZ(r32, cb));
    bf16x8 b1 = *reinterpret_cast<const bf16x8*>((const char*)Ks + KSWZ(32 + r32, cb));
    p0 = __builtin_amdgcn_mfma_f32_32x32x16_bf16(b0, qr[d0], p0, 0, 0, 0);
    p1 = __builtin_amdgcn_mfma_f32_32x32x16_bf16(b1, qr[d0], p1, 0, 0, 0); }
}
__device__ __forceinline__ int v_st(int k, int c) { const int kk = (k & ~0xC) | ((k & 4) << 1) | ((k & 8) >> 1); return ((kk >> 3) * 4 + (c >> 5)) * 512 + ((kk & 7) * 32 + (c & 31)) * 2; }
__device__ __forceinline__ int v_rd_base(int lane) { return ((lane & 3) << 3) | (((lane >> 2) & 3) << 6) | (((lane >> 4) & 1) << 5) | (((lane >> 5) & 1) << 8); }
constexpr int v_rd_off(int d0, int ks, int half) { return d0 * 512 + ks * 4096 + half * 2048; }
template <int OFF> __device__ __forceinline__ s16x4 tr_read(int vb) {
  s16x4 r; asm volatile("ds_read_b64_tr_b16 %0, %1 offset:%2" : "=&v"(r) : "v"(vb), "i"(OFF) : "memory"); return r;
}
template <int D0> __device__ __forceinline__ void pv_one(f32x16& od, int vb, bf16x8 pa0, bf16x8 pa1, bf16x8 pa2, bf16x8 pa3) {
  const s16x4 l0 = tr_read<v_rd_off(D0, 0, 0)>(vb), h0 = tr_read<v_rd_off(D0, 0, 1)>(vb), l1 = tr_read<v_rd_off(D0, 1, 0)>(vb), h1 = tr_read<v_rd_off(D0, 1, 1)>(vb);
  const s16x4 l2 = tr_read<v_rd_off(D0, 2, 0)>(vb), h2 = tr_read<v_rd_off(D0, 2, 1)>(vb), l3 = tr_read<v_rd_off(D0, 3, 0)>(vb), h3 = tr_read<v_rd_off(D0, 3, 1)>(vb);
  asm volatile("s_waitcnt lgkmcnt(0)" ::: "memory"); SBAR();
#define PK(L, H) (bf16x8){L[0], L[1], L[2], L[3], H[0], H[1], H[2], H[3]}
  od = __builtin_amdgcn_mfma_f32_32x32x16_bf16(pa0, PK(l0, h0), od, 0, 0, 0);
  od = __builtin_amdgcn_mfma_f32_32x32x16_bf16(pa1, PK(l1, h1), od, 0, 0, 0);
  od = __builtin_amdgcn_mfma_f32_32x32x16_bf16(pa2, PK(l2, h2), od, 0, 0, 0);
  od = __builtin_amdgcn_mfma_f32_32x32x16_bf16(pa3, PK(l3, h3), od, 0, 0, 0);
#undef PK
}
__device__ __forceinline__ void pv_d0(f32x16* o, int vb, bf16x8 pa0, bf16x8 pa1, bf16x8 pa2, bf16x8 pa3) {
  pv_one<0>(o[0], vb, pa0, pa1, pa2, pa3); pv_one<1>(o[1], vb, pa0, pa1, pa2, pa3); pv_one<2>(o[2], vb, pa0, pa1, pa2, pa3); pv_one<3>(o[3], vb, pa0, pa1, pa2, pa3);
}
__device__ __forceinline__ void attn_dense_body(const bf16_t* __restrict__ Qb, const bf16_t* __restrict__ Kh, const bf16_t* __restrict__ Vh,
                                                bf16_t* __restrict__ Ob, int seq, char* lds, const int tid) {
  constexpr int SDEPTH = 2;
  const int wid = tid >> 6, lane = tid & 63, r32 = lane & 31, hi = lane >> 5;
  bf16_t* V_lds = (bf16_t*)lds; bf16_t* K_lds = (bf16_t*)(lds + 2 * SHM_V);
  float* ws = (float*)(lds + 2 * SHM_V + 2 * SHM_K) + wid * 64; float* li_l = ws; float* al_l = ws + 32;
  float m_reg = -1e30f, l_reg = 0; f32x16 o[4] = {}; bf16x8 qr[8];
  const bf16_t* Qw = Qb + (long)(wid * QBLK + r32) * LDQ + hi * 8;
#pragma unroll
  for (int d0 = 0; d0 < 8; ++d0) qr[d0] = *reinterpret_cast<const bf16x8*>(Qw + d0 * 16);
  const int sr = tid >> 4, sc = (tid & 15) * 8, vst0 = v_st(sr, sc), vst1 = v_st(32 + sr, sc);
  const int vb0 = (int)(uintptr_t)V_lds + v_rd_base(lane);
  struct { bf16x8 vs0, vs1, ks0, ks1; } sr_[SDEPTH];
#define LD8(p) (*reinterpret_cast<const bf16x8*>(p))
  const unsigned kvoff = (unsigned)((sr * LDK + sc) * 2);
#define SLOAD(i, k0) do { const char* vb_ = (const char*)Vh + (size_t)(k0) * (LDK * 2); const char* kb_ = (const char*)Kh + (size_t)(k0) * (LDK * 2); \
    sr_[i].vs0 = LD8(vb_ + kvoff); sr_[i].vs1 = LD8(vb_ + 32 * LDK * 2 + kvoff); \
    sr_[i].ks0 = LD8(kb_ + kvoff); sr_[i].ks1 = LD8(kb_ + 32 * LDK * 2 + kvoff); } while (0)
#define SWRITE(b, i) do { *(bf16x8*)((char*)V_lds + (b) * SHM_V + vst0) = sr_[i].vs0;          \
    *(bf16x8*)((char*)V_lds + (b) * SHM_V + vst1) = sr_[i].vs1; int kc = sc * 2;               \
    *(bf16x8*)((char*)K_lds + (b) * SHM_K + KSWZ(sr, kc)) = sr_[i].ks0;                       \
    *(bf16x8*)((char*)K_lds + (b) * SHM_K + KSWZ(32 + sr, kc)) = sr_[i].ks1; } while (0)
#define SWAIT() do { if constexpr (SDEPTH == 2) asm volatile("s_waitcnt vmcnt(4)" ::: "memory"); else asm volatile("s_waitcnt vmcnt(0)" ::: "memory"); } while (0)
#define RESC(a) do { if (__any((a) < 1.f)) { if (hi == 0) al_l[r32] = (a); asm volatile("s_waitcnt lgkmcnt(0)" ::: "memory"); \
    for (int d = 0; d < 4; ++d) for (int r = 0; r < 16; ++r) o[d][r] *= al_l[crow(r, hi)]; } } while (0)
  f32x16 pA0, pA1, pB0, pB1; float mnA, mnB, alA, alB; bf16x8 pa0, pa1, pa2, pa3; const int NT = seq / KVBLK;
  constexpr int SE = 0, SO = SDEPTH - 1;
  SLOAD(SE, 0); asm volatile("s_waitcnt vmcnt(0)" ::: "memory"); SWRITE(0, SE); __syncthreads();
  qkt(pA0, pA1, K_lds, qr, r32, hi); partialSM(pA0, pA1, m_reg, mnA, alA);
  SLOAD(SO, KVBLK); if constexpr (SDEPTH == 2) { if (2 < NT) SLOAD(SE, 2 * KVBLK); }
  SWAIT(); SWRITE(1, SO); __syncthreads();
  for (int j = 1; j + 1 < NT; j += 2) {
    SBAR(); qkt(pB0, pB1, (bf16_t*)((char*)K_lds + SHM_K), qr, r32, hi);
    finishSM(pA0, pA1, alA, l_reg, pa0, pa1, pa2, pa3); SBAR();
    SLOAD(SO, (j + SDEPTH) * KVBLK); SBAR();
    pv_d0(o, vb0, pa0, pa1, pa2, pa3); partialSM(pB0, pB1, m_reg, mnB, alB);
    __syncthreads(); SWAIT(); SWRITE(0, SE);
    RESC(alB); __syncthreads();
    SBAR(); qkt(pA0, pA1, K_lds, qr, r32, hi);
    finishSM(pB0, pB1, alB, l_reg, pa0, pa1, pa2, pa3); SBAR();
    if (SDEPTH == 1 || j + 3 < NT) SLOAD(SE, (j + 1 + SDEPTH) * KVBLK); SBAR();
    pv_d0(o, vb0 + (int)SHM_V, pa0, pa1, pa2, pa3); partialSM(pA0, pA1, m_reg, mnA, alA);
    __syncthreads(); SWAIT(); SWRITE(1, SO);
    RESC(alA); __syncthreads();
  }
  SBAR(); qkt(pB0, pB1, (bf16_t*)((char*)K_lds + SHM_K), qr, r32, hi);
  finishSM(pA0, pA1, alA, l_reg, pa0, pa1, pa2, pa3); SBAR();
  pv_d0(o, vb0, pa0, pa1, pa2, pa3); partialSM(pB0, pB1, m_reg, mnB, alB);
  __syncthreads(); RESC(alB);
  finishSM(pB0, pB1, alB, l_reg, pa0, pa1, pa2, pa3); SBAR();
  pv_d0(o, vb0 + (int)SHM_V, pa0, pa1, pa2, pa3);
  if (hi == 0) li_l[r32] = l_reg; asm volatile("s_waitcnt lgkmcnt(0)" ::: "memory");
  float rli[16];
#pragma unroll
  for (int r = 0; r < 16; ++r) rli[r] = __builtin_amdgcn_rcpf(li_l[crow(r, hi)]);
  bf16_t* Ow = Ob + (long)(wid * QBLK) * LDO;
#pragma unroll
  for (int r = 0; r < 16; ++r) { int orow = crow(r, hi);
#pragma unroll
    for (int d0 = 0; d0 < 4; ++d0) Ow[(long)orow * LDO + d0 * 32 + r32] = f2bf(o[d0][r] * rli[r]); }
#undef LD8
#undef SLOAD
#undef SWRITE
#undef SWAIT
#undef RESC
}
}

struct RowJob {
    int row0, nrows, has_y, has_next, ldy;
    const bf16_t* Y; const float* gn_post; const float* modL; int gate_off;
    const float* xsrc_lat; const float* xsrc_ctx; float* xdst_lat; float* xdst_ctx;
    const float* gn_next; const float* modN; int shift_off, scale_off; bf16_t* H;
    const float* ypart;
    bf16_t* x16;
};
constexpr int RPW = 2;
__device__ __forceinline__ void wave_sumR(float (&v)[RPW]) {
#pragma unroll
    for (int o = 1; o < 64; o <<= 1) {
#pragma unroll
        for (int r = 0; r < RPW; ++r) v[r] += __shfl_xor(v[r], o);
    }
}
__device__ __forceinline__ void row_phase(const RowJob& J, int gw, int ngw, int lane) {
    const int has_y = J.has_y, has_next = J.has_next;
    f32x4 gnp[4], gnn[4];
#pragma unroll
    for (int j = 0; j < 4; ++j) { gnp[j] = *(const f32x4*)(J.gn_post + 4 * lane + 256 * j); gnn[j] = *(const f32x4*)(J.gn_next + 4 * lane + 256 * j); }
    for (int base = J.row0 + gw * RPW; base < J.nrows; base += ngw * RPW) {
        const bool lat = base < RL; const int bidx = lat ? (base >> 12) : 8;
        const float* xs = lat ? J.xsrc_lat + (size_t)base * DM : J.xsrc_ctx + (size_t)(base - RL) * DM;
        float* xd = lat ? J.xdst_lat + (size_t)base * DM : J.xdst_ctx + (size_t)(base - RL) * DM;
        f32x4 x[RPW][4]; u32x2 yw[RPW][4];
#pragma unroll
        for (int r = 0; r < RPW; ++r)
#pragma unroll
            for (int j = 0; j < 4; ++j) x[r][j] = *(const f32x4*)(xs + (size_t)r * DM + 4 * lane + 256 * j);
        if (has_y) {
            if (!lat && J.ypart != nullptr) {
                const bf16_t* pr = (const bf16_t*)J.ypart + (size_t)(base - RL) * DM;
#pragma unroll
                for (int r = 0; r < RPW; ++r)
#pragma unroll
                    for (int j = 0; j < 4; ++j) { f32x4 a = (f32x4){0.f, 0.f, 0.f, 0.f};
#pragma unroll
                        for (int k2 = 0; k2 < 4; ++k2) { const u32x2 w = *(const u32x2*)(pr + ((size_t)k2 * RC + r) * DM + 4 * lane + 256 * j); a = a + (f32x4){bflo(w.x), bfhi(w.x), bflo(w.y), bfhi(w.y)}; }
                        yw[r][j].x = cvt_pk_bf16(a[0], a[1]); yw[r][j].y = cvt_pk_bf16(a[2], a[3]); }
            } else {
                const bf16_t* yr = J.Y + (size_t)base * J.ldy;
#pragma unroll
                for (int r = 0; r < RPW; ++r)
#pragma unroll
                    for (int j = 0; j < 4; ++j) yw[r][j] = *(const u32x2*)(yr + (size_t)r * J.ldy + 4 * lane + 256 * j);
            }
        }
        f32x4 gt[4], sh[4], sc[4];
        {
            const float* gate = J.modL + bidx * 6144 + J.gate_off; const float* shp = J.modN + bidx * 6144 + J.shift_off; const float* scp = J.modN + bidx * 6144 + J.scale_off;
#pragma unroll
            for (int j = 0; j < 4; ++j) { gt[j] = *(const f32x4*)(gate + 4 * lane + 256 * j); sh[j] = *(const f32x4*)(shp + 4 * lane + 256 * j); sc[j] = *(const f32x4*)(scp + 4 * lane + 256 * j); }
        }
        if (has_y) {
            float ss[RPW];
#pragma unroll
            for (int r = 0; r < RPW; ++r) { float a = 0.f;
#pragma unroll
                for (int j = 0; j < 4; ++j) { const float y0 = bflo(yw[r][j].x), y1 = bfhi(yw[r][j].x), y2 = bflo(yw[r][j].y), y3 = bfhi(yw[r][j].y); a += (y0 * y0 + y1 * y1) + (y2 * y2 + y3 * y3); }
                ss[r] = a; }
            wave_sumR(ss);
#pragma unroll
            for (int r = 0; r < RPW; ++r) { const float rs = rsqrtf(ss[r] * (1.0f / DM) + NORM_EPS);
#pragma unroll
                for (int j = 0; j < 4; ++j) { const f32x4 y = (f32x4){bflo(yw[r][j].x), bfhi(yw[r][j].x), bflo(yw[r][j].y), bfhi(yw[r][j].y)};
                    x[r][j] = x[r][j] + gt[j] * ((y * rs) * gnp[j]); *(f32x4*)(xd + (size_t)r * DM + 4 * lane + 256 * j) = x[r][j]; } }
        }
        if (J.x16 != nullptr && lat) {
#pragma unroll
            for (int r = 0; r < RPW; ++r)
#pragma unroll
                for (int j = 0; j < 4; ++j) { u32x2 w; w.x = cvt_pk_bf16(x[r][j][0], x[r][j][1]); w.y = cvt_pk_bf16(x[r][j][2], x[r][j][3]); *(u32x2*)(J.x16 + (size_t)(base + r) * DM + 4 * lane + 256 * j) = w; }
        }
        if (has_next) {
            float ss[RPW];
#pragma unroll
            for (int r = 0; r < RPW; ++r) { float a = 0.f;
#pragma unroll
                for (int j = 0; j < 4; ++j) a += (x[r][j][0] * x[r][j][0] + x[r][j][1] * x[r][j][1]) + (x[r][j][2] * x[r][j][2] + x[r][j][3] * x[r][j][3]);
                ss[r] = a; }
            wave_sumR(ss);
            bf16_t* hr = J.H + (size_t)base * DM;
#pragma unroll
            for (int r = 0; r < RPW; ++r) { const float rs = rsqrtf(ss[r] * (1.0f / DM) + NORM_EPS);
#pragma unroll
                for (int j = 0; j < 4; ++j) { const f32x4 h = ((x[r][j] * rs) * gnn[j]) * (sc[j] + 1.0f) + sh[j]; u32x2 w; w.x = cvt_pk_bf16(h[0], h[1]); w.y = cvt_pk_bf16(h[2], h[3]);
                    *(u32x2*)(hr + (size_t)r * DM + 4 * lane + 256 * j) = w; } }
        }
    }
}

__device__ __forceinline__ void qkvpost_phase(const bf16_t* raw, const float* qg, const float* kg, bf16_t* Q, bf16_t* Kb, bf16_t* Vb, int gw, int ngw, int lane) {
    const float qg1 = qg[lane], qg2 = qg[64 + lane], kg1 = kg[lane], kg2 = kg[64 + lane];
    const float inv = exp2f(-(float)(lane & 31) * (13.287712379549449f / 32.0f));
    for (int row = gw; row < RT; row += ngw) {
        const bool lat = row < RL; const int b = lat ? (row >> 12) : ((row - RL) >> 8); const int t = lat ? (row & 4095) : ((row - RL) & 255);
        const int pos = lat ? (CTXL + t) : t;
        const bf16_t* r = raw + (size_t)row * 1536;
#define RB(i) (__uint_as_float((unsigned)r[(i)] << 16))
        float cs = 1.f, sn = 0.f;
        if (lat) { const float p = (lane < 32) ? (float)(t >> 6) : (float)(t & 63); const float ang = p * inv; float rev = ang * 0.15915494309189535f; rev -= floorf(rev);
            sn = __builtin_amdgcn_sinf(rev); cs = __builtin_amdgcn_cosf(rev); }
        if (lat) {
#pragma unroll
            for (int h = 0; h < 8; ++h) { const float x1 = RB(h * 128 + lane), x2 = RB(h * 128 + 64 + lane);
                const float ss = wave_sum(x1 * x1 + x2 * x2); const float rs = rsqrtf(ss * (1.0f / 128.0f) + NORM_EPS);
                const float y1 = x1 * rs * qg1, y2 = x2 * rs * qg2;
                bf16_t* q = Q + (size_t)row * 1024 + h * 128; q[lane] = f2bf(y1 * cs - y2 * sn); q[64 + lane] = f2bf(y1 * sn + y2 * cs); }
        }
        const size_t kvoff = ((size_t)b * SKV + pos) * 256;
#pragma unroll
        for (int kh = 0; kh < 2; ++kh) { const float x1 = RB(1024 + kh * 128 + lane), x2 = RB(1024 + kh * 128 + 64 + lane);
            const float ss = wave_sum(x1 * x1 + x2 * x2); const float rs = rsqrtf(ss * (1.0f / 128.0f) + NORM_EPS);
            const float y1 = x1 * rs * kg1, y2 = x2 * rs * kg2;
            bf16_t* k = Kb + kvoff + kh * 128; k[lane] = f2bf(y1 * cs - y2 * sn); k[64 + lane] = f2bf(y1 * sn + y2 * cs);
            bf16_t* v = Vb + kvoff + kh * 128; v[lane] = r[1280 + kh * 128 + lane]; v[64 + lane] = r[1280 + kh * 128 + 64 + lane]; }
#undef RB
    }
}

constexpr int KF = 2304;
__device__ __forceinline__ void fold_phase(const bf16_t* H, bf16_t* Z, bf16_t* DFTL, int gw, int ngw, int lane) {
    for (int zr = gw; zr < NBATCH * ZJ; zr += ngw) {
        const int b = zr / ZJ, j = zr % ZJ;
        int n1 = -1, n2 = -1; float sgn = 1.f;
        if (j < 2048) { n1 = j; if (j > 0) n2 = SEQ - j; }
        else if (j == 2048) { n1 = 2048; }
        else if (j >= KF) { const int n = j - KF; if (n > 0) { n1 = n; n2 = SEQ - n; sgn = -1.f; } }
#pragma unroll
        for (int q = 0; q < 2; ++q) {
            const int col = 8 * lane + 512 * q; unsigned z0; asm volatile("v_mov_b32 %0, 0" : "=v"(z0)); u32x4 o = (u32x4){z0, z0, z0, z0};
            if (n1 >= 0) {
                const u32x4 a = *(const u32x4*)(H + ((size_t)b * SEQ + n1) * DM + col);
                if (n2 >= 0) { const u32x4 c = *(const u32x4*)(H + ((size_t)b * SEQ + n2) * DM + col);
#pragma unroll
                    for (int e = 0; e < 4; ++e) o[e] = cvt_pk_bf16(bflo(a[e]) + sgn * bflo(c[e]), bfhi(a[e]) + sgn * bfhi(c[e])); }
                else o = a;
            }
            *(u32x4*)(Z + (size_t)zr * DM + col) = o;
        }
    }
    for (int k = gw; k < SEQ / 2; k += ngw) {
        for (int jb = lane; jb < ZJ / 8; jb += 64) {
            float v[8];
#pragma unroll
            for (int e = 0; e < 8; ++e) { const int j = jb * 8 + e; float val;
                if (j < 2048) val = __builtin_amdgcn_cosf((float)((k * j) & 4095) * (1.0f / 4096.0f));
                else if (j == 2048) val = (k & 1) ? -1.f : 1.f;
                else if (j < KF) val = 0.f;
                else val = __builtin_amdgcn_sinf((float)((k * (j - KF)) & 4095) * (1.0f / 4096.0f));
                v[e] = val; }
            u32x4 o; o.x = cvt_pk_bf16(v[0], v[1]); o.y = cvt_pk_bf16(v[2], v[3]); o.z = cvt_pk_bf16(v[4], v[5]); o.w = cvt_pk_bf16(v[6], v[7]);
            *(u32x4*)(DFTL + (size_t)k * ZJ + jb * 8) = o;
        }
    }
}
__device__ __forceinline__ void combine_phase(const bf16_t* PAB, const bf16_t* RTp, bf16_t* Yf, int gw, int ngw, int lane) {
    const float sc = 1.0f / 1024.0f;
    for (int r = gw; r < NBATCH * 2048; r += ngw) {
        const int b = r >> 11, k = r & 2047;
        const bf16_t* pa = PAB + ((size_t)(b * 2 + 0) * 2048 + k) * DM; const bf16_t* pb = PAB + ((size_t)(b * 2 + 1) * 2048 + k) * DM;
        bf16_t* y0 = Yf + ((size_t)b * SEQ + k) * DM; bf16_t* y1 = Yf + ((size_t)b * SEQ + (SEQ - k)) * DM;
#pragma unroll
        for (int q = 0; q < 2; ++q) { const int col = 8 * lane + 512 * q;
            const u32x4 a = *(const u32x4*)(pa + col), c = *(const u32x4*)(pb + col); u32x4 om, op;
#pragma unroll
            for (int e = 0; e < 4; ++e) { const float a0 = bflo(a[e]), a1 = bfhi(a[e]), c0 = bflo(c[e]), c1 = bfhi(c[e]);
                om[e] = cvt_pk_bf16((a0 - c0) * sc, (a1 - c1) * sc); op[e] = cvt_pk_bf16((a0 + c0) * sc, (a1 + c1) * sc); }
            *(u32x4*)(y0 + col) = om; if (k > 0) *(u32x4*)(y1 + col) = op; }
    }
    for (int t = gw; t < NBATCH * 1024; t += ngw) {
        const int b = t >> 10, m = t & 1023; const bf16_t* rr = RTp + ((size_t)b * 1024 + m) * ZJ; float s = 0.f;
#pragma unroll
        for (int c4 = 0; c4 < 4; ++c4) { const u32x4 w = *(const u32x4*)(rr + (c4 * 64 + lane) * 8);
#pragma unroll
            for (int e = 0; e < 4; ++e) s += bflo(w[e]) - bfhi(w[e]); }
        s = wave_sum(s);
        if (lane == 0) { const float ny = __uint_as_float((unsigned)rr[2048] << 16); Yf[((size_t)b * SEQ + 2048) * DM + m] = f2bf((s + ny) * sc); }
    }
}

__device__ __forceinline__ void spatial_phase(LAS unsigned char* lds, bf16_t* BIGp, const float* stats, const bf16_t* aws, const float* ln_g, const float* b_s, int nchunks, const int tid) {
    const int wid = tid >> 6, lane = tid & 63, fr = lane & 15, fq = lane >> 4;
    constexpr int LDP = 136;
    LAS bf16_t* Wl = (LAS bf16_t*)lds;
    LAS bf16_t* Vt = (LAS bf16_t*)(lds + 128 * LDP * 2);
    LAS float* St = (LAS float*)(lds + (128 + 256) * LDP * 2);
    const int G = gridDim.x, c = blockIdx.x;
    const bool fixed_g = (G % 8) == 0;
    const int per_g = fixed_g ? G / 8 : 1;
    int gcur = -1;
    bf16x8 af[4]; float bias = 0.f;
    for (int i = 0; ; ++i) {
        int ch, g;
        if (fixed_g) { g = c & 7; ch = (c >> 3) + per_g * i; if (ch >= nchunks) break; }
        else { const int u = c + G * i; if (u >= nchunks * 8) break; ch = u >> 3; g = u & 7; }
        u32x4 vw[8];
#pragma unroll
        for (int it = 0; it < 8; ++it) { const int id = it * 512 + tid, ql = id & 15, cb = (id >> 4) & 31, q = (id >> 9) * 16 + ql;
            vw[it] = *(const u32x4*)(BIGp + (size_t)(ch * 128 + q) * 4096 + 2048 + g * 256 + cb * 8); }
        const int prow = ch * 128 + 16 * wid + fr;
        bf16_t* const ubase = BIGp + (size_t)prow * 4096 + g * 256 + 8 * fq;
        u32x4 uw[8];
#pragma unroll
        for (int j = 0; j < 8; ++j) uw[j] = *(const u32x4*)(ubase + 32 * j);
        if (g != gcur) {
#pragma unroll
            for (int it = 0; it < 4; ++it) { const int id = it * 512 + tid, p = id >> 4, kc = id & 15;
                *(LAS u32x4*)(Wl + p * LDP + kc * 8) = *(const u32x4*)(aws + ((size_t)g * 128 + p) * 128 + kc * 8); }
        }
        if (tid < 128) { const float* sp = stats + (size_t)(ch * 128 + tid) * 64; float a = 0.f, q = 0.f;
#pragma unroll
            for (int k2 = 0; k2 < 32; ++k2) { a += sp[2 * k2]; q += sp[2 * k2 + 1]; }
            const float mu = a * (1.0f / 2048.0f); const float var = q * (1.0f / 2048.0f) - mu * mu;
            St[2 * tid] = mu; St[2 * tid + 1] = rsqrtf(fmaxf(var, 0.f) + LN_EPS); }
        __syncthreads();
        if (g != gcur) {
#pragma unroll
            for (int ks = 0; ks < 4; ++ks) af[ks] = *(const LAS bf16x8*)(Wl + (16 * wid + fr) * LDP + 32 * ks + 8 * fq);
            bias = b_s[g * 128 + 16 * wid + fr]; gcur = g;
        }
#pragma unroll
        for (int it = 0; it < 8; ++it) { const int id = it * 512 + tid, ql = id & 15, cb = (id >> 4) & 31, q = (id >> 9) * 16 + ql, c0 = cb * 8;
            const u32x4 w = vw[it];
            const float mu = St[2 * q], rs = St[2 * q + 1];
            const f32x4 g0 = *(const f32x4*)(ln_g + g * 256 + c0), g1 = *(const f32x4*)(ln_g + g * 256 + c0 + 4);
            const float v[8] = {bflo(w.x), bfhi(w.x), bflo(w.y), bfhi(w.y), bflo(w.z), bfhi(w.z), bflo(w.w), bfhi(w.w)};
#pragma unroll
            for (int e = 0; e < 8; ++e) { const float gg = e < 4 ? g0[e] : g1[e - 4]; Vt[(c0 + e) * LDP + q] = f2bf((v[e] - mu) * rs * gg); } }
        __syncthreads();
#pragma unroll
        for (int j = 0; j < 8; ++j) {
            f32x4 a0 = (f32x4){0.f, 0.f, 0.f, 0.f}, a1 = a0;
            const int cr = 32 * j + 8 * (fr >> 2) + (fr & 3);
#pragma unroll
            for (int ks = 0; ks < 4; ++ks) {
                const bf16x8 b0 = *(const LAS bf16x8*)(Vt + cr * LDP + 32 * ks + 8 * fq), b1 = *(const LAS bf16x8*)(Vt + (cr + 4) * LDP + 32 * ks + 8 * fq);
                a0 = __builtin_amdgcn_mfma_f32_16x16x32_bf16(b0, af[ks], a0, 0, 0, 0); a1 = __builtin_amdgcn_mfma_f32_16x16x32_bf16(b1, af[ks], a1, 0, 0, 0); }
            const u32x4 u4 = uw[j];
            u32x4 o;
            o.x = cvt_pk_bf16(bflo(u4.x) * (a0[0] + bias), bfhi(u4.x) * (a0[1] + bias)); o.y = cvt_pk_bf16(bflo(u4.y) * (a0[2] + bias), bfhi(u4.y) * (a0[3] + bias));
            o.z = cvt_pk_bf16(bflo(u4.z) * (a1[0] + bias), bfhi(u4.z) * (a1[1] + bias)); o.w = cvt_pk_bf16(bflo(u4.w) * (a1[2] + bias), bfhi(u4.w) * (a1[3] + bias));
            *(u32x4*)(ubase + 32 * j) = o;
        }
        __syncthreads();
    }
}

template <bool QKPERM> __device__ __forceinline__ void p0_transpose_item(const float* W, int K, int N, bf16_t* WT, LAS float* scr, int item, int lane) {
    const int nblk = N / 32, kb = item / nblk, nb = item % nblk, k0 = 64 * kb, n0 = 32 * nb;
    {
        const int kr = lane >> 3, nc = (lane & 7) * 4; f32x4 v[8];
        int src = n0 + nc;
        if (QKPERM && src < 1280) { const int p = src & 127; src = (src & ~127) + 16 * (p >> 5) + 4 * ((p >> 3) & 3) + 64 * ((p >> 2) & 1); }
#pragma unroll
        for (int i = 0; i < 8; ++i) v[i] = *(const f32x4*)(W + (size_t)(k0 + 8 * i + kr) * N + src);
#pragma unroll
        for (int i = 0; i < 8; ++i) {
#pragma unroll
            for (int e = 0; e < 4; ++e) scr[(8 * i + kr) * 33 + nc + e] = v[i][e]; }
    }
    asm volatile("s_waitcnt lgkmcnt(0)" ::: "memory");
    const int c = lane & 7;
#pragma unroll
    for (int j = 0; j < 4; ++j) { const int n = (lane >> 3) + 8 * j; const LAS float* s = scr + (8 * c) * 33 + n;
        u32x4 o; o.x = cvt_pk_bf16(s[0 * 33], s[1 * 33]); o.y = cvt_pk_bf16(s[2 * 33], s[3 * 33]); o.z = cvt_pk_bf16(s[4 * 33], s[5 * 33]); o.w = cvt_pk_bf16(s[6 * 33], s[7 * 33]);
        *(u32x4*)(WT + (size_t)(n0 + n) * K + k0 + 8 * c) = o; }
    asm volatile("s_waitcnt lgkmcnt(0)" ::: "memory");
}

struct Params { const float* in[19]; float* out; unsigned char* ws; int ph_lo, ph_hi; };
constexpr int LDS_PAR_OFF = 131072, LDS_BARST_OFF = 131072 + 256, LDS_JOB_OFF = 131072 + 320;
struct PView {
    LAS const unsigned char* base;
    __device__ __forceinline__ const float* in(int i) const { return pg8::jptr<const float>(base + 8 * i); }
    __device__ __forceinline__ float* out() const { return pg8::jptr<float>(base + 8 * 19); }
    __device__ __forceinline__ unsigned char* wsp() const { return pg8::jptr<unsigned char>(base + 8 * 20); }
};

__device__ __forceinline__ void prologue_phase(const PView& P, LAS unsigned char* lds, const int tid) {
    const int wid = tid >> 6, lane = tid & 63;
    unsigned char* ws = P.wsp();
    {
        LAS float* sl = (LAS float*)lds;
        LAS float* red = (LAS float*)(lds + 36864);
        float* MOD = (float*)(ws + WS_MOD);
        for (int item = blockIdx.x; item < 192; item += gridDim.x) {
            const int layer = item / 48, col0 = (item % 48) * 128;
            for (int idx = tid; idx < 9216; idx += 512) { const int r = idx >> 10, k = idx & 1023; const float v = r < 8 ? P.in(1)[r * 1024 + k] : P.in(3)[k]; sl[idx] = v / (1.0f + __expf(-v)); }
            __syncthreads();
            const int ks = tid >> 5, c4 = tid & 31;
            const float* w = P.in(4) + ((size_t)layer * 1024 + ks * 64) * 6144 + col0 + c4 * 4;
            f32x4 acc[9];
#pragma unroll
            for (int r = 0; r < 9; ++r) acc[r] = (f32x4){0.f, 0.f, 0.f, 0.f};
#pragma unroll 16
            for (int kk = 0; kk < 64; ++kk) { const f32x4 wv = *(const f32x4*)(w + (size_t)kk * 6144);
#pragma unroll
                for (int r = 0; r < 9; ++r) acc[r] = acc[r] + wv * sl[r * 1024 + ks * 64 + kk]; }
#pragma unroll
            for (int r = 0; r < 9; ++r) *(LAS f32x4*)(red + (ks * 9 + r) * 128 + c4 * 4) = acc[r];
            __syncthreads();
            for (int idx = tid; idx < 9 * 128; idx += 512) { const int r = idx >> 7, cc = idx & 127; float s = P.in(5)[layer * 6144 + col0 + cc];
#pragma unroll
                for (int k2 = 0; k2 < 16; ++k2) s += red[(k2 * 9 + r) * 128 + cc];
                MOD[(size_t)(layer * 9 + r) * 6144 + col0 + cc] = s; }
            __syncthreads();
        }
    }
    {
        LAS float* scr = (LAS float*)(lds + wid * 8448);
        const int gw = blockIdx.x * 8 + wid, ngw = gridDim.x * 8;
        constexpr int I_W1 = 16 * 128, I_W2 = 64 * 32, I_AIN = 16 * 128, I_AOUT = 32 * 32, I_BO = 16 * 32, I_QKV = 16 * 48, I_WO = 16 * 32;
        constexpr int NITEMS = 4 * I_W1 + 4 * I_W2 + 2 * I_AIN + 2 * I_AOUT + I_BO + I_QKV + I_WO;
        for (int it = gw; it < NITEMS; it += ngw) {
            int r = it;
            if (r < 4 * I_W1) { const int l = r / I_W1; p0_transpose_item<false>(P.in(7) + (size_t)l * 1024 * 4096, 1024, 4096, (bf16_t*)(ws + WS_W1T) + (size_t)l * 4096 * 1024, scr, r % I_W1, lane); continue; } r -= 4 * I_W1;
            if (r < 4 * I_W2) { const int l = r / I_W2; p0_transpose_item<false>(P.in(8) + (size_t)l * 4096 * 1024, 4096, 1024, (bf16_t*)(ws + WS_W2T) + (size_t)l * 1024 * 4096, scr, r % I_W2, lane); continue; } r -= 4 * I_W2;
            if (r < 2 * I_AIN) { const int l = r / I_AIN; p0_transpose_item<false>(P.in(9) + (size_t)l * 1024 * 4096, 1024, 4096, (bf16_t*)(ws + WS_AWINT) + (size_t)l * 4096 * 1024, scr, r % I_AIN, lane); continue; } r -= 2 * I_AIN;
            if (r < 2 * I_AOUT) { const int l = r / I_AOUT; p0_transpose_item<false>(P.in(13) + (size_t)l * 2048 * 1024, 2048, 1024, (bf16_t*)(ws + WS_AWOUTT) + (size_t)l * 1024 * 2048, scr, r % I_AOUT, lane); continue; } r -= 2 * I_AOUT;
            if (r < I_BO) { p0_transpose_item<false>(P.in(14), 1024, 1024, (bf16_t*)(ws + WS_BWOUTT), scr, r, lane); continue; } r -= I_BO;
            if (r < I_QKV) { p0_transpose_item<false>(P.in(15), 1024, 1536, (bf16_t*)(ws + WS_QKVT), scr, r, lane); continue; } r -= I_QKV;
            p0_transpose_item<false>(P.in(18), 1024, 1024, (bf16_t*)(ws + WS_WOT), scr, r, lane);
        }
    }
    {
        const int gt = blockIdx.x * 512 + tid, ngt = gridDim.x * 512;
        bf16_t* aws = (bf16_t*)(ws + WS_AWS);
        for (int i = gt; i < 2 * 8 * 128 * 128 / 8; i += ngt) { const f32x4 a = *(const f32x4*)(P.in(11) + (size_t)i * 8), b = *(const f32x4*)(P.in(11) + (size_t)i * 8 + 4);
            u32x4 o; o.x = cvt_pk_bf16(a[0], a[1]); o.y = cvt_pk_bf16(a[2], a[3]); o.z = cvt_pk_bf16(b[0], b[1]); o.w = cvt_pk_bf16(b[2], b[3]); *(u32x4*)(aws + (size_t)i * 8) = o; }
        bf16_t* cc = (bf16_t*)(ws + WS_CC); bf16_t* scm = (bf16_t*)(ws + WS_SC); bf16_t* dc = (bf16_t*)(ws + WS_DFTC);
        for (int i = gt; i < 65536; i += ngt) { const int m = i >> 8, c = i & 255; const float rev = (float)((m * c) & 255) * (1.0f / 256.0f);
            cc[i] = f2bf(__builtin_amdgcn_cosf(rev)); scm[i] = f2bf(__builtin_amdgcn_sinf(rev)); }
        for (int i = gt; i < 131072; i += ngt) { const int k = i >> 9, j = i & 511; const int n = j & 255; const float rev = (float)((k * n) & 255) * (1.0f / 256.0f);
            dc[i] = f2bf(j < 256 ? __builtin_amdgcn_cosf(rev) : -__builtin_amdgcn_sinf(rev)); }
    }
}


#define XB_TMO      128
#define XB_XCNT(j)  (256  + 64 * (j))
#define XB_XSUB(j)  (1280 + 64 * (j))
#define XB_XGEN(j)  (2304 + 64 * (j))
#define XB_TOP      3328
#define XB_TOPGEN   3392
#define XCD_BAR_WORDS 3456
#define XB_SPIN_CAP (1u << 18)
__device__ __forceinline__ unsigned xb_ld(unsigned* p)              { return __hip_atomic_load(p, __ATOMIC_RELAXED, __HIP_MEMORY_SCOPE_AGENT); }
__device__ __forceinline__ unsigned xb_add(unsigned* p, unsigned v) { return __hip_atomic_fetch_add(p, v, __ATOMIC_RELAXED, __HIP_MEMORY_SCOPE_AGENT); }
__device__ __forceinline__ unsigned xb_xcc_id() { return (unsigned)__builtin_amdgcn_s_getreg((3 << 11) | 20) & 0xFu; }
#define XB_SPIN(cond, bar) do { unsigned _sp = 0; while (cond) { __builtin_amdgcn_s_sleep(1); \
    if ((++_sp & 255u) == 0u) { if (xb_ld(&(bar)[XB_TMO])) break; if (_sp > XB_SPIN_CAP) { atomicAdd(&(bar)[XB_TMO], 1u); break; } } } } while (0)
struct XcdBarrier { unsigned* bar; unsigned x; volatile LAS unsigned* st; };
__device__ __forceinline__ XcdBarrier xcd_barrier_post(unsigned* bar, volatile LAS unsigned* st) {
    XcdBarrier b; b.bar = bar; b.x = xb_xcc_id(); b.st = st;
    if (threadIdx.x == 0) (void)xb_add(&bar[XB_XCNT(b.x)], 1u);
    return b;
}
__device__ __forceinline__ void xcd_barrier_complete(unsigned* bar, unsigned x, unsigned& nloc, unsigned& nx) {
    const unsigned G = gridDim.x * gridDim.y * gridDim.z;
    unsigned sum, cnt, mine, sp = 0u;
    for (;;) {
        sum = 0u; cnt = 0u; mine = 0u;
#pragma unroll
        for (unsigned j = 0; j < 16; ++j) { const unsigned c = xb_ld(&bar[XB_XCNT(j)]); sum += c; cnt += (c > 0u) ? 1u : 0u; mine = (j == x) ? c : mine; }
        if (sum == G) break;
        __builtin_amdgcn_s_sleep(1);
        if ((++sp & 255u) == 0u) { if (xb_ld(&bar[XB_TMO])) break; if (sp > XB_SPIN_CAP) { atomicAdd(&bar[XB_TMO], 1u); break; } }
    }
    nloc = mine > 0u ? mine : 1u; nx = cnt > 0u ? cnt : 1u;
}
__device__ __forceinline__ void xcd_barrier(const XcdBarrier& b) {
    asm volatile("s_waitcnt vmcnt(0)" ::: "memory");
    __syncthreads();
    if (threadIdx.x == 0) {
        unsigned* bar = b.bar;
        __builtin_amdgcn_s_waitcnt(0);
        unsigned nloc = b.st[0], nx = b.st[1];
        if (nloc == 0u) { xcd_barrier_complete(bar, b.x, nloc, nx); b.st[0] = nloc; b.st[1] = nx; }
        const unsigned old = xb_add(&bar[XB_XSUB(b.x)], 1u);
        const unsigned gen = old / nloc;
        if (old + 1u == (gen + 1u) * nloc) {
            __builtin_amdgcn_fence(__ATOMIC_RELEASE, "agent");
            asm volatile("s_waitcnt vmcnt(0)" ::: "memory");
            const unsigned og = xb_add(&bar[XB_TOP], 1u);
            const unsigned tg = og / nx;
            if (og + 1u == (tg + 1u) * nx) xb_add(&bar[XB_TOPGEN], 1u);
            else XB_SPIN(xb_ld(&bar[XB_TOPGEN]) == tg, bar);
            __builtin_amdgcn_fence(__ATOMIC_ACQUIRE, "agent");
            xb_add(&bar[XB_XGEN(b.x)], 1u);
            asm volatile("s_waitcnt vmcnt(0)" ::: "memory");
        } else {
            XB_SPIN(xb_ld(&bar[XB_XGEN(b.x)]) == gen, bar);
            __builtin_amdgcn_fence(__ATOMIC_ACQUIRE, "agent");
            asm volatile("s_waitcnt vmcnt(0)" ::: "memory");
        }
    }
    __syncthreads();
}

enum { K_PRO = 0, K_ROW, K_GEMM, K_SPATIAL, K_FOLD, K_QKVPOST, K_ATTN, K_NONE };
constexpr int NPH = 34;

__device__ __forceinline__ GJob mkgemm(const bf16_t* A, int lda, const bf16_t* B, int ldb, void* C, int ldc, int M, int N, int K, int act, int out_f32) {
    int z; asm volatile("v_mov_b32 %0, 0" : "=v"(z));
    GJob g; g.A = A; g.A2 = A; g.a2mask = (unsigned)z; g.lda = lda; g.B = B; g.b_bs_hi = z; g.b_bs_lo = z; g.bdiv = 1; g.b_pn_mod = 1 << 20; g.ldb = ldb;
    g.C = C; g.c_bs = z; g.ldc = ldc; g.out_f32 = out_f32; g.act = act; g.scale = 1.0f; g.stats = (float*)(size_t)z; g.stats_pn0 = z; g.nM = M / 256; g.nN = N / 256; g.nB = 1; g.K = K; g.part = (float*)(size_t)z; g.split_pm0 = 1 << 20; g.ksplit = 1; g.fused = z; g.has_next = z; g.gate_off = z; g.shift_off = z; g.scale_off = z; g.x_mode = z;
    g.xsrc = (const float*)(size_t)z; g.xdst = (float*)(size_t)z; g.Hout = (bf16_t*)(size_t)z; g.gn_post = g.xsrc; g.gn_next = g.xsrc; g.modL = g.xsrc; g.modN = g.xsrc; g.slot1 = (unsigned*)(size_t)z; g.slot2 = g.slot1; g.cnt1 = g.slot1; g.cnt2 = g.slot1; g.kf = z; g.dry = z; g.Kd = g.Hout; g.Vd = g.Hout; g.qg = g.xsrc; g.kg = g.xsrc; return g;
}
__device__ __forceinline__ RowJob mkrow(const PView& P, int layer, int which, int nrows, const bf16_t* Y, bf16_t* H) {
    unsigned char* ws = P.wsp();
    const float* norm_g = P.in(6); const float* MOD = (const float*)(ws + WS_MOD); float* out = P.out(); float* XC = (float*)((unsigned char*)out + OUT_XC);
    RowJob r; r.row0 = (which != 0) ? RL : 0; r.nrows = nrows; r.has_y = which != 0; r.ldy = DM; r.Y = Y; r.H = H;
    r.ypart = (which != 0 && layer <= 1) ? (const float*)((unsigned char*)out + OUT_PART) : nullptr;
    r.x16 = (which == 0) ? (bf16_t*)(ws + WS_X16) : nullptr;
    r.modL = MOD + (size_t)layer * 9 * 6144; r.gn_post = norm_g + (layer * 4 + (which == 1 ? 1 : 3)) * DM; r.gate_off = (which == 1 ? 2 : 5) * DM;
    const bool first = (layer == 0 && which <= 1);
    r.xsrc_lat = first ? P.in(0) : out; r.xsrc_ctx = first ? P.in(2) : XC; r.xdst_lat = out; r.xdst_ctx = XC;
    if (which == 0) { r.has_next = 1; r.gn_next = norm_g + (layer * 4 + 0) * DM; r.modN = r.modL; r.shift_off = 0; r.scale_off = DM; }
    else if (which == 1) { r.has_next = 1; r.gn_next = norm_g + (layer * 4 + 2) * DM; r.modN = r.modL; r.shift_off = 3 * DM; r.scale_off = 4 * DM; }
    else { r.has_next = layer < 3; const int nl = layer < 3 ? layer + 1 : layer; r.gn_next = norm_g + (nl * 4 + 0) * DM; r.modN = MOD + (size_t)nl * 9 * 6144; r.shift_off = 0; r.scale_off = DM; }
    return r;
}

__device__ __forceinline__ void phase_info(int ph, int& kind, int& sync, int& a, int& rows) {
    kind = K_GEMM; sync = 1; a = 0; rows = RT;
    switch (ph) {
        case 0: kind = K_PRO; break;
        case 1: kind = K_ROW; a = 0; break;
        case 3: kind = K_SPATIAL; a = 0; rows = RT; break;
        case 28: kind = K_SPATIAL; a = 1; rows = RL; break;
        case 5: kind = K_ROW; a = 1; break;
        case 8: kind = K_ROW; a = 2; sync = 0; break;
        case 9: kind = K_FOLD; break;
        case 10: sync = 0; break;
        case 12: sync = 0; break;
        case 15: kind = K_ROW; a = 3; break;
        case 18: kind = K_ROW; a = 4; break;
        case 20: kind = K_QKVPOST; break;
        case 21: kind = K_ATTN; break;
        case 23: case 26: case 30: case 33: kind = K_NONE; sync = 0; break;
        case 32: sync = 0; break;
        default: break;
    }
}
__device__ __forceinline__ GJob gemm_job(int ph, const PView& P) {
    unsigned char* ws = P.wsp();
    bf16_t* YH = (bf16_t*)(ws + WS_YH); unsigned char* BIG = ws + WS_BIG; bf16_t* BIGb = (bf16_t*)BIG; float* STATS = (float*)((unsigned char*)P.out() + OUT_STATS);
    GJob g = mkgemm(YH, DM, YH, DM, YH, DM, 256, 256, 256, 0, 0);
    int up_layer = -1, down_layer = -1, rows = RT;
    switch (ph) {
        case 2: case 27: { const int j = ph == 2 ? 0 : 1; rows = ph == 2 ? RT : RL;
            g = mkgemm(YH, DM, (const bf16_t*)(ws + WS_AWINT) + (size_t)j * 4096 * 1024, DM, BIGb, 4096, rows, 4096, 1024, 1, 0); g.stats = STATS; g.stats_pn0 = 8; break; }
        case 4: case 29: { const int j = ph == 4 ? 0 : 1; rows = ph == 4 ? RT : RL;
            g = mkgemm(BIGb, 4096, (const bf16_t*)(ws + WS_AWOUTT) + (size_t)j * 1024 * 2048, 2048, YH, DM, rows, 1024, 2048, 0, 0); break; }
        case 6: up_layer = 0; rows = RT; break;
        case 7: down_layer = 0; rows = RT; break;
        case 16: up_layer = 1; rows = RT; break;
        case 17: down_layer = 1; rows = RT; break;
        case 24: up_layer = 2; rows = RL; break;
        case 25: down_layer = 2; rows = RL; break;
        case 31: up_layer = 3; rows = RL; break;
        case 32: down_layer = 3; rows = RL; break;
        case 10: { g = mkgemm((const bf16_t*)(ws + WS_CC), 256, (const bf16_t*)(BIG + BIG_Z), DM, BIG + BIG_RT, ZJ, 256, ZJ, 256, 0, 0);
            g.A2 = (const bf16_t*)(ws + WS_SC); g.a2mask = 0x1FE00u; g.nB = 32; g.bdiv = 4; g.b_bs_hi = ZJ * DM; g.b_bs_lo = 256; g.c_bs = 256 * ZJ; break; }
        case 11: { g = mkgemm((const bf16_t*)(ws + WS_CC), 256, YH + (size_t)RL * DM, DM, BIG + BIG_RTC, 512, 256, 512, 256, 0, 0);
            g.A2 = (const bf16_t*)(ws + WS_SC); g.a2mask = 0x2u; g.nB = 32; g.bdiv = 4; g.b_bs_hi = CTXL * DM; g.b_bs_lo = 256; g.b_pn_mod = 1; g.c_bs = 256 * 512; break; }
        case 12: { g = mkgemm((const bf16_t*)(BIG + BIG_DFTL), ZJ, (const bf16_t*)(BIG + BIG_RT), ZJ, BIG + BIG_Y2, DM, SEQ / 2, 1024, ZJ, 0, 0);
            g.nB = 16; g.bdiv = 2; g.b_bs_hi = 1024 * ZJ; g.b_bs_lo = KF; g.c_bs = (SEQ / 2) * DM; g.kf = KF; break; }
        case 13: { g = mkgemm((const bf16_t*)(ws + WS_DFTC), 512, (const bf16_t*)(BIG + BIG_RTC), 512, YH + (size_t)RL * DM, DM, CTXL, 1024, 512, 0, 0);
            g.nB = 8; g.b_bs_hi = 1024 * 512; g.c_bs = CTXL * DM; g.scale = 1.0f / 256.0f; break; }
        case 14: g = mkgemm(YH, DM, (const bf16_t*)(ws + WS_BWOUTT), DM, BIG + BIG_Y2, DM, RT, 1024, 1024, 0, 0); break;
        case 19: g = mkgemm(YH, DM, (const bf16_t*)(ws + WS_QKVT), DM, BIG + BIG_RAW, 1536, RT, 1536, 1024, 0, 0); break;
        case 22: g = mkgemm((const bf16_t*)(BIG + BIG_O), DM, (const bf16_t*)(ws + WS_WOT), DM, YH, DM, RL, 1024, 1024, 0, 0); break;
        default: break;
    }
    if (down_layer >= 0 && rows == RT) {   }
    if (up_layer >= 0) g = mkgemm(YH, DM, (const bf16_t*)(ws + WS_W1T) + (size_t)up_layer * 4096 * 1024, DM, BIGb, 4096, rows, 4096, 1024, 2, 0);
    if (down_layer >= 0) g = mkgemm(BIGb, 4096, (const bf16_t*)(ws + WS_W2T) + (size_t)down_layer * 1024 * 4096, 4096, YH, DM, rows, 1024, 4096, 0, 0);
    if (ph == 4 || ph == 7 || ph == 14 || ph == 17) { g.part = (float*)((unsigned char*)P.out() + OUT_PART); g.split_pm0 = RL / 256; g.ksplit = 4; }
    {
        int layer = -1, which = 0;
        switch (ph) { case 4: layer = 0; which = 1; break; case 7: layer = 0; which = 2; break; case 14: layer = 1; which = 1; break; case 17: layer = 1; which = 2; break;
                      case 22: layer = 2; which = 1; break; case 25: layer = 2; which = 2; break; case 29: layer = 3; which = 1; break; case 32: layer = 3; which = 2; break; default: break; }
        if (layer >= 0) {
            const float* norm_g = P.in(6); const float* MOD = (const float*)(ws + WS_MOD); float* out = P.out();
            g.fused = 1; g.modL = MOD + (size_t)layer * 9 * 6144; g.gn_post = norm_g + (layer * 4 + (which == 1 ? 1 : 3)) * DM; g.gate_off = (which == 1 ? 2 : 5) * DM;
            const bool firstu = (layer == 0 && which == 1), lastu = (layer == 3 && which == 2);
            g.xsrc = (const float*)(ws + WS_X16); g.xdst = lastu ? out : (float*)(ws + WS_X16); g.x_mode = (lastu ? 2 : 0); g.Hout = YH; (void)firstu;
            if (which == 1) { g.has_next = 1; g.gn_next = norm_g + (layer * 4 + 2) * DM; g.modN = g.modL; g.shift_off = 3 * DM; g.scale_off = 4 * DM; }
            else { g.has_next = layer < 3; const int nl = layer < 3 ? layer + 1 : layer; g.gn_next = norm_g + (nl * 4 + 0) * DM; g.modN = MOD + (size_t)nl * 9 * 6144; g.shift_off = 0; g.scale_off = DM; }
            g.slot1 = (unsigned*)(ws + WS_XS1); g.slot2 = (unsigned*)(ws + WS_XS2);
            g.cnt1 = (unsigned*)(ws + WS_CNT) + (size_t)(ph * 2 + 0) * 136 * 64; g.cnt2 = (unsigned*)(ws + WS_CNT) + (size_t)(ph * 2 + 1) * 136 * 64;
        }
    }
    return g;
}

__global__ void __launch_bounds__(512) mega_fwd(Params Pk) {
    extern __shared__ __attribute__((aligned(16))) unsigned char lds_raw[];
    cg::grid_group grid = cg::this_grid();
    LAS unsigned char* lds = (LAS unsigned char*)lds_raw;
    const int G = gridDim.x, cidx = blockIdx.x;
    {
        const int t0 = threadIdx.x;
        LAS unsigned long long* par = (LAS unsigned long long*)(lds + LDS_PAR_OFF);
        if (t0 < 19) par[t0] = (unsigned long long)Pk.in[t0];
        if (t0 == 19) par[19] = (unsigned long long)Pk.out;
        if (t0 == 20) par[20] = (unsigned long long)Pk.ws;
        if (t0 == 21) { ((LAS unsigned*)(lds + LDS_BARST_OFF))[0] = 0u; ((LAS unsigned*)(lds + LDS_BARST_OFF))[1] = 0u; }
    }
    __syncthreads();
    if ((Pk.ph_hi - Pk.ph_lo) > 1) (void)xcd_barrier_post((unsigned*)(Pk.ws + WS_BAR), (volatile LAS unsigned*)(lds + LDS_BARST_OFF));
    PView P; P.base = lds + LDS_PAR_OFF;
    LAS GJob* jl = (LAS GJob*)(lds + LDS_JOB_OFF);

    const int ph_lo = Pk.ph_lo, ph_hi = Pk.ph_hi;
    int replayed = 0;
    for (int ph = ph_lo; ph < ph_hi; ++ph) {
        int tid = threadIdx.x; asm volatile("" : "+v"(tid));
        const int wid = __builtin_amdgcn_readfirstlane(tid >> 6), lane = tid & 63;
        const int gw = cidx * 8 + wid, ngw = G * 8;
        int kind, sync, a, rows;
        phase_info(ph, kind, sync, a, rows);
        if (ph == 14 && !replayed && ph_lo == 0) {
            unsigned char* wsx = P.wsp();
            combine_phase((const bf16_t*)(wsx + WS_BIG + BIG_Y2), (const bf16_t*)(wsx + WS_BIG + BIG_RT), (bf16_t*)(wsx + WS_YH), gw, ngw, lane);
            XcdBarrier xbar; xbar.bar = (unsigned*)(wsx + WS_BAR); xbar.x = xb_xcc_id(); xbar.st = (volatile LAS unsigned*)(lds + LDS_BARST_OFF);
            xcd_barrier(xbar);
        }
        if (kind == K_GEMM) {
            if (tid == 0) { GJob g = gemm_job(ph, P); if (REPEAT_MASK != 0ULL && ((REPEAT_MASK >> ph) & 1ULL) && !replayed && DRY_ALL) g.dry = DRY_ALL; const int* src = (const int*)&g; LAS int* dst = (LAS int*)jl;
#pragma unroll
                for (int q = 0; q < (int)(sizeof(GJob) / 4); ++q) dst[q] = src[q]; }
            __syncthreads();
#ifndef NO_GEMM
            pg8::gemm_phase(lds, jl, G, cidx, tid);
#endif
        } else if (kind == K_ROW) {
            unsigned char* ws = P.wsp(); bf16_t* YH = (bf16_t*)(ws + WS_YH);
            const int layer = a == 0 ? 0 : (a - 1) >> 1, which = a == 0 ? 0 : ((a - 1) & 1) + 1;
            const bf16_t* Y = (a == 3) ? (const bf16_t*)(ws + WS_BIG + BIG_Y2) : YH;
            const int nr = (a == 4) ? RT : rows;
            const RowJob r = mkrow(P, layer, which, nr, Y, YH);
#ifndef NO_ROW
            row_phase(r, gw, ngw, lane);
#endif
        } else if (kind == K_PRO) {
#ifndef NO_PRO
            prologue_phase(P, lds, tid);
#endif
        } else if (kind == K_SPATIAL) {
            unsigned char* ws = P.wsp();
            spatial_phase(lds, (bf16_t*)(ws + WS_BIG), (const float*)((unsigned char*)P.out() + OUT_STATS), (const bf16_t*)(ws + WS_AWS) + (size_t)a * 8 * 128 * 128, P.in(10) + a * 2048, P.in(12) + a * 8 * 128, rows / 128, tid);
        } else if (kind == K_FOLD) {
            unsigned char* ws = P.wsp();
            fold_phase((const bf16_t*)(ws + WS_YH), (bf16_t*)(ws + WS_BIG + BIG_Z), (bf16_t*)(ws + WS_BIG + BIG_DFTL), gw, ngw, lane);
        } else if (kind == K_QKVPOST) {
            unsigned char* ws = P.wsp();
            qkvpost_phase((const bf16_t*)(ws + WS_BIG + BIG_RAW), P.in(16), P.in(17), (bf16_t*)(ws + WS_YH), (bf16_t*)(ws + WS_BIG + BIG_K), (bf16_t*)(ws + WS_BIG + BIG_V), gw, ngw, lane);
        } else if (kind == K_ATTN) {
            unsigned char* ws = P.wsp(); unsigned char* BIG = ws + WS_BIG; const bf16_t* YH = (const bf16_t*)(ws + WS_YH);
            const int xcd = cidx & 7, slot = cidx >> 3, per = G >> 3;
            for (int i = 0; ; ++i) {
                const int v = (G % 8 == 0) ? (i * G + xcd * per + slot) : (i * G + cidx);
                if (v >= 1024) break;
                const int qb = v & 15, hh = (v >> 4) & 3, kvh = (v >> 6) & 1, b = v >> 7, h = kvh * 4 + hh;
                const bf16_t* Qb = YH + ((size_t)b * SEQ + qb * 256) * 1024 + h * 128;
                const bf16_t* Kh = (const bf16_t*)(BIG + BIG_K) + (size_t)b * SKV * 256 + kvh * 128;
                const bf16_t* Vh = (const bf16_t*)(BIG + BIG_V) + (size_t)b * SKV * 256 + kvh * 128;
                bf16_t* Ob = (bf16_t*)(BIG + BIG_O) + ((size_t)b * SEQ + qb * 256) * 1024 + h * 128;
#ifndef NO_ATT
                att::attn_dense_body(Qb, Kh, Vh, Ob, SKV, (char*)lds_raw, tid);
#endif
                __syncthreads();
            }
        }
        if (REPEAT_MASK != 0ULL) { if (((REPEAT_MASK >> ph) & 1ULL) && !replayed) { replayed = 1; --ph; __syncthreads(); continue; } replayed = 0; }
        if (sync && ph + 1 < ph_hi) for (int srep = 0; srep < SYNC_REP; ++srep) {
            if (ph == 0) {
                asm volatile("s_waitcnt vmcnt(0) lgkmcnt(0)" ::: "memory");
                __syncthreads();
                if (wid == 0) { __builtin_amdgcn_fence(__ATOMIC_RELEASE, "agent"); asm volatile("s_waitcnt vmcnt(0) lgkmcnt(0)" ::: "memory"); }
                grid.sync();
                if (wid == 0) { __builtin_amdgcn_fence(__ATOMIC_ACQUIRE, "agent"); asm volatile("s_waitcnt vmcnt(0) lgkmcnt(0)" ::: "memory"); }
                __syncthreads();
            } else {
                XcdBarrier xbar; xbar.bar = (unsigned*)(P.wsp() + WS_BAR); xbar.x = xb_xcc_id(); xbar.st = (volatile LAS unsigned*)(lds + LDS_BARST_OFF);
                xcd_barrier(xbar);
            }
        }
    }
}


#ifdef STOP_PH
__global__ void __launch_bounds__(256) dump_kernel(const unsigned char* ws, float* out) {
    const bf16_t* YH = (const bf16_t*)(ws + WS_YH); const bf16_t* BIGb = (const bf16_t*)(ws + WS_BIG);
    for (size_t i = (size_t)blockIdx.x * 256 + threadIdx.x; i < (size_t)RL * DM; i += (size_t)gridDim.x * 256) {
        const size_t r = i >> 10, c = i & 1023;
        float v = __uint_as_float((unsigned)YH[i] << 16);
        for (int k = 0; k < 4; ++k) v += __uint_as_float((unsigned)BIGb[r * 4096 + c + 1024 * k] << 16);
        if (STOP_PH >= 6) v += out[i];
        out[i] = v;
    }
}
#endif
extern "C" void kernel_launch(void* const* d_in, const int* in_sizes, int n_in, void* d_out, int out_size, void* d_ws, size_t ws_size, hipStream_t stream) {
    static int grid = 0;
    if (grid == 0) {
        if (n_in != 19 || out_size != RL * DM || ws_size < WS_END) { fprintf(stderr, "kernel_launch: unexpected shapes (n_in %d out %d ws %zu, need ws >= %zu)\n", n_in, out_size, ws_size, (size_t)WS_END); grid = -1; return; }
        int dev = 0, cus = 0, per_cu = 0;
        (void)hipGetDevice(&dev);
        (void)hipDeviceGetAttribute(&cus, hipDeviceAttributeMultiprocessorCount, dev);
        if (hipFuncSetAttribute((const void*)mega_fwd, hipFuncAttributeMaxDynamicSharedMemorySize, LDS_BYTES) != hipSuccess) { fprintf(stderr, "kernel_launch: hipFuncSetAttribute failed\n"); grid = -1; return; }
        if (hipOccupancyMaxActiveBlocksPerMultiprocessor(&per_cu, (const void*)mega_fwd, 512, LDS_BYTES) != hipSuccess || per_cu < 1) { fprintf(stderr, "kernel_launch: occupancy query gave %d\n", per_cu); per_cu = 1; }
        (void)hipGetLastError();
        grid = cus * per_cu;
        fprintf(stderr, "kernel_launch: grid %d (cus %d x %d)\n", grid, cus, per_cu);
    }
    if (grid < 0) return;
    Params p{};
    for (int i = 0; i < 19; ++i) p.in[i] = (const float*)d_in[i];
    p.out = (float*)d_out; p.ws = (unsigned char*)d_ws;
#ifndef MK_MULTI
#define MK_MULTI 0
#endif
#if MK_MULTI
    static const int cuts[] = {0,1,2,3,4,5,6,7,8,9,10,12,14,15,16,17,18,19,20,21,22,23,24,25,26,27,28,29,30,31,32,33,34};
    hipError_t e = hipSuccess;
    for (int li = 0; li + 1 < (int)(sizeof(cuts) / sizeof(int)); ++li) {
        p.ph_lo = cuts[li]; p.ph_hi = cuts[li + 1];
#ifdef STOP_PH
        if (p.ph_hi > STOP_PH) break;
#endif
        hipLaunchKernelGGL(mega_fwd, dim3(grid), dim3(512), LDS_BYTES, stream, p);
    }
#ifdef STOP_PH
    hipLaunchKernelGGL(dump_kernel, dim3(2048), dim3(256), 0, stream, (const unsigned char*)d_ws, (float*)d_out);
#endif
    e = hipPeekAtLastError();
#else
    p.ph_lo = 0; p.ph_hi = NPH;
    (void)hipMemsetAsync((unsigned char*)d_ws + WS_CNT, 0, CNT_BYTES, stream);
    (void)hipMemsetAsync((unsigned char*)d_ws + WS_BAR, 0, 16384, stream);
    void* args[] = {&p};
    hipError_t e = hipLaunchCooperativeKernel((const void*)mega_fwd, dim3(grid), dim3(512), args, LDS_BYTES, stream);
#endif
    if (e != hipSuccess) fprintf(stderr, "kernel_launch: cooperative launch failed: %s (grid %d)\n", hipGetErrorString(e), grid);
}
```

```cpp
#include <hip/hip_runtime.h>
#ifndef DRY_ALL
#define DRY_ALL 0
#endif
#ifndef NT_STORES
#define NT_STORES 0
#endif
#ifndef SYNC_REP
#define SYNC_REP 1
#endif
#ifndef REPEAT_MASK
#define REPEAT_MASK 0ULL
#endif
#include <hip/hip_cooperative_groups.h>
#include <cstdio>
#include <cstdint>
namespace cg = cooperative_groups;

#define LAS __attribute__((address_space(3)))
typedef unsigned short bf16_t;
typedef short bf16x8 __attribute__((ext_vector_type(8)));
typedef short s16x4 __attribute__((ext_vector_type(4)));
typedef float f32x4 __attribute__((ext_vector_type(4)));
typedef float f32x16 __attribute__((ext_vector_type(16)));
typedef unsigned u32x4 __attribute__((ext_vector_type(4)));
typedef unsigned u32x2 __attribute__((ext_vector_type(2)));

constexpr int DM = 1024, NBATCH = 8, SEQ = 4096, CTXL = 256;
constexpr int RL = NBATCH * SEQ;
constexpr int RC = NBATCH * CTXL;
constexpr int RT = RL + RC;
constexpr int SKV = CTXL + SEQ;
constexpr int ZJ = 4352;
constexpr float NORM_EPS = 1e-6f, LN_EPS = 1e-5f;

constexpr size_t MiB = 1u << 20;
constexpr size_t WS_MOD = 0;
constexpr size_t WS_BAR = 901120;
constexpr size_t WS_XS1 = 1 * MiB;
constexpr size_t WS_XS2 = 2 * MiB;
constexpr size_t WS_CNT = 3 * MiB;
constexpr size_t CNT_BYTES = (size_t)34 * 2 * 136 * 256;
constexpr size_t WS_CC = 10 * MiB;
constexpr size_t WS_SC = WS_CC + 131072;
constexpr size_t WS_DFTC = WS_SC + 131072;
constexpr size_t WS_AWS = 11 * MiB;
constexpr size_t WS_W1T = 12 * MiB;
constexpr size_t WS_W2T = 44 * MiB;
constexpr size_t WS_AWINT = 76 * MiB;
constexpr size_t WS_AWOUTT = 92 * MiB;
constexpr size_t WS_BWOUTT = 100 * MiB;
constexpr size_t WS_QKVT = 102 * MiB;
constexpr size_t WS_WOT = 105 * MiB;
constexpr size_t WS_YH = 107 * MiB;
constexpr size_t WS_BIG = 175 * MiB;
constexpr size_t WS_X16 = 447 * MiB;
constexpr size_t WS_END = 511 * MiB;
constexpr size_t OUT_PART = 0;
constexpr size_t OUT_STATS = 32 * MiB;
constexpr size_t OUT_XC = 41 * MiB;
constexpr size_t BIG_Z = 0;
constexpr size_t BIG_DFTL = 68 * MiB;
constexpr size_t BIG_RT = 102 * MiB;
constexpr size_t BIG_RTC = 170 * MiB;
constexpr size_t BIG_Y2 = 178 * MiB;
constexpr size_t BIG_RAW = 0;
constexpr size_t BIG_K = 204 * MiB;
constexpr size_t BIG_V = 221 * MiB;
constexpr size_t BIG_Q = 0;
constexpr size_t BIG_O = 68 * MiB;

constexpr int LDS_BYTES = 141312;
constexpr int LDS_XP_OFF = 131072 + 1024, LDS_XS_OFF = 131072 + 5120, LDS_XF_OFF = 131072 + 6144;

typedef __bf16 bf16v2_t __attribute__((ext_vector_type(2)));
typedef float f32v2_t __attribute__((ext_vector_type(2)));
__device__ __forceinline__ unsigned cvt_pk_bf16(float lo, float hi) { const f32v2_t v = {lo, hi}; const bf16v2_t b = __builtin_convertvector(v, bf16v2_t); return __builtin_bit_cast(unsigned, b); }
__device__ __forceinline__ bf16_t f2bf(float f) { return (bf16_t)(cvt_pk_bf16(f, 0.f) & 0xffffu); }
__device__ __forceinline__ float bflo(unsigned w) { return __uint_as_float(w << 16); }
__device__ __forceinline__ float bfhi(unsigned w) { return __uint_as_float(w & 0xffff0000u); }
__device__ __forceinline__ float wave_sum(float v) {
#pragma unroll
    for (int o = 1; o < 64; o <<= 1) v += __shfl_xor(v, o);
    return v;
}
__device__ __forceinline__ float gelu_tanh(float x) {
    const float z2 = 1.5957691216057308f * (x + 0.044715f * x * x * x);
    const float e = __builtin_amdgcn_exp2f(-z2 * 1.4426950408889634f);
    return x * __builtin_amdgcn_rcpf(1.0f + e);
}

__device__ __forceinline__ f32x4 gelu_tanh4(f32x4 x) {
    f32x4 t = x * x; t = t * 0.044715f + 1.0f; t = t * x;
    const f32x4 a = t * (-2.3022082f);
    f32x4 e; e[0] = __builtin_amdgcn_exp2f(a[0]); e[1] = __builtin_amdgcn_exp2f(a[1]); e[2] = __builtin_amdgcn_exp2f(a[2]); e[3] = __builtin_amdgcn_exp2f(a[3]);
    const f32x4 d = e + 1.0f;
    f32x4 r; r[0] = __builtin_amdgcn_rcpf(d[0]); r[1] = __builtin_amdgcn_rcpf(d[1]); r[2] = __builtin_amdgcn_rcpf(d[2]); r[3] = __builtin_amdgcn_rcpf(d[3]);
    return x * r;
}
__device__ __forceinline__ f32x4 relu2_4(f32x4 x) {
    f32x4 m; m[0] = fmaxf(x[0], 0.f); m[1] = fmaxf(x[1], 0.f); m[2] = fmaxf(x[2], 0.f); m[3] = fmaxf(x[3], 0.f);
    return x * m;
}

namespace pg8 {
constexpr int BM = 256, BK = 64, HALF = 128, HTB = HALF * BK * 2, STAGE_BYTES = 8 * HTB, NXCD = 8, WGM = 8;
__host__ __device__ __forceinline__ int lds_byte(int r, int c) { const int st = (r >> 4) * 2 + (c >> 5), rr = r & 15, cc = c & 31, ob = rr * 64 + cc * 2; return st * 1024 + (ob ^ (((ob >> 9) & 1) << 5)); }
__host__ __device__ __forceinline__ void stage_rc(int b, int& R, int& C) { const int st = b / 1024, sb = b % 1024, swz = sb ^ (((sb >> 9) & 1) << 5); R = (st >> 1) * 16 + swz / 64; C = (st & 1) * 32 + (swz % 64) / 2; }
__host__ __device__ __forceinline__ int perm32(int rho) { const int n = rho >> 4, i = rho & 15; return 8 * (i >> 2) + 4 * n + (i & 3); }

struct GJob {
    const bf16_t* A; const bf16_t* A2; const bf16_t* B; void* C; float* stats;
    unsigned a2mask; int lda; int b_bs_hi, b_bs_lo, bdiv, b_pn_mod, ldb;
    int c_bs, ldc, out_f32, act; float scale;
    int stats_pn0;
    int nM, nN, nB, K;
    float* part; int split_pm0, ksplit;
    int fused, has_next, gate_off, shift_off, scale_off, x_mode;
    const float* xsrc; float* xdst; bf16_t* Hout; const float* gn_post; const float* gn_next; const float* modL; const float* modN;
    unsigned* slot1; unsigned* slot2; unsigned* cnt1; unsigned* cnt2; int kf; int dry;
    bf16_t* Kd; bf16_t* Vd; const float* qg; const float* kg;
};
#define JI(f) (__builtin_amdgcn_readfirstlane((int)(J->f)))
#define JF32(f) (__int_as_float(__builtin_amdgcn_readfirstlane(__float_as_int(J->f))))
template <class T> __device__ __forceinline__ T* jptr(const LAS void* p) {
    const LAS unsigned* q = (const LAS unsigned*)p; const unsigned lo = (unsigned)__builtin_amdgcn_readfirstlane((int)q[0]), hi = (unsigned)__builtin_amdgcn_readfirstlane((int)q[1]);
    typedef __attribute__((address_space(1))) T GT;
    GT* g = (GT*)(((unsigned long long)hi << 32) | lo); return (T*)g;
}
struct Unit { const char* a; const char* b; int bt, pm, pn, ks, nt; };

#define RFL(x) (UNIFORM ? __builtin_amdgcn_readfirstlane(x) : (x))
template <bool UNIFORM> __device__ __forceinline__ bool unit_next(const LAS GJob* J, int i, int G, int c, Unit& u) {
    const int nMall = JI(nM), nN = JI(nN), split_pm0 = JI(split_pm0), ksplit = JI(ksplit);
    const int nM = split_pm0 < nMall ? split_pm0 : nMall;
    const int per = nM * nN, nreg = per * JI(nB), nsplit = (nMall - nM) * nN * ksplit;
    const long L = (long)i * G + c; if (L >= nreg + nsplit) return false;
    const int lda = JI(lda), ldb = JI(ldb), K = JI(K);
    if (L >= nreg) {
        const int s = (int)L - nreg, ks = RFL(s % ksplit), t = s / ksplit;
        u.pn = RFL(t % nN); u.pm = RFL(nM + t / nN); u.bt = 0; u.ks = ks; u.nt = RFL((K / ksplit) / BK);
        u.a = (const char*)(jptr<const bf16_t>(&J->A) + (long)u.pm * 256 * lda + ks * (K / ksplit));
        u.b = (const char*)(jptr<const bf16_t>(&J->B) + (long)u.pn * 256 * ldb + ks * (K / ksplit));
        return true;
    }
    int wgid = (int)L; { const int nwg = nreg, q = nwg / NXCD, r = nwg % NXCD, xcd = wgid % NXCD, off = wgid / NXCD; wgid = (xcd < r ? xcd * (q + 1) : r * (q + 1) + (xcd - r) * q) + off; }
    const int bt = RFL(wgid / per), w = wgid % per;
    const int nig = WGM * nN, gid = w / nig, fm = gid * WGM, gsz = (nM - fm) < WGM ? (nM - fm) : WGM;
    u.pm = RFL(fm + ((w % nig) % gsz)); u.pn = RFL((w % nig) / gsz); u.bt = bt; u.ks = -1; u.nt = K / BK;
    const bf16_t* Ab = (((unsigned)JI(a2mask) >> u.pn) & 1u) ? jptr<const bf16_t>(&J->A2) : jptr<const bf16_t>(&J->A);
    u.a = (const char*)(Ab + (long)u.pm * 256 * lda);
    { const int kf = JI(kf); if (kf > 0) { const int part = bt & 1; u.a += (size_t)part * kf * 2; u.nt = part ? (K - kf) / BK : kf / BK; } }
    const int bdiv = JI(bdiv);
    const int bhi = RFL(bt / bdiv), blo = RFL(bt % bdiv), pnm = RFL(u.pn % JI(b_pn_mod));
    u.b = (const char*)(jptr<const bf16_t>(&J->B) + (long)bhi * JI(b_bs_hi) + (long)blo * JI(b_bs_lo) + (long)pnm * 256 * ldb);
    return true;
}

#undef RFL
constexpr int UT_MAX = 16, UT_STRIDE = 12;
__device__ __forceinline__ void unit_table_build(LAS unsigned* tab, const LAS GJob* J, int G, int c, int tid) {
    if (tid < UT_MAX) {
        Unit u; u.a = nullptr; u.b = nullptr; u.bt = 0; u.pm = 0; u.pn = 0; u.ks = -1; u.nt = 4;
        const bool ok = unit_next<false>(J, tid, G, c, u);
        LAS unsigned* e = tab + tid * UT_STRIDE;
        const unsigned long long pa = (unsigned long long)u.a, pb = (unsigned long long)u.b;
        e[0] = (unsigned)pa; e[1] = (unsigned)(pa >> 32); e[2] = (unsigned)pb; e[3] = (unsigned)(pb >> 32);
        e[4] = (unsigned)u.bt; e[5] = (unsigned)u.pm; e[6] = (unsigned)u.pn; e[7] = (unsigned)u.ks; e[8] = (unsigned)u.nt; e[9] = ok ? 1u : 0u;
    }
}
__device__ __forceinline__ bool unit_fetch(const LAS unsigned* tab, int i, Unit& u) {
    if (i >= UT_MAX) return false;
    const LAS unsigned* e = tab + i * UT_STRIDE;
    if (__builtin_amdgcn_readfirstlane((int)e[9]) == 0) return false;
    u.a = jptr<const char>(e); u.b = jptr<const char>(e + 2);
    u.bt = __builtin_amdgcn_readfirstlane((int)e[4]); u.pm = __builtin_amdgcn_readfirstlane((int)e[5]); u.pn = __builtin_amdgcn_readfirstlane((int)e[6]);
    u.ks = __builtin_amdgcn_readfirstlane((int)e[7]); u.nt = __builtin_amdgcn_readfirstlane((int)e[8]);
    return true;
}

__device__ __forceinline__ void epilogue(const LAS GJob* J, const f32x4 (&acc)[2][2][4][2], const Unit& u, int wr, int wc, int fr, int fq) {
    asm volatile("" : "+v"(fr), "+v"(fq));
    const int row0 = u.pm * BM + wr * 64 + fr, col0 = u.pn * BM + wc * 32 + 8 * fq;
    float* const stats = jptr<float>(&J->stats); const int stats_pn0 = JI(stats_pn0);
    const bool do_stats = (stats != nullptr) && (u.pn >= stats_pn0);
    const float sc = JF32(scale); const bool has_scale = (sc != 1.0f); const int act = JI(act), out_f32 = JI(out_f32), ldc = JI(ldc); const bool nostore = (REPEAT_MASK != 0ULL) && (JI(dry) == 2);
    char* const Cb = jptr<char>(&J->C) + ((size_t)u.bt * JI(c_bs) << (out_f32 ? 2 : 1));
    if (u.ks >= 0) {
        const int nMall = JI(nM), sp0 = JI(split_pm0);
        float* const part = jptr<float>(&J->part) + (size_t)u.ks * (nMall - sp0) * BM * ldc;
#pragma unroll
        for (int ai = 0; ai < 2; ++ai)
#pragma unroll
            for (int m = 0; m < 4; ++m) {
                const int row = row0 + ai * HALF + m * 16;
#pragma unroll
                for (int bj = 0; bj < 2; ++bj) { float* p = part + (size_t)(row - sp0 * BM) * ldc + col0 + bj * HALF; *(f32x4*)p = acc[ai][bj][m][0]; *(f32x4*)(p + 4) = acc[ai][bj][m][1]; }
            }
        return;
    }
#pragma unroll
    for (int ai = 0; ai < 2; ++ai)
#pragma unroll
        for (int m = 0; m < 4; ++m) {
            const int row = row0 + ai * HALF + m * 16;
            float ssum = 0.f, ssq = 0.f;
#pragma unroll
            for (int bj = 0; bj < 2; ++bj) {
                f32x4 v0 = acc[ai][bj][m][0], v1 = acc[ai][bj][m][1];
                if (has_scale) { v0 = v0 * sc; v1 = v1 * sc; }
                if (act == 1) { v0 = gelu_tanh4(v0); v1 = gelu_tanh4(v1); }
                else if (act == 2) { v0 = relu2_4(v0); v1 = relu2_4(v1); }
                if (do_stats) {
#pragma unroll
                    for (int e = 0; e < 4; ++e) { ssum += v0[e] + v1[e]; ssq += v0[e] * v0[e] + v1[e] * v1[e]; }
                }
                const size_t off = (size_t)row * ldc + col0 + bj * HALF;
                if (out_f32) { float* p = (float*)Cb + off; *(f32x4*)p = v0; *(f32x4*)(p + 4) = v1; }
                else { u32x4 w; w.x = cvt_pk_bf16(v0[0], v0[1]); w.y = cvt_pk_bf16(v0[2], v0[3]); w.z = cvt_pk_bf16(v1[0], v1[1]); w.w = cvt_pk_bf16(v1[2], v1[3]);
                       if (REPEAT_MASK != 0ULL && nostore) { asm volatile("" :: "v"(w.x), "v"(w.y), "v"(w.z), "v"(w.w)); } else
                       if (NT_STORES) __builtin_nontemporal_store(w, (u32x4*)((bf16_t*)Cb + off)); else *(u32x4*)((bf16_t*)Cb + off) = w; }
            }
            if (do_stats) {
                ssum += __shfl_xor(ssum, 16); ssum += __shfl_xor(ssum, 32); ssq += __shfl_xor(ssq, 16); ssq += __shfl_xor(ssq, 32);
                if (fq == 0) { float* s = stats + ((size_t)row * 32 + (u.pn - stats_pn0) * 4 + wc) * 2; s[0] = ssum; s[1] = ssq; }
            }
        }
}

__device__ __forceinline__ void row_exchange(LAS unsigned char* lds, const float (&q)[2][4], unsigned* slot, unsigned* cnt, const Unit& u, int wr, int wc, int fr, int fq, int wid, int lane) {
    LAS float* P = (LAS float*)(lds + 131072 + 1024); LAS float* S = (LAS float*)(lds + 131072 + 5120);
#pragma unroll
    for (int ai = 0; ai < 2; ++ai)
#pragma unroll
        for (int m = 0; m < 4; ++m) { float t = q[ai][m]; t += __shfl_xor(t, 16); t += __shfl_xor(t, 32); if (fq == 0) P[(ai * HALF + wr * 64 + m * 16 + fr) * 4 + wc] = t; }
    asm volatile("s_waitcnt lgkmcnt(0)" ::: "memory"); __builtin_amdgcn_s_barrier(); asm volatile("" ::: "memory");
    const int row = wid * 32 + (lane & 31);
    unsigned* myslot = slot + ((size_t)(u.pm * BM + row) * 4);
    if (lane < 32) { const float t = (P[row * 4 + 0] + P[row * 4 + 1]) + (P[row * 4 + 2] + P[row * 4 + 3]);
        __hip_atomic_store(myslot + u.pn, __float_as_uint(t), __ATOMIC_RELAXED, __HIP_MEMORY_SCOPE_AGENT); }
    asm volatile("s_waitcnt vmcnt(0)" ::: "memory");
    if (lane == 0) __hip_atomic_fetch_add(cnt + 64 * u.pm, 1u, __ATOMIC_RELAXED, __HIP_MEMORY_SCOPE_AGENT);
    if (wid == 0) {
        for (int spin = 0; spin < (1 << 20); ++spin) {
            if ((unsigned)__builtin_amdgcn_readfirstlane((int)__hip_atomic_load(cnt + 64 * u.pm, __ATOMIC_RELAXED, __HIP_MEMORY_SCOPE_AGENT)) >= 32u) break;
            __builtin_amdgcn_s_sleep(2);
        }
        __builtin_amdgcn_fence(__ATOMIC_ACQUIRE, "agent");
    }
    asm volatile("s_waitcnt vmcnt(0) lgkmcnt(0)" ::: "memory"); __builtin_amdgcn_s_barrier(); asm volatile("" ::: "memory");
    if (lane < 32) { float t = 0.f;
#pragma unroll
        for (int k = 0; k < 4; ++k) t += __uint_as_float(__hip_atomic_load(myslot + k, __ATOMIC_RELAXED, __HIP_MEMORY_SCOPE_AGENT));
        S[row] = rsqrtf(t * (1.0f / 1024.0f) + 1e-6f); }
    asm volatile("s_waitcnt lgkmcnt(0)" ::: "memory"); __builtin_amdgcn_s_barrier(); asm volatile("" ::: "memory");
}
__device__ __forceinline__ void epilogue_fused(const LAS GJob* J, f32x4 (&acc)[2][2][4][2], const Unit& u, LAS unsigned char* lds, int wr, int wc, int fr, int fq, int wid, int lane) {
    const int row0 = u.pm * BM + wr * 64 + fr, col0 = u.pn * BM + wc * 32 + 8 * fq;
    const int bidx = (u.pm * BM) >> 12;
    const LAS float* S = (const LAS float*)(lds + 131072 + 5120);
    const unsigned lo4 = (unsigned)(row0 * DM + col0) * 4u, lo2 = (unsigned)(row0 * DM + col0) * 2u;
#define XOFF(ai, m, bj, n) ((unsigned)((((ai) * HALF + (m) * 16) * DM + (bj) * HALF + 4 * (n)) * 4))
    float q[2][4];
#pragma unroll
    for (int ai = 0; ai < 2; ++ai)
#pragma unroll
        for (int m = 0; m < 4; ++m) { float t = 0.f;
#pragma unroll
            for (int bj = 0; bj < 2; ++bj)
#pragma unroll
                for (int n = 0; n < 2; ++n) { const f32x4 y = acc[ai][bj][m][n]; t += (y[0] * y[0] + y[1] * y[1]) + (y[2] * y[2] + y[3] * y[3]); }
            q[ai][m] = t; }
    const char* xs = (const char*)jptr<const float>(&J->xsrc);
    const bool dst32 = (JI(x_mode) & 2) != 0;
    u32x4 xq[2][4];
#define XLOADH(bj) do { _Pragma("unroll") for (int ai = 0; ai < 2; ++ai) _Pragma("unroll") for (int m = 0; m < 4; ++m) xq[ai][m] = *(const u32x4*)(xs + XOFF(ai, m, bj, 0) / 2 + lo2); } while (0)
    XLOADH(0);
    row_exchange(lds, q, jptr<unsigned>(&J->slot1), jptr<unsigned>(&J->cnt1), u, wr, wc, fr, fq, wid, lane);
    {
        const float* gate = jptr<const float>(&J->modL) + bidx * 6144 + JI(gate_off) + col0; const float* gnp = jptr<const float>(&J->gn_post) + col0;
        char* xd = (char*)jptr<float>(&J->xdst);
#pragma unroll
        for (int ai = 0; ai < 2; ++ai)
#pragma unroll
            for (int m = 0; m < 4; ++m) q[ai][m] = 0.f;
#pragma unroll
        for (int bj = 0; bj < 2; ++bj) {
            const f32x4 gt0 = *(const f32x4*)(gate + bj * HALF), gt1 = *(const f32x4*)(gate + bj * HALF + 4), gp0 = *(const f32x4*)(gnp + bj * HALF), gp1 = *(const f32x4*)(gnp + bj * HALF + 4);
#pragma unroll
            for (int ai = 0; ai < 2; ++ai)
#pragma unroll
                for (int m = 0; m < 4; ++m) {
                    const float rs = S[ai * HALF + wr * 64 + m * 16 + fr]; const u32x4 w = xq[ai][m];
                    const f32x4 x0 = (f32x4){bflo(w.x), bfhi(w.x), bflo(w.y), bfhi(w.y)}, x1 = (f32x4){bflo(w.z), bfhi(w.z), bflo(w.w), bfhi(w.w)};
                    const f32x4 xn0 = x0 + gt0 * ((acc[ai][bj][m][0] * rs) * gp0), xn1 = x1 + gt1 * ((acc[ai][bj][m][1] * rs) * gp1);
                    acc[ai][bj][m][0] = xn0; acc[ai][bj][m][1] = xn1;
                    q[ai][m] += ((xn0[0] * xn0[0] + xn0[1] * xn0[1]) + (xn0[2] * xn0[2] + xn0[3] * xn0[3])) + ((xn1[0] * xn1[0] + xn1[1] * xn1[1]) + (xn1[2] * xn1[2] + xn1[3] * xn1[3])); }
            asm volatile("" ::: "memory");
            if (bj == 0) XLOADH(1);
            if (dst32) {
#pragma unroll
                for (int ai = 0; ai < 2; ++ai)
#pragma unroll
                    for (int m = 0; m < 4; ++m) { *(f32x4*)(xd + XOFF(ai, m, bj, 0) + lo4) = acc[ai][bj][m][0]; *(f32x4*)(xd + XOFF(ai, m, bj, 1) + lo4) = acc[ai][bj][m][1]; }
            } else {
#pragma unroll
                for (int ai = 0; ai < 2; ++ai)
#pragma unroll
                    for (int m = 0; m < 4; ++m) { const f32x4 a0 = acc[ai][bj][m][0], a1 = acc[ai][bj][m][1];
                        u32x4 w; w.x = cvt_pk_bf16(a0[0], a0[1]); w.y = cvt_pk_bf16(a0[2], a0[3]); w.z = cvt_pk_bf16(a1[0], a1[1]); w.w = cvt_pk_bf16(a1[2], a1[3]);
                        *(u32x4*)(xd + XOFF(ai, m, bj, 0) / 2 + lo2) = w; }
            }
        }
    }
#undef XLOADH
    if (!JI(has_next)) return;
    row_exchange(lds, q, jptr<unsigned>(&J->slot2), jptr<unsigned>(&J->cnt2), u, wr, wc, fr, fq, wid, lane);
    {
        const float* modN = jptr<const float>(&J->modN) + bidx * 6144 + col0; const float* shp = modN + JI(shift_off); const float* scp = modN + JI(scale_off); const float* gnn = jptr<const float>(&J->gn_next) + col0;
        char* H = (char*)jptr<bf16_t>(&J->Hout);
#pragma unroll
        for (int bj = 0; bj < 2; ++bj) {
            const f32x4 gn0 = *(const f32x4*)(gnn + bj * HALF), gn1 = *(const f32x4*)(gnn + bj * HALF + 4), sh0 = *(const f32x4*)(shp + bj * HALF), sh1 = *(const f32x4*)(shp + bj * HALF + 4);
            const f32x4 sc0 = *(const f32x4*)(scp + bj * HALF) + 1.0f, sc1 = *(const f32x4*)(scp + bj * HALF + 4) + 1.0f;
#pragma unroll
            for (int ai = 0; ai < 2; ++ai)
#pragma unroll
                for (int m = 0; m < 4; ++m) {
                    const float rs = S[ai * HALF + wr * 64 + m * 16 + fr];
                    const f32x4 h0 = ((acc[ai][bj][m][0] * rs) * gn0) * sc0 + sh0, h1 = ((acc[ai][bj][m][1] * rs) * gn1) * sc1 + sh1;
                    u32x4 w; w.x = cvt_pk_bf16(h0[0], h0[1]); w.y = cvt_pk_bf16(h0[2], h0[3]); w.z = cvt_pk_bf16(h1[0], h1[1]); w.w = cvt_pk_bf16(h1[2], h1[3]);
                    *(u32x4*)(H + XOFF(ai, m, bj, 0) / 2 + lo2) = w; }
        }
    }
#undef XOFF
}

__device__ __forceinline__ void epilogue_qkv(const LAS GJob* J, const f32x4 (&acc)[2][2][4][2], const Unit& u, LAS unsigned char* lds, int wr, int wc, int fr, int fq) {
    asm volatile("" : "+v"(fr), "+v"(fq));
    LAS float* P = (LAS float*)(lds + 131072 + 1024);
    const bool is_v = (u.pn == 5), is_k = (u.pn == 4);
    if (!is_v) {
#pragma unroll
        for (int ai = 0; ai < 2; ++ai)
#pragma unroll
            for (int m = 0; m < 4; ++m)
#pragma unroll
                for (int bj = 0; bj < 2; ++bj) { const f32x4 a = acc[ai][bj][m][0], b = acc[ai][bj][m][1];
                    float t = ((a[0] * a[0] + a[1] * a[1]) + (a[2] * a[2] + a[3] * a[3])) + ((b[0] * b[0] + b[1] * b[1]) + (b[2] * b[2] + b[3] * b[3]));
                    t += __shfl_xor(t, 16); t += __shfl_xor(t, 32);
                    if (fq == 0) P[((ai * HALF + wr * 64 + m * 16 + fr) * 2 + bj) * 4 + wc] = t; }
    }
    asm volatile("s_waitcnt lgkmcnt(0)" ::: "memory"); __builtin_amdgcn_s_barrier(); asm volatile("" ::: "memory");
    const int d0 = 16 * wc + 4 * fq;
    bf16_t* const Qd = jptr<bf16_t>(&J->C); bf16_t* const Kd = jptr<bf16_t>(&J->Kd); bf16_t* const Vd = jptr<bf16_t>(&J->Vd);
    const float* g = is_k ? jptr<const float>(&J->kg) : jptr<const float>(&J->qg);
    f32x4 g1 = (f32x4){1.f, 1.f, 1.f, 1.f}, g2 = g1; float inv[4] = {0.f, 0.f, 0.f, 0.f};
    if (!is_v) { g1 = *(const f32x4*)(g + d0); g2 = *(const f32x4*)(g + 64 + d0);
#pragma unroll
        for (int e = 0; e < 4; ++e) inv[e] = exp2f(-(float)((d0 + e) & 31) * (13.287712379549449f / 32.0f)); }
#pragma unroll
    for (int ai = 0; ai < 2; ++ai)
#pragma unroll
        for (int m = 0; m < 4; ++m) {
            const int trow = ai * HALF + wr * 64 + m * 16 + fr, row = u.pm * BM + trow;
            const bool lat = row < RL; const int b = lat ? (row >> 12) : ((row - RL) >> 8), t = lat ? (row & 4095) : ((row - RL) & 255), pos = lat ? (CTXL + t) : t;
            const size_t kvoff = ((size_t)b * SKV + pos) * 256;
            if (is_v) {
#pragma unroll
                for (int bj = 0; bj < 2; ++bj) { const f32x4 a = acc[ai][bj][m][0], c = acc[ai][bj][m][1];
                    u32x4 w; w.x = cvt_pk_bf16(a[0], a[1]); w.y = cvt_pk_bf16(a[2], a[3]); w.z = cvt_pk_bf16(c[0], c[1]); w.w = cvt_pk_bf16(c[2], c[3]);
                    *(u32x4*)(Vd + kvoff + bj * HALF + 32 * wc + 8 * fq) = w; }
            } else {
                f32x4 cs = (f32x4){1.f, 1.f, 1.f, 1.f}, sn = (f32x4){0.f, 0.f, 0.f, 0.f};
                if (lat) { const float p = (d0 < 32) ? (float)(t >> 6) : (float)(t & 63);
#pragma unroll
                    for (int e = 0; e < 4; ++e) { float rev = (p * inv[e]) * 0.15915494309189535f; rev -= floorf(rev); sn[e] = __builtin_amdgcn_sinf(rev); cs[e] = __builtin_amdgcn_cosf(rev); } }
#pragma unroll
                for (int bj = 0; bj < 2; ++bj) {
                    const f32x4 pr = *(const LAS f32x4*)(P + (trow * 2 + bj) * 4);
                    const float rs = rsqrtf(((pr[0] + pr[1]) + (pr[2] + pr[3])) * (1.0f / 128.0f) + NORM_EPS);
                    const f32x4 y1 = (acc[ai][bj][m][0] * rs) * g1, y2 = (acc[ai][bj][m][1] * rs) * g2;
                    const f32x4 o1 = y1 * cs - y2 * sn, o2 = y1 * sn + y2 * cs;
                    u32x2 w1, w2; w1.x = cvt_pk_bf16(o1[0], o1[1]); w1.y = cvt_pk_bf16(o1[2], o1[3]); w2.x = cvt_pk_bf16(o2[0], o2[1]); w2.y = cvt_pk_bf16(o2[2], o2[3]);
                    if (is_k) { bf16_t* d = Kd + kvoff + bj * HALF + d0; *(u32x2*)d = w1; *(u32x2*)(d + 64) = w2; }
                    else if (lat) { bf16_t* d = Qd + (size_t)row * 1024 + (2 * u.pn + bj) * HALF + d0; *(u32x2*)d = w1; *(u32x2*)(d + 64) = w2; }
                }
            }
        }
}

__device__ __forceinline__ void gemm_phase(LAS unsigned char* lds, const LAS GJob* J, int G, int cidx, const int tid) {
    const int wid = __builtin_amdgcn_readfirstlane(tid >> 6), lane = tid & 63, wr = wid >> 2, wc = wid & 3, fr = lane & 15, fq = lane >> 4;
    const int lda = JI(lda), ldb = JI(ldb);
    unsigned voffA[2], voffB[2];
#pragma unroll
    for (int i = 0; i < 2; ++i) { int R, C; stage_rc(tid * 16 + i * 8192, R, C); const int Rb = (R & ~31) + perm32(R & 31);
        voffA[i] = (unsigned)(R * lda + C) * 2u; voffB[i] = (unsigned)(Rb * ldb + C) * 2u; }
    const size_t kstep = (size_t)(BK * 2);
    const size_t hsA = (size_t)HALF * lda * 2, hsB = (size_t)HALF * ldb * 2;
    const unsigned ldsw = (unsigned)wid * 1024u;
    const int aoff = lds_byte(wr * 64 + fr, fq * 8), boff = lds_byte(wc * 32 + fr, fq * 8);
#define PG8_SA(b, h) (((b) * 2 + (h)) * HTB)
#define PG8_SB(b, h) ((4 + (b) * 2 + (h)) * HTB)
#define PG8_STAGE(bufoff, gbase, voff) do { _Pragma("unroll") for (int _i = 0; _i < 2; ++_i) \
        __builtin_amdgcn_global_load_lds((const unsigned*)((const char*)(gbase) + (voff)[_i]), (LAS unsigned*)(lds + (bufoff) + ldsw + _i * 8192), 16, 0, 0); } while (0)
#define PG8_LDA(dst, b, h) do { _Pragma("unroll") for (int m = 0; m < 4; ++m) _Pragma("unroll") for (int k = 0; k < 2; ++k) dst[m][k] = *(const LAS bf16x8*)(lds + PG8_SA(b, h) + aoff + m * 2048 + k * 1024); } while (0)
#define PG8_LDB(dst, b, h) do { _Pragma("unroll") for (int n = 0; n < 2; ++n) _Pragma("unroll") for (int k = 0; k < 2; ++k) dst[n][k] = *(const LAS bf16x8*)(lds + PG8_SB(b, h) + boff + n * 2048 + k * 1024); } while (0)
#define PG8_MMA(ai, bj, At, Bt) do { __builtin_amdgcn_s_setprio(1); _Pragma("unroll") for (int m = 0; m < 4; ++m) _Pragma("unroll") for (int n = 0; n < 2; ++n) _Pragma("unroll") for (int k = 0; k < 2; ++k) \
        acc[ai][bj][m][n] = __builtin_amdgcn_mfma_f32_16x16x32_bf16(Bt[n][k], At[m][k], acc[ai][bj][m][n], 0, 0, 0); __builtin_amdgcn_s_setprio(0); } while (0)
#define PG8_WAIT_V(n) asm volatile("s_waitcnt vmcnt(" #n ")" ::: "memory")
#define PG8_WAIT_L(n) asm volatile("s_waitcnt lgkmcnt(" #n ")" ::: "memory")
#define PG8_BAR __builtin_amdgcn_s_barrier()
#define PG8_SCHED __builtin_amdgcn_sched_barrier(0)
    Unit cur, nxt; int ui = 0;
    LAS unsigned* const utab = (LAS unsigned*)(lds + 131072 + 9216);
    unit_table_build(utab, J, G, cidx, tid);
    asm volatile("s_waitcnt lgkmcnt(0)" ::: "memory"); __builtin_amdgcn_s_barrier(); asm volatile("" ::: "memory");
    if (!unit_fetch(utab, 0, cur)) return;
    f32x4 acc[2][2][4][2];
#pragma unroll
    for (int a = 0; a < 2; ++a)
#pragma unroll
        for (int b = 0; b < 2; ++b)
#pragma unroll
            for (int m = 0; m < 4; ++m)
#pragma unroll
                for (int n = 0; n < 2; ++n) acc[a][b][m][n] = (f32x4){0.f, 0.f, 0.f, 0.f};
    bf16x8 At[4][2], B0[2][2], B1[2][2];
    const char* cA = cur.a; const char* cB = cur.b;
    PG8_STAGE(PG8_SB(0, 0), cB, voffB); PG8_STAGE(PG8_SB(0, 1), cB + hsB, voffB); PG8_STAGE(PG8_SA(0, 0), cA, voffA); PG8_STAGE(PG8_SA(0, 1), cA + hsA, voffA);
    if (wr == 1) PG8_BAR;
    PG8_WAIT_V(2); PG8_BAR;
    PG8_STAGE(PG8_SB(1, 0), cB + kstep, voffB); PG8_STAGE(PG8_SA(1, 0), cA + kstep, voffA); PG8_STAGE(PG8_SB(1, 1), cB + hsB + kstep, voffB);
    PG8_WAIT_V(6); PG8_BAR;
    for (;;) {
        const bool has_next = unit_fetch(utab, ui + 1, nxt);
        const char* nA = has_next ? nxt.a : cA; const char* nB = has_next ? nxt.b : cB;
        const int nt = cur.nt;
        for (int t = 0; t < nt; t += 2) {
            const bool last = (t == nt - 2);
            const char* a1 = cA + (size_t)(t + 1) * kstep;
            const char* a2 = last ? nA : cA + (size_t)(t + 2) * kstep; const char* b2 = last ? nB : cB + (size_t)(t + 2) * kstep;
            const char* a3 = a2 + kstep; const char* b3 = b2 + kstep;
            PG8_LDB(B0, 0, 0); PG8_LDB(B1, 0, 1); PG8_SCHED; PG8_LDA(At, 0, 0); PG8_STAGE(PG8_SA(1, 1), a1 + hsA, voffA);
            PG8_WAIT_V(8); PG8_WAIT_L(0); PG8_BAR; PG8_MMA(0, 0, At, B0); PG8_MMA(0, 1, At, B1); PG8_BAR; PG8_SCHED;
            PG8_LDA(At, 0, 1); PG8_STAGE(PG8_SB(0, 0), b2, voffB); PG8_STAGE(PG8_SB(0, 1), b2 + hsB, voffB); PG8_STAGE(PG8_SA(0, 0), a2, voffA);
            PG8_WAIT_V(8); PG8_WAIT_L(0); PG8_BAR; PG8_MMA(1, 0, At, B0); PG8_MMA(1, 1, At, B1); PG8_BAR; PG8_SCHED;
            PG8_LDB(B0, 1, 0); PG8_LDB(B1, 1, 1); PG8_SCHED; PG8_LDA(At, 1, 0); PG8_STAGE(PG8_SA(0, 1), a2 + hsA, voffA);
            PG8_WAIT_V(8); PG8_WAIT_L(0); PG8_BAR; PG8_MMA(0, 0, At, B0); PG8_MMA(0, 1, At, B1); PG8_BAR; PG8_SCHED;
            PG8_LDA(At, 1, 1); PG8_STAGE(PG8_SB(1, 0), b3, voffB); PG8_STAGE(PG8_SB(1, 1), b3 + hsB, voffB); PG8_STAGE(PG8_SA(1, 0), a3, voffA);
            PG8_WAIT_V(8); PG8_WAIT_L(0); PG8_BAR; PG8_MMA(1, 0, At, B0); PG8_MMA(1, 1, At, B1); PG8_BAR; PG8_SCHED;
        }
        if (wr == 0) PG8_BAR;
        if (REPEAT_MASK != 0ULL && JI(dry) == 1) {   } else
#ifndef NO_FUSED
#ifndef NO_FUSEDEPI
        if (JI(fused) && cur.ks < 0) epilogue_fused(J, acc, cur, lds, wr, wc, fr, fq, wid, lane);
        else
#endif
        if (false) {}
        else
#endif
        epilogue(J, acc, cur, wr, wc, fr, fq);
        if (!has_next) break;
#pragma unroll
        for (int a = 0; a < 2; ++a)
#pragma unroll
            for (int b = 0; b < 2; ++b)
#pragma unroll
                for (int m = 0; m < 4; ++m)
#pragma unroll
                    for (int n = 0; n < 2; ++n) acc[a][b][m][n] = (f32x4){0.f, 0.f, 0.f, 0.f};
        cur = nxt; cA = nA; cB = nB; ++ui;
        if (wr == 1) PG8_BAR;
    }
    PG8_WAIT_V(0);
    PG8_BAR;
#undef PG8_SA
#undef PG8_SB
#undef PG8_STAGE
#undef PG8_LDA
#undef PG8_LDB
#undef PG8_MMA
#undef PG8_WAIT_V
#undef PG8_WAIT_L
#undef PG8_BAR
#undef PG8_SCHED
}
}
using pg8::GJob;

namespace att {
constexpr int D = 128, NW = 8, QBLK = 32, KVBLK = 64;
constexpr float SCALE = 0.088388347648318440f;
constexpr float THR = 8.f;
constexpr int LDQ = 1024, LDK = 256, LDO = 1024;
constexpr size_t SHM_V = KVBLK * D * 2, SHM_K = KVBLK * D * 2, SHM_ATTN = 2 * SHM_V + 2 * SHM_K + NW * 64 * 4;
#define KSWZ(row, colB) ((row) * 256 + ((colB) ^ (((row) & 7) << 4)))
#define SBAR() __builtin_amdgcn_sched_barrier(0)
__device__ __forceinline__ int crow(int r, int hi) { return (r & 3) + 8 * (r >> 2) + 4 * hi; }
__device__ __forceinline__ void partialSM(f32x16& p0, f32x16& p1, float& m_reg, float& mn, float& alpha) {
  constexpr float C = SCALE * 1.4426950408889634f;
  float pmax = p0[0]; for (int r = 1; r < 16; ++r) pmax = fmaxf(pmax, p0[r]); for (int r = 0; r < 16; ++r) pmax = fmaxf(pmax, p1[r]);
  { auto rr = __builtin_amdgcn_permlane32_swap(__float_as_uint(pmax), __float_as_uint(pmax), false, false);
    pmax = fmaxf(__uint_as_float(rr[0]), __uint_as_float(rr[1])); }
  if (__builtin_expect(__all(pmax - m_reg <= THR / SCALE), 1)) { mn = m_reg; alpha = 1.f; }
  else { mn = fmaxf(m_reg, pmax); alpha = __builtin_amdgcn_exp2f((m_reg - mn) * C); m_reg = mn; }
  float mnC = -mn * C;
  for (int r = 0; r < 16; ++r) p0[r] = fmaf(p0[r], C, mnC); for (int r = 0; r < 16; ++r) p1[r] = fmaf(p1[r], C, mnC);
  for (int r = 0; r < 16; ++r) p0[r] = __builtin_amdgcn_exp2f(p0[r]);
}
__device__ __forceinline__ void finishSM(f32x16& p0, f32x16& p1, float alpha, float& l_reg, bf16x8& pa0, bf16x8& pa1, bf16x8& pa2, bf16x8& pa3) {
  for (int r = 0; r < 16; ++r) p1[r] = __builtin_amdgcn_exp2f(p1[r]);
  float ps = 0; for (int r = 0; r < 16; ++r) ps += p0[r]; for (int r = 0; r < 16; ++r) ps += p1[r];
  { auto rr = __builtin_amdgcn_permlane32_swap(__float_as_uint(ps), __float_as_uint(ps), false, false);
    ps = __uint_as_float(rr[0]) + __uint_as_float(rr[1]); }
  l_reg = l_reg * alpha + ps;
#define PK4(P, BASE, OUT) do { unsigned a0 = cvt_pk_bf16(P[BASE + 0], P[BASE + 1]), a1 = cvt_pk_bf16(P[BASE + 2], P[BASE + 3]);   \
    unsigned b0 = cvt_pk_bf16(P[BASE + 4], P[BASE + 5]), b1 = cvt_pk_bf16(P[BASE + 6], P[BASE + 7]);                              \
    auto r0 = __builtin_amdgcn_permlane32_swap(a0, b0, false, false); auto r1 = __builtin_amdgcn_permlane32_swap(a1, b1, false, false); \
    u32x4 w = {r0[0], r1[0], r0[1], r1[1]}; OUT = *reinterpret_cast<bf16x8*>(&w); } while (0)
  PK4(p0, 0, pa0); PK4(p0, 8, pa1); PK4(p1, 0, pa2); PK4(p1, 8, pa3);
#undef PK4
}
__device__ __forceinline__ void qkt(f32x16& p0, f32x16& p1, const bf16_t* Ks, const bf16x8* qr, int r32, int hi) {
  p0 = f32x16{}; p1 = f32x16{};
  for (int d0 = 0; d0 < 8; ++d0) { int cb = (d0 * 16 + hi * 8) * 2;
    bf16x8 b0 = *reinterpret_cast<const bf16x8*>((const char*)Ks + KSWZ(r32, cb));
    bf16x8 b1 = *reinterpret_cast<const bf16x8*>((const char*)Ks + KSWZ(32 + r32, cb));
    p0 = __builtin_amdgcn_mfma_f32_32x32x16_bf16(b0, qr[d0], p0, 0, 0, 0);
    p1 = __builtin_amdgcn_mfma_f32_32x32x16_bf16(b1, qr[d0], p1, 0, 0, 0); }
}
__device__ __forceinline__ int v_st(int k, int c) { const int kk = (k & ~0xC) | ((k & 4) << 1) | ((k & 8) >> 1); return ((kk >> 3) * 4 + (c >> 5)) * 512 + ((kk & 7) * 32 + (c & 31)) * 2; }
__device__ __forceinline__ int v_rd_base(int lane) { return ((lane & 3) << 3) | (((lane >> 2) & 3) << 6) | (((lane >> 4) & 1) << 5) | (((lane >> 5) & 1) << 8); }
constexpr int v_rd_off(int d0, int ks, int half) { return d0 * 512 + ks * 4096 + half * 2048; }
template <int OFF> __device__ __forceinline__ s16x4 tr_read(int vb) {
  s16x4 r; asm volatile("ds_read_b64_tr_b16 %0, %1 offset:%2" : "=&v"(r) : "v"(vb), "i"(OFF) : "memory"); return r;
}
template <int D0> __device__ __forceinline__ void pv_one(f32x16& od, int vb, bf16x8 pa0, bf16x8 pa1, bf16x8 pa2, bf16x8 pa3) {
  const s16x4 l0 = tr_read<v_rd_off(D0, 0, 0)>(vb), h0 = tr_read<v_rd_off(D0, 0, 1)>(vb), l1 = tr_read<v_rd_off(D0, 1, 0)>(vb), h1 = tr_read<v_rd_off(D0, 1, 1)>(vb);
  const s16x4 l2 = tr_read<v_rd_off(D0, 2, 0)>(vb), h2 = tr_read<v_rd_off(D0, 2, 1)>(vb), l3 = tr_read<v_rd_off(D0, 3, 0)>(vb), h3 = tr_read<v_rd_off(D0, 3, 1)>(vb);
  asm volatile("s_waitcnt lgkmcnt(0)" ::: "memory"); SBAR();
#define PK(L, H) (bf16x8){L[0], L[1], L[2], L[3], H[0], H[1], H[2], H[3]}
  od = __builtin_amdgcn_mfma_f32_32x32x16_bf16(pa0, PK(l0, h0), od, 0, 0, 0);
  od = __builtin_amdgcn_mfma_f32_32x32x16_bf16(pa1, PK(l1, h1), od, 0, 0, 0);
  od = __builtin_amdgcn_mfma_f32_32x32x16_bf16(pa2, PK(l2, h2), od, 0, 0, 0);
  od = __builtin_amdgcn_mfma_f32_32x32x16_bf16(pa3, PK(l3, h3), od, 0, 0, 0);
#undef PK
}
__device__ __forceinline__ void pv_d0(f32x16* o, int vb, bf16x8 pa0, bf16x8 pa1, bf16x8 pa2, bf16x8 pa3) {
  pv_one<0>(o[0], vb, pa0, pa1, pa2, pa3); pv_one<1>(o[1], vb, pa0, pa1, pa2, pa3); pv_one<2>(o[2], vb, pa0, pa1, pa2, pa3); pv_one<3>(o[3], vb, pa0, pa1, pa2, pa3);
}
__device__ __forceinline__ void attn_dense_body(const bf16_t* __restrict__ Qb, const bf16_t* __restrict__ Kh, const bf16_t* __restrict__ Vh,
                                                bf16_t* __restrict__ Ob, int seq, char* lds, const int tid) {
  constexpr int SDEPTH = 2;
  const int wid = tid >> 6, lane = tid & 63, r32 = lane & 31, hi = lane >> 5;
  bf16_t* V_lds = (bf16_t*)lds; bf16_t* K_lds = (bf16_t*)(lds + 2 * SHM_V);
  float* ws = (float*)(lds + 2 * SHM_V + 2 * SHM_K) + wid * 64; float* li_l = ws; float* al_l = ws + 32;
  float m_reg = -1e30f, l_reg = 0; f32x16 o[4] = {}; bf16x8 qr[8];
  const bf16_t* Qw = Qb + (long)(wid * QBLK + r32) * LDQ + hi * 8;
#pragma unroll
  for (int d0 = 0; d0 < 8; ++d0) qr[d0] = *reinterpret_cast<const bf16x8*>(Qw + d0 * 16);
  const int sr = tid >> 4, sc = (tid & 15) * 8, vst0 = v_st(sr, sc), vst1 = v_st(32 + sr, sc);
  const int vb0 = (int)(uintptr_t)V_lds + v_rd_base(lane);
  struct { bf16x8 vs0, vs1, ks0, ks1; } sr_[SDEPTH];
#define LD8(p) (*reinterpret_cast<const bf16x8*>(p))
  const unsigned kvoff = (unsigned)((sr * LDK + sc) * 2);
#define SLOAD(i, k0) do { const char* vb_ = (const char*)Vh + (size_t)(k0) * (LDK * 2); const char* kb_ = (const char*)Kh + (size_t)(k0) * (LDK * 2); \
    sr_[i].vs0 = LD8(vb_ + kvoff); sr_[i].vs1 = LD8(vb_ + 32 * LDK * 2 + kvoff); \
    sr_[i].ks0 = LD8(kb_ + kvoff); sr_[i].ks1 = LD8(kb_ + 32 * LDK * 2 + kvoff); } while (0)
#define SWRITE(b, i) do { *(bf16x8*)((char*)V_lds + (b) * SHM_V + vst0) = sr_[i].vs0;          \
    *(bf16x8*)((char*)V_lds + (b) * SHM_V + vst1) = sr_[i].vs1; int kc = sc * 2;               \
    *(bf16x8*)((char*)K_lds + (b) * SHM_K + KSWZ(sr, kc)) = sr_[i].ks0;                       \
    *(bf16x8*)((char*)K_lds + (b) * SHM_K + KSWZ(32 + sr, kc)) = sr_[i].ks1; } while (0)
#define SWAIT() do { if constexpr (SDEPTH == 2) asm volatile("s_waitcnt vmcnt(4)" ::: "memory"); else asm volatile("s_waitcnt vmcnt(0)" ::: "memory"); } while (0)
#define RESC(a) do { if (__any((a) < 1.f)) { if (hi == 0) al_l[r32] = (a); asm volatile("s_waitcnt lgkmcnt(0)" ::: "memory"); \
    for (int d = 0; d < 4; ++d) for (int r = 0; r < 16; ++r) o[d][r] *= al_l[crow(r, hi)]; } } while (0)
  f32x16 pA0, pA1, pB0, pB1; float mnA, mnB, alA, alB; bf16x8 pa0, pa1, pa2, pa3; const int NT = seq / KVBLK;
  constexpr int SE = 0, SO = SDEPTH - 1;
  SLOAD(SE, 0); asm volatile("s_waitcnt vmcnt(0)" ::: "memory"); SWRITE(0, SE); __syncthreads();
  qkt(pA0, pA1, K_lds, qr, r32, hi); partialSM(pA0, pA1, m_reg, mnA, alA);
  SLOAD(SO, KVBLK); if constexpr (SDEPTH == 2) { if (2 < NT) SLOAD(SE, 2 * KVBLK); }
  SWAIT(); SWRITE(1, SO); __syncthreads();
  for (int j = 1; j + 1 < NT; j += 2) {
    SBAR(); qkt(pB0, pB1, (bf16_t*)((char*)K_lds + SHM_K), qr, r32, hi);
    finishSM(pA0, pA1, alA, l_reg, pa0, pa1, pa2, pa3); SBAR();
    SLOAD(SO, (j + SDEPTH) * KVBLK); SBAR();
    pv_d0(o, vb0, pa0, pa1, pa2, pa3); partialSM(pB0, pB1, m_reg, mnB, alB);
    __syncthreads(); SWAIT(); SWRITE(0, SE);
    RESC(alB); __syncthreads();
    SBAR(); qkt(pA0, pA1, K_lds, qr, r32, hi);
    finishSM(pB0, pB1, alB, l_reg, pa0, pa1, pa2, pa3); SBAR();
    if (SDEPTH == 1 || j + 3 < NT) SLOAD(SE, (j + 1 + SDEPTH) * KVBLK); SBAR();
    pv_d0(o, vb0 + (int)SHM_V, pa0, pa1, pa2, pa3); partialSM(pA0, pA1, m_reg, mnA, alA);
    __syncthreads(); SWAIT(); SWRITE(1, SO);
    RESC(alA); __syncthreads();
  }
  SBAR(); qkt(pB0, pB1, (bf16_t*)((char*)K_lds + SHM_K), qr, r32, hi);
  finishSM(pA0, pA1, alA, l_reg, pa0, pa1, pa2, pa3); SBAR();
  pv_d0(o, vb0, pa0, pa1, pa2, pa3); partialSM(pB0, pB1, m_reg, mnB, alB);
  __syncthreads(); RESC(alB);
  finishSM(pB0, pB1, alB, l_reg, pa0, pa1, pa2, pa3); SBAR();
  pv_d0(o, vb0 + (int)SHM_V, pa0, pa1, pa2, pa3);
  if (hi == 0) li_l[r32] = l_reg; asm volatile("s_waitcnt lgkmcnt(0)" ::: "memory");
  float rli[16];
#pragma unroll
  for (int r = 0; r < 16; ++r) rli[r] = __builtin_amdgcn_rcpf(li_l[crow(r, hi)]);
  bf16_t* Ow = Ob + (long)(wid * QBLK) * LDO;
#pragma unroll
  for (int r = 0; r < 16; ++r) { int orow = crow(r, hi);
#pragma unroll
    for (int d0 = 0; d0 < 4; ++d0) Ow[(long)orow * LDO + d0 * 32 + r32] = f2bf(o[d0][r] * rli[r]); }
#undef LD8
#undef SLOAD
#undef SWRITE
#undef SWAIT
#undef RESC
}
}

struct RowJob {
    int row0, nrows, has_y, has_next, ldy;
    const bf16_t* Y; const float* gn_post; const float* modL; int gate_off;
    const float* xsrc_lat; const float* xsrc_ctx; float* xdst_lat; float* xdst_ctx;
    const float* gn_next; const float* modN; int shift_off, scale_off; bf16_t* H;
    const float* ypart;
    bf16_t* x16;
};
constexpr int RPW = 2;
__device__ __forceinline__ void wave_sumR(float (&v)[RPW]) {
#pragma unroll
    for (int o = 1; o < 64; o <<= 1) {
#pragma unroll
        for (int r = 0; r < RPW; ++r) v[r] += __shfl_xor(v[r], o);
    }
}
__device__ __forceinline__ void row_phase(const RowJob& J, int gw, int ngw, int lane) {
    const int has_y = J.has_y, has_next = J.has_next;
    f32x4 gnp[4], gnn[4];
#pragma unroll
    for (int j = 0; j < 4; ++j) { gnp[j] = *(const f32x4*)(J.gn_post + 4 * lane + 256 * j); gnn[j] = *(const f32x4*)(J.gn_next + 4 * lane + 256 * j); }
    for (int base = J.row0 + gw * RPW; base < J.nrows; base += ngw * RPW) {
        const bool lat = base < RL; const int bidx = lat ? (base >> 12) : 8;
        const float* xs = lat ? J.xsrc_lat + (size_t)base * DM : J.xsrc_ctx + (size_t)(base - RL) * DM;
        float* xd = lat ? J.xdst_lat + (size_t)base * DM : J.xdst_ctx + (size_t)(base - RL) * DM;
        f32x4 x[RPW][4]; u32x2 yw[RPW][4];
#pragma unroll
        for (int r = 0; r < RPW; ++r)
#pragma unroll
            for (int j = 0; j < 4; ++j) x[r][j] = *(const f32x4*)(xs + (size_t)r * DM + 4 * lane + 256 * j);
        if (has_y) {
            if (!lat && J.ypart != nullptr) {
                const float* pr = J.ypart + (size_t)(base - RL) * DM;
#pragma unroll
                for (int r = 0; r < RPW; ++r)
#pragma unroll
                    for (int j = 0; j < 4; ++j) { f32x4 a = *(const f32x4*)(pr + (size_t)r * DM + 4 * lane + 256 * j);
#pragma unroll
                        for (int k2 = 1; k2 < 4; ++k2) a = a + *(const f32x4*)(pr + ((size_t)k2 * RC + r) * DM + 4 * lane + 256 * j);
                        yw[r][j].x = cvt_pk_bf16(a[0], a[1]); yw[r][j].y = cvt_pk_bf16(a[2], a[3]); }
            } else {
                const bf16_t* yr = J.Y + (size_t)base * J.ldy;
#pragma unroll
                for (int r = 0; r < RPW; ++r)
#pragma unroll
                    for (int j = 0; j < 4; ++j) yw[r][j] = *(const u32x2*)(yr + (size_t)r * J.ldy + 4 * lane + 256 * j);
            }
        }
        f32x4 gt[4], sh[4], sc[4];
        {
            const float* gate = J.modL + bidx * 6144 + J.gate_off; const float* shp = J.modN + bidx * 6144 + J.shift_off; const float* scp = J.modN + bidx * 6144 + J.scale_off;
#pragma unroll
            for (int j = 0; j < 4; ++j) { gt[j] = *(const f32x4*)(gate + 4 * lane + 256 * j); sh[j] = *(const f32x4*)(shp + 4 * lane + 256 * j); sc[j] = *(const f32x4*)(scp + 4 * lane + 256 * j); }
        }
        if (has_y) {
            float ss[RPW];
#pragma unroll
            for (int r = 0; r < RPW; ++r) { float a = 0.f;
#pragma unroll
                for (int j = 0; j < 4; ++j) { const float y0 = bflo(yw[r][j].x), y1 = bfhi(yw[r][j].x), y2 = bflo(yw[r][j].y), y3 = bfhi(yw[r][j].y); a += (y0 * y0 + y1 * y1) + (y2 * y2 + y3 * y3); }
                ss[r] = a; }
            wave_sumR(ss);
#pragma unroll
            for (int r = 0; r < RPW; ++r) { const float rs = rsqrtf(ss[r] * (1.0f / DM) + NORM_EPS);
#pragma unroll
                for (int j = 0; j < 4; ++j) { const f32x4 y = (f32x4){bflo(yw[r][j].x), bfhi(yw[r][j].x), bflo(yw[r][j].y), bfhi(yw[r][j].y)};
                    x[r][j] = x[r][j] + gt[j] * ((y * rs) * gnp[j]); *(f32x4*)(xd + (size_t)r * DM + 4 * lane + 256 * j) = x[r][j]; } }
        }
        if (J.x16 != nullptr && lat) {
#pragma unroll
            for (int r = 0; r < RPW; ++r)
#pragma unroll
                for (int j = 0; j < 4; ++j) { u32x2 w; w.x = cvt_pk_bf16(x[r][j][0], x[r][j][1]); w.y = cvt_pk_bf16(x[r][j][2], x[r][j][3]); *(u32x2*)(J.x16 + (size_t)(base + r) * DM + 4 * lane + 256 * j) = w; }
        }
        if (has_next) {
            float ss[RPW];
#pragma unroll
            for (int r = 0; r < RPW; ++r) { float a = 0.f;
#pragma unroll
                for (int j = 0; j < 4; ++j) a += (x[r][j][0] * x[r][j][0] + x[r][j][1] * x[r][j][1]) + (x[r][j][2] * x[r][j][2] + x[r][j][3] * x[r][j][3]);
                ss[r] = a; }
            wave_sumR(ss);
            bf16_t* hr = J.H + (size_t)base * DM;
#pragma unroll
            for (int r = 0; r < RPW; ++r) { const float rs = rsqrtf(ss[r] * (1.0f / DM) + NORM_EPS);
#pragma unroll
                for (int j = 0; j < 4; ++j) { const f32x4 h = ((x[r][j] * rs) * gnn[j]) * (sc[j] + 1.0f) + sh[j]; u32x2 w; w.x = cvt_pk_bf16(h[0], h[1]); w.y = cvt_pk_bf16(h[2], h[3]);
                    *(u32x2*)(hr + (size_t)r * DM + 4 * lane + 256 * j) = w; } }
        }
    }
}

__device__ __forceinline__ void qkvpost_phase(const bf16_t* raw, const float* qg, const float* kg, bf16_t* Q, bf16_t* Kb, bf16_t* Vb, int gw, int ngw, int lane) {
    const int l32 = lane & 31, d0 = 4 * l32; const bool lower = l32 < 16;
    const f32x4 qgv = *(const f32x4*)(qg + d0), kgv = *(const f32x4*)(kg + d0);
    f32x4 inv;
#pragma unroll
    for (int e = 0; e < 4; ++e) inv[e] = exp2f(-(float)((d0 + e) & 31) * (13.287712379549449f / 32.0f));
    const bool rowfreq = ((d0 & 63) < 32);
    for (int base = gw * 2; base < RT; base += ngw * 2) {
        const bool lat = base < RL;
        u32x2 qw[2][4], kw[2], vw[2];
#pragma unroll
        for (int r = 0; r < 2; ++r) { const bf16_t* rr = raw + (size_t)(base + r) * 1536 + 4 * lane;
            if (lat) {
#pragma unroll
                for (int c = 0; c < 4; ++c) qw[r][c] = *(const u32x2*)(rr + c * 256);
            }
            kw[r] = *(const u32x2*)(rr + 1024); vw[r] = *(const u32x2*)(rr + 1280); }
        f32x4 xv[2][5]; float ss[2][5];
#pragma unroll
        for (int r = 0; r < 2; ++r)
#pragma unroll
            for (int c = 0; c < 5; ++c) { const u32x2 w = (c < 4) ? qw[r][c] : kw[r];
                xv[r][c] = (f32x4){bflo(w.x), bfhi(w.x), bflo(w.y), bfhi(w.y)};
                ss[r][c] = (xv[r][c][0] * xv[r][c][0] + xv[r][c][1] * xv[r][c][1]) + (xv[r][c][2] * xv[r][c][2] + xv[r][c][3] * xv[r][c][3]); }
#pragma unroll
        for (int o = 1; o < 32; o <<= 1)
#pragma unroll
            for (int r = 0; r < 2; ++r)
#pragma unroll
                for (int c = 0; c < 5; ++c) if (c == 4 || lat) ss[r][c] += __shfl_xor(ss[r][c], o);
        const f32x4 sgn = lower ? (f32x4){-1.f, -1.f, -1.f, -1.f} : (f32x4){1.f, 1.f, 1.f, 1.f};
#pragma unroll
        for (int r = 0; r < 2; ++r) {
            const int row = base + r; const int b = lat ? (row >> 12) : ((row - RL) >> 8); const int t = lat ? (row & 4095) : ((row - RL) & 255);
            const int pos = lat ? (CTXL + t) : t;
            f32x4 cs = (f32x4){1.f, 1.f, 1.f, 1.f}, sn = (f32x4){0.f, 0.f, 0.f, 0.f};
            if (lat) { const float p = rowfreq ? (float)(t >> 6) : (float)(t & 63);
#pragma unroll
                for (int e = 0; e < 4; ++e) { float rev = (p * inv[e]) * 0.15915494309189535f; rev -= floorf(rev); sn[e] = __builtin_amdgcn_sinf(rev); cs[e] = __builtin_amdgcn_cosf(rev); } }
            f32x4 y[5], pr[5];
#pragma unroll
            for (int c = 0; c < 5; ++c) { const float rs = rsqrtf(ss[r][c] * (1.0f / 128.0f) + NORM_EPS); y[c] = (xv[r][c] * rs) * (c < 4 ? qgv : kgv); }
#pragma unroll
            for (int c = 0; c < 5; ++c) if (c == 4 || lat) {
#pragma unroll
                for (int e = 0; e < 4; ++e) pr[c][e] = __shfl_xor(y[c][e], 16); }
            const size_t kvoff = ((size_t)b * SKV + pos) * 256 + 4 * lane;
#pragma unroll
            for (int c = 0; c < 5; ++c) if (c == 4 || lat) {
                const f32x4 o4 = y[c] * cs + (pr[c] * sn) * sgn;
                u32x2 ow; ow.x = cvt_pk_bf16(o4[0], o4[1]); ow.y = cvt_pk_bf16(o4[2], o4[3]);
                if (c < 4) *(u32x2*)(Q + (size_t)row * 1024 + c * 256 + 4 * lane) = ow; else *(u32x2*)(Kb + kvoff) = ow; }
            *(u32x2*)(Vb + kvoff) = vw[r];
        }
    }
}

constexpr int KF = 2304;
__device__ __forceinline__ void fold_phase(const bf16_t* H, bf16_t* Z, bf16_t* DFTL, int gw, int ngw, int lane) {
    for (int zr = gw; zr < NBATCH * ZJ; zr += ngw) {
        const int b = zr / ZJ, j = zr % ZJ;
        int n1 = -1, n2 = -1; float sgn = 1.f;
        if (j < 2048) { n1 = j; if (j > 0) n2 = SEQ - j; }
        else if (j == 2048) { n1 = 2048; }
        else if (j >= KF) { const int n = j - KF; if (n > 0) { n1 = n; n2 = SEQ - n; sgn = -1.f; } }
#pragma unroll
        for (int q = 0; q < 2; ++q) {
            const int col = 8 * lane + 512 * q; unsigned z0; asm volatile("v_mov_b32 %0, 0" : "=v"(z0)); u32x4 o = (u32x4){z0, z0, z0, z0};
            if (n1 >= 0) {
                const u32x4 a = *(const u32x4*)(H + ((size_t)b * SEQ + n1) * DM + col);
                if (n2 >= 0) { const u32x4 c = *(const u32x4*)(H + ((size_t)b * SEQ + n2) * DM + col);
#pragma unroll
                    for (int e = 0; e < 4; ++e) o[e] = cvt_pk_bf16(bflo(a[e]) + sgn * bflo(c[e]), bfhi(a[e]) + sgn * bfhi(c[e])); }
                else o = a;
            }
            *(u32x4*)(Z + (size_t)zr * DM + col) = o;
        }
    }
    for (int k = gw; k < SEQ / 2; k += ngw) {
        for (int jb = lane; jb < ZJ / 8; jb += 64) {
            float v[8];
#pragma unroll
            for (int e = 0; e < 8; ++e) { const int j = jb * 8 + e; float val;
                if (j < 2048) val = __builtin_amdgcn_cosf((float)((k * j) & 4095) * (1.0f / 4096.0f));
                else if (j == 2048) val = (k & 1) ? -1.f : 1.f;
                else if (j < KF) val = 0.f;
                else val = __builtin_amdgcn_sinf((float)((k * (j - KF)) & 4095) * (1.0f / 4096.0f));
                v[e] = val; }
            u32x4 o; o.x = cvt_pk_bf16(v[0], v[1]); o.y = cvt_pk_bf16(v[2], v[3]); o.z = cvt_pk_bf16(v[4], v[5]); o.w = cvt_pk_bf16(v[6], v[7]);
            *(u32x4*)(DFTL + (size_t)k * ZJ + jb * 8) = o;
        }
    }
}
__device__ __forceinline__ void combine_phase(const bf16_t* PAB, const bf16_t* RTp, bf16_t* Yf, int gw, int ngw, int lane) {
    const float sc = 1.0f / 1024.0f;
    for (int r = gw; r < NBATCH * 2048; r += ngw) {
        const int b = r >> 11, k = r & 2047;
        const bf16_t* pa = PAB + ((size_t)(b * 2 + 0) * 2048 + k) * DM; const bf16_t* pb = PAB + ((size_t)(b * 2 + 1) * 2048 + k) * DM;
        bf16_t* y0 = Yf + ((size_t)b * SEQ + k) * DM; bf16_t* y1 = Yf + ((size_t)b * SEQ + (SEQ - k)) * DM;
#pragma unroll
        for (int q = 0; q < 2; ++q) { const int col = 8 * lane + 512 * q;
            const u32x4 a = *(const u32x4*)(pa + col), c = *(const u32x4*)(pb + col); u32x4 om, op;
#pragma unroll
            for (int e = 0; e < 4; ++e) { const float a0 = bflo(a[e]), a1 = bfhi(a[e]), c0 = bflo(c[e]), c1 = bfhi(c[e]);
                om[e] = cvt_pk_bf16((a0 - c0) * sc, (a1 - c1) * sc); op[e] = cvt_pk_bf16((a0 + c0) * sc, (a1 + c1) * sc); }
            *(u32x4*)(y0 + col) = om; if (k > 0) *(u32x4*)(y1 + col) = op; }
    }
    for (int t = gw; t < NBATCH * 1024; t += ngw) {
        const int b = t >> 10, m = t & 1023; const bf16_t* rr = RTp + ((size_t)b * 1024 + m) * ZJ; float s = 0.f;
#pragma unroll
        for (int c4 = 0; c4 < 4; ++c4) { const u32x4 w = *(const u32x4*)(rr + (c4 * 64 + lane) * 8);
#pragma unroll
            for (int e = 0; e < 4; ++e) s += bflo(w[e]) - bfhi(w[e]); }
        s = wave_sum(s);
        if (lane == 0) { const float ny = __uint_as_float((unsigned)rr[2048] << 16); Yf[((size_t)b * SEQ + 2048) * DM + m] = f2bf((s + ny) * sc); }
    }
}

__device__ __forceinline__ void spatial_phase(LAS unsigned char* lds, bf16_t* BIGp, const float* stats, const bf16_t* aws, const float* ln_g, const float* b_s, int nchunks, const int tid) {
    const int wid = tid >> 6, lane = tid & 63, fr = lane & 15, fq = lane >> 4;
    constexpr int LDP = 136;
    LAS bf16_t* Wl = (LAS bf16_t*)lds;
    LAS bf16_t* Vt = (LAS bf16_t*)(lds + 128 * LDP * 2);
    LAS float* St = (LAS float*)(lds + (128 + 256) * LDP * 2);
    const int G = gridDim.x, c = blockIdx.x;
    const bool fixed_g = (G % 8) == 0;
    const int per_g = fixed_g ? G / 8 : 1;
    int gcur = -1;
    bf16x8 af[4]; float bias = 0.f;
    for (int i = 0; ; ++i) {
        int ch, g;
        if (fixed_g) { g = c & 7; ch = (c >> 3) + per_g * i; if (ch >= nchunks) break; }
        else { const int u = c + G * i; if (u >= nchunks * 8) break; ch = u >> 3; g = u & 7; }
        u32x4 vw[8];
#pragma unroll
        for (int it = 0; it < 8; ++it) { const int id = it * 512 + tid, ql = id & 15, cb = (id >> 4) & 31, q = (id >> 9) * 16 + ql;
            vw[it] = *(const u32x4*)(BIGp + (size_t)(ch * 128 + q) * 4096 + 2048 + g * 256 + cb * 8); }
        const int prow = ch * 128 + 16 * wid + fr;
        bf16_t* const ubase = BIGp + (size_t)prow * 4096 + g * 256 + 8 * fq;
        u32x4 uw[8];
#pragma unroll
        for (int j = 0; j < 8; ++j) uw[j] = *(const u32x4*)(ubase + 32 * j);
        if (g != gcur) {
#pragma unroll
            for (int it = 0; it < 4; ++it) { const int id = it * 512 + tid, p = id >> 4, kc = id & 15;
                *(LAS u32x4*)(Wl + p * LDP + kc * 8) = *(const u32x4*)(aws + ((size_t)g * 128 + p) * 128 + kc * 8); }
        }
        if (tid < 128) { const float* sp = stats + (size_t)(ch * 128 + tid) * 64; float a = 0.f, q = 0.f;
#pragma unroll
            for (int k2 = 0; k2 < 32; ++k2) { a += sp[2 * k2]; q += sp[2 * k2 + 1]; }
            const float mu = a * (1.0f / 2048.0f); const float var = q * (1.0f / 2048.0f) - mu * mu;
            St[2 * tid] = mu; St[2 * tid + 1] = rsqrtf(fmaxf(var, 0.f) + LN_EPS); }
        __syncthreads();
        if (g != gcur) {
#pragma unroll
            for (int ks = 0; ks < 4; ++ks) af[ks] = *(const LAS bf16x8*)(Wl + (16 * wid + fr) * LDP + 32 * ks + 8 * fq);
            bias = b_s[g * 128 + 16 * wid + fr]; gcur = g;
        }
#pragma unroll
        for (int it = 0; it < 8; ++it) { const int id = it * 512 + tid, ql = id & 15, cb = (id >> 4) & 31, q = (id >> 9) * 16 + ql, c0 = cb * 8;
            const u32x4 w = vw[it];
            const float mu = St[2 * q], rs = St[2 * q + 1];
            const f32x4 g0 = *(const f32x4*)(ln_g + g * 256 + c0), g1 = *(const f32x4*)(ln_g + g * 256 + c0 + 4);
            const float v[8] = {bflo(w.x), bfhi(w.x), bflo(w.y), bfhi(w.y), bflo(w.z), bfhi(w.z), bflo(w.w), bfhi(w.w)};
#pragma unroll
            for (int e = 0; e < 8; ++e) { const float gg = e < 4 ? g0[e] : g1[e - 4]; Vt[(c0 + e) * LDP + q] = f2bf((v[e] - mu) * rs * gg); } }
        __syncthreads();
#pragma unroll
        for (int j = 0; j < 8; ++j) {
            f32x4 a0 = (f32x4){0.f, 0.f, 0.f, 0.f}, a1 = a0;
            const int cr = 32 * j + 8 * (fr >> 2) + (fr & 3);
#pragma unroll
            for (int ks = 0; ks < 4; ++ks) {
                const bf16x8 b0 = *(const LAS bf16x8*)(Vt + cr * LDP + 32 * ks + 8 * fq), b1 = *(const LAS bf16x8*)(Vt + (cr + 4) * LDP + 32 * ks + 8 * fq);
                a0 = __builtin_amdgcn_mfma_f32_16x16x32_bf16(b0, af[ks], a0, 0, 0, 0); a1 = __builtin_amdgcn_mfma_f32_16x16x32_bf16(b1, af[ks], a1, 0, 0, 0); }
            const u32x4 u4 = uw[j];
            u32x4 o;
            o.x = cvt_pk_bf16(bflo(u4.x) * (a0[0] + bias), bfhi(u4.x) * (a0[1] + bias)); o.y = cvt_pk_bf16(bflo(u4.y) * (a0[2] + bias), bfhi(u4.y) * (a0[3] + bias));
            o.z = cvt_pk_bf16(bflo(u4.z) * (a1[0] + bias), bfhi(u4.z) * (a1[1] + bias)); o.w = cvt_pk_bf16(bflo(u4.w) * (a1[2] + bias), bfhi(u4.w) * (a1[3] + bias));
            *(u32x4*)(ubase + 32 * j) = o;
        }
        __syncthreads();
    }
}

template <bool QKPERM> __device__ __forceinline__ void p0_transpose_item(const float* W, int K, int N, bf16_t* WT, LAS float* scr, int item, int lane) {
    const int nblk = N / 32, kb = item / nblk, nb = item % nblk, k0 = 64 * kb, n0 = 32 * nb;
    {
        const int kr = lane >> 3, nc = (lane & 7) * 4; f32x4 v[8];
        int src = n0 + nc;
        if (QKPERM && src < 1280) { const int p = src & 127; src = (src & ~127) + 16 * (p >> 5) + 4 * ((p >> 3) & 3) + 64 * ((p >> 2) & 1); }
#pragma unroll
        for (int i = 0; i < 8; ++i) v[i] = *(const f32x4*)(W + (size_t)(k0 + 8 * i + kr) * N + src);
#pragma unroll
        for (int i = 0; i < 8; ++i) {
#pragma unroll
            for (int e = 0; e < 4; ++e) scr[(8 * i + kr) * 33 + nc + e] = v[i][e]; }
    }
    asm volatile("s_waitcnt lgkmcnt(0)" ::: "memory");
    const int c = lane & 7;
#pragma unroll
    for (int j = 0; j < 4; ++j) { const int n = (lane >> 3) + 8 * j; const LAS float* s = scr + (8 * c) * 33 + n;
        u32x4 o; o.x = cvt_pk_bf16(s[0 * 33], s[1 * 33]); o.y = cvt_pk_bf16(s[2 * 33], s[3 * 33]); o.z = cvt_pk_bf16(s[4 * 33], s[5 * 33]); o.w = cvt_pk_bf16(s[6 * 33], s[7 * 33]);
        *(u32x4*)(WT + (size_t)(n0 + n) * K + k0 + 8 * c) = o; }
    asm volatile("s_waitcnt lgkmcnt(0)" ::: "memory");
}

struct Params { const float* in[19]; float* out; unsigned char* ws; int ph_lo, ph_hi; };
constexpr int LDS_PAR_OFF = 131072, LDS_BARST_OFF = 131072 + 256, LDS_JOB_OFF = 131072 + 320;
struct PView {
    LAS const unsigned char* base;
    __device__ __forceinline__ const float* in(int i) const { return pg8::jptr<const float>(base + 8 * i); }
    __device__ __forceinline__ float* out() const { return pg8::jptr<float>(base + 8 * 19); }
    __device__ __forceinline__ unsigned char* wsp() const { return pg8::jptr<unsigned char>(base + 8 * 20); }
};

__device__ __forceinline__ void prologue_phase(const PView& P, LAS unsigned char* lds, const int tid) {
    const int wid = tid >> 6, lane = tid & 63;
    unsigned char* ws = P.wsp();
    {
        LAS float* sl = (LAS float*)lds;
        LAS float* red = (LAS float*)(lds + 36864);
        float* MOD = (float*)(ws + WS_MOD);
        for (int item = blockIdx.x; item < 192; item += gridDim.x) {
            const int layer = item / 48, col0 = (item % 48) * 128;
            for (int idx = tid; idx < 9216; idx += 512) { const int r = idx >> 10, k = idx & 1023; const float v = r < 8 ? P.in(1)[r * 1024 + k] : P.in(3)[k]; sl[idx] = v / (1.0f + __expf(-v)); }
            __syncthreads();
            const int ks = tid >> 5, c4 = tid & 31;
            const float* w = P.in(4) + ((size_t)layer * 1024 + ks * 64) * 6144 + col0 + c4 * 4;
            f32x4 acc[9];
#pragma unroll
            for (int r = 0; r < 9; ++r) acc[r] = (f32x4){0.f, 0.f, 0.f, 0.f};
#pragma unroll 16
            for (int kk = 0; kk < 64; ++kk) { const f32x4 wv = *(const f32x4*)(w + (size_t)kk * 6144);
#pragma unroll
                for (int r = 0; r < 9; ++r) acc[r] = acc[r] + wv * sl[r * 1024 + ks * 64 + kk]; }
#pragma unroll
            for (int r = 0; r < 9; ++r) *(LAS f32x4*)(red + (ks * 9 + r) * 128 + c4 * 4) = acc[r];
            __syncthreads();
            for (int idx = tid; idx < 9 * 128; idx += 512) { const int r = idx >> 7, cc = idx & 127; float s = P.in(5)[layer * 6144 + col0 + cc];
#pragma unroll
                for (int k2 = 0; k2 < 16; ++k2) s += red[(k2 * 9 + r) * 128 + cc];
                MOD[(size_t)(layer * 9 + r) * 6144 + col0 + cc] = s; }
            __syncthreads();
        }
    }
    {
        LAS float* scr = (LAS float*)(lds + wid * 8448);
        const int gw = blockIdx.x * 8 + wid, ngw = gridDim.x * 8;
        constexpr int I_W1 = 16 * 128, I_W2 = 64 * 32, I_AIN = 16 * 128, I_AOUT = 32 * 32, I_BO = 16 * 32, I_QKV = 16 * 48, I_WO = 16 * 32;
        constexpr int NITEMS = 4 * I_W1 + 4 * I_W2 + 2 * I_AIN + 2 * I_AOUT + I_BO + I_QKV + I_WO;
        for (int it = gw; it < NITEMS; it += ngw) {
            int r = it;
            if (r < 4 * I_W1) { const int l = r / I_W1; p0_transpose_item<false>(P.in(7) + (size_t)l * 1024 * 4096, 1024, 4096, (bf16_t*)(ws + WS_W1T) + (size_t)l * 4096 * 1024, scr, r % I_W1, lane); continue; } r -= 4 * I_W1;
            if (r < 4 * I_W2) { const int l = r / I_W2; p0_transpose_item<false>(P.in(8) + (size_t)l * 4096 * 1024, 4096, 1024, (bf16_t*)(ws + WS_W2T) + (size_t)l * 1024 * 4096, scr, r % I_W2, lane); continue; } r -= 4 * I_W2;
            if (r < 2 * I_AIN) { const int l = r / I_AIN; p0_transpose_item<false>(P.in(9) + (size_t)l * 1024 * 4096, 1024, 4096, (bf16_t*)(ws + WS_AWINT) + (size_t)l * 4096 * 1024, scr, r % I_AIN, lane); continue; } r -= 2 * I_AIN;
            if (r < 2 * I_AOUT) { const int l = r / I_AOUT; p0_transpose_item<false>(P.in(13) + (size_t)l * 2048 * 1024, 2048, 1024, (bf16_t*)(ws + WS_AWOUTT) + (size_t)l * 1024 * 2048, scr, r % I_AOUT, lane); continue; } r -= 2 * I_AOUT;
            if (r < I_BO) { p0_transpose_item<false>(P.in(14), 1024, 1024, (bf16_t*)(ws + WS_BWOUTT), scr, r, lane); continue; } r -= I_BO;
            if (r < I_QKV) { p0_transpose_item<false>(P.in(15), 1024, 1536, (bf16_t*)(ws + WS_QKVT), scr, r, lane); continue; } r -= I_QKV;
            p0_transpose_item<false>(P.in(18), 1024, 1024, (bf16_t*)(ws + WS_WOT), scr, r, lane);
        }
    }
    {
        const int gt = blockIdx.x * 512 + tid, ngt = gridDim.x * 512;
        bf16_t* aws = (bf16_t*)(ws + WS_AWS);
        for (int i = gt; i < 2 * 8 * 128 * 128 / 8; i += ngt) { const f32x4 a = *(const f32x4*)(P.in(11) + (size_t)i * 8), b = *(const f32x4*)(P.in(11) + (size_t)i * 8 + 4);
            u32x4 o; o.x = cvt_pk_bf16(a[0], a[1]); o.y = cvt_pk_bf16(a[2], a[3]); o.z = cvt_pk_bf16(b[0], b[1]); o.w = cvt_pk_bf16(b[2], b[3]); *(u32x4*)(aws + (size_t)i * 8) = o; }
        bf16_t* cc = (bf16_t*)(ws + WS_CC); bf16_t* scm = (bf16_t*)(ws + WS_SC); bf16_t* dc = (bf16_t*)(ws + WS_DFTC);
        for (int i = gt; i < 65536; i += ngt) { const int m = i >> 8, c = i & 255; const float rev = (float)((m * c) & 255) * (1.0f / 256.0f);
            cc[i] = f2bf(__builtin_amdgcn_cosf(rev)); scm[i] = f2bf(__builtin_amdgcn_sinf(rev)); }
        for (int i = gt; i < 131072; i += ngt) { const int k = i >> 9, j = i & 511; const int n = j & 255; const float rev = (float)((k * n) & 255) * (1.0f / 256.0f);
            dc[i] = f2bf(j < 256 ? __builtin_amdgcn_cosf(rev) : -__builtin_amdgcn_sinf(rev)); }
    }
}


#define XB_TMO      128
#define XB_XCNT(j)  (256  + 64 * (j))
#define XB_XSUB(j)  (1280 + 64 * (j))
#define XB_XGEN(j)  (2304 + 64 * (j))
#define XB_TOP      3328
#define XB_TOPGEN   3392
#define XCD_BAR_WORDS 3456
#define XB_SPIN_CAP (1u << 18)
__device__ __forceinline__ unsigned xb_ld(unsigned* p)              { return __hip_atomic_load(p, __ATOMIC_RELAXED, __HIP_MEMORY_SCOPE_AGENT); }
__device__ __forceinline__ unsigned xb_add(unsigned* p, unsigned v) { return __hip_atomic_fetch_add(p, v, __ATOMIC_RELAXED, __HIP_MEMORY_SCOPE_AGENT); }
__device__ __forceinline__ unsigned xb_xcc_id() { return (unsigned)__builtin_amdgcn_s_getreg((3 << 11) | 20) & 0xFu; }
#define XB_SPIN(cond, bar) do { unsigned _sp = 0; while (cond) { __builtin_amdgcn_s_sleep(1); \
    if ((++_sp & 255u) == 0u) { if (xb_ld(&(bar)[XB_TMO])) break; if (_sp > XB_SPIN_CAP) { atomicAdd(&(bar)[XB_TMO], 1u); break; } } } } while (0)
struct XcdBarrier { unsigned* bar; unsigned x; volatile LAS unsigned* st; };
__device__ __forceinline__ XcdBarrier xcd_barrier_post(unsigned* bar, volatile LAS unsigned* st) {
    XcdBarrier b; b.bar = bar; b.x = xb_xcc_id(); b.st = st;
    if (threadIdx.x == 0) (void)xb_add(&bar[XB_XCNT(b.x)], 1u);
    return b;
}
__device__ __forceinline__ void xcd_barrier_complete(unsigned* bar, unsigned x, unsigned& nloc, unsigned& nx) {
    const unsigned G = gridDim.x * gridDim.y * gridDim.z;
    unsigned sum, cnt, mine, sp = 0u;
    for (;;) {
        sum = 0u; cnt = 0u; mine = 0u;
#pragma unroll
        for (unsigned j = 0; j < 16; ++j) { const unsigned c = xb_ld(&bar[XB_XCNT(j)]); sum += c; cnt += (c > 0u) ? 1u : 0u; mine = (j == x) ? c : mine; }
        if (sum == G) break;
        __builtin_amdgcn_s_sleep(1);
        if ((++sp & 255u) == 0u) { if (xb_ld(&bar[XB_TMO])) break; if (sp > XB_SPIN_CAP) { atomicAdd(&bar[XB_TMO], 1u); break; } }
    }
    nloc = mine > 0u ? mine : 1u; nx = cnt > 0u ? cnt : 1u;
}
__device__ __forceinline__ void xcd_barrier(const XcdBarrier& b) {
    asm volatile("s_waitcnt vmcnt(0)" ::: "memory");
    __syncthreads();
    if (threadIdx.x == 0) {
        unsigned* bar = b.bar;
        __builtin_amdgcn_s_waitcnt(0);
        unsigned nloc = b.st[0], nx = b.st[1];
        if (nloc == 0u) { xcd_barrier_complete(bar, b.x, nloc, nx); b.st[0] = nloc; b.st[1] = nx; }
        const unsigned old = xb_add(&bar[XB_XSUB(b.x)], 1u);
        const unsigned gen = old / nloc;
        if (old + 1u == (gen + 1u) * nloc) {
            __builtin_amdgcn_fence(__ATOMIC_RELEASE, "agent");
            asm volatile("s_waitcnt vmcnt(0)" ::: "memory");
            const unsigned og = xb_add(&bar[XB_TOP], 1u);
            const unsigned tg = og / nx;
            if (og + 1u == (tg + 1u) * nx) xb_add(&bar[XB_TOPGEN], 1u);
            else XB_SPIN(xb_ld(&bar[XB_TOPGEN]) == tg, bar);
            __builtin_amdgcn_fence(__ATOMIC_ACQUIRE, "agent");
            xb_add(&bar[XB_XGEN(b.x)], 1u);
            asm volatile("s_waitcnt vmcnt(0)" ::: "memory");
        } else {
            XB_SPIN(xb_ld(&bar[XB_XGEN(b.x)]) == gen, bar);
            __builtin_amdgcn_fence(__ATOMIC_ACQUIRE, "agent");
            asm volatile("s_waitcnt vmcnt(0)" ::: "memory");
        }
    }
    __syncthreads();
}

enum { K_PRO = 0, K_ROW, K_GEMM, K_SPATIAL, K_FOLD, K_QKVPOST, K_ATTN, K_NONE };
constexpr int NPH = 34;

__device__ __forceinline__ GJob mkgemm(const bf16_t* A, int lda, const bf16_t* B, int ldb, void* C, int ldc, int M, int N, int K, int act, int out_f32) {
    int z; asm volatile("v_mov_b32 %0, 0" : "=v"(z));
    GJob g; g.A = A; g.A2 = A; g.a2mask = (unsigned)z; g.lda = lda; g.B = B; g.b_bs_hi = z; g.b_bs_lo = z; g.bdiv = 1; g.b_pn_mod = 1 << 20; g.ldb = ldb;
    g.C = C; g.c_bs = z; g.ldc = ldc; g.out_f32 = out_f32; g.act = act; g.scale = 1.0f; g.stats = (float*)(size_t)z; g.stats_pn0 = z; g.nM = M / 256; g.nN = N / 256; g.nB = 1; g.K = K; g.part = (float*)(size_t)z; g.split_pm0 = 1 << 20; g.ksplit = 1; g.fused = z; g.has_next = z; g.gate_off = z; g.shift_off = z; g.scale_off = z; g.x_mode = z;
    g.xsrc = (const float*)(size_t)z; g.xdst = (float*)(size_t)z; g.Hout = (bf16_t*)(size_t)z; g.gn_post = g.xsrc; g.gn_next = g.xsrc; g.modL = g.xsrc; g.modN = g.xsrc; g.slot1 = (unsigned*)(size_t)z; g.slot2 = g.slot1; g.cnt1 = g.slot1; g.cnt2 = g.slot1; g.kf = z; g.dry = z; g.Kd = g.Hout; g.Vd = g.Hout; g.qg = g.xsrc; g.kg = g.xsrc; return g;
}
__device__ __forceinline__ RowJob mkrow(const PView& P, int layer, int which, int nrows, const bf16_t* Y, bf16_t* H) {
    unsigned char* ws = P.wsp();
    const float* norm_g = P.in(6); const float* MOD = (const float*)(ws + WS_MOD); float* out = P.out(); float* XC = (float*)((unsigned char*)out + OUT_XC);
    RowJob r; r.row0 = (which != 0) ? RL : 0; r.nrows = nrows; r.has_y = which != 0; r.ldy = DM; r.Y = Y; r.H = H;
    r.ypart = (which != 0 && layer <= 1) ? (const float*)((unsigned char*)out + OUT_PART) : nullptr;
    r.x16 = (which == 0) ? (bf16_t*)(ws + WS_X16) : nullptr;
    r.modL = MOD + (size_t)layer * 9 * 6144; r.gn_post = norm_g + (layer * 4 + (which == 1 ? 1 : 3)) * DM; r.gate_off = (which == 1 ? 2 : 5) * DM;
    const bool first = (layer == 0 && which <= 1);
    r.xsrc_lat = first ? P.in(0) : out; r.xsrc_ctx = first ? P.in(2) : XC; r.xdst_lat = out; r.xdst_ctx = XC;
    if (which == 0) { r.has_next = 1; r.gn_next = norm_g + (layer * 4 + 0) * DM; r.modN = r.modL; r.shift_off = 0; r.scale_off = DM; }
    else if (which == 1) { r.has_next = 1; r.gn_next = norm_g + (layer * 4 + 2) * DM; r.modN = r.modL; r.shift_off = 3 * DM; r.scale_off = 4 * DM; }
    else { r.has_next = layer < 3; const int nl = layer < 3 ? layer + 1 : layer; r.gn_next = norm_g + (nl * 4 + 0) * DM; r.modN = MOD + (size_t)nl * 9 * 6144; r.shift_off = 0; r.scale_off = DM; }
    return r;
}

__device__ __forceinline__ void phase_info(int ph, int& kind, int& sync, int& a, int& rows) {
    kind = K_GEMM; sync = 1; a = 0; rows = RT;
    switch (ph) {
        case 0: kind = K_PRO; break;
        case 1: kind = K_ROW; a = 0; break;
        case 3: kind = K_SPATIAL; a = 0; rows = RT; break;
        case 28: kind = K_SPATIAL; a = 1; rows = RL; break;
        case 5: kind = K_ROW; a = 1; break;
        case 8: kind = K_ROW; a = 2; sync = 0; break;
        case 9: kind = K_FOLD; break;
        case 10: sync = 0; break;
        case 12: sync = 0; break;
        case 15: kind = K_ROW; a = 3; break;
        case 18: kind = K_ROW; a = 4; break;
        case 20: kind = K_QKVPOST; break;
        case 21: kind = K_ATTN; break;
        case 23: case 26: case 30: case 33: kind = K_NONE; sync = 0; break;
        case 32: sync = 0; break;
        default: break;
    }
}
__device__ __forceinline__ GJob gemm_job(int ph, const PView& P) {
    unsigned char* ws = P.wsp();
    bf16_t* YH = (bf16_t*)(ws + WS_YH); unsigned char* BIG = ws + WS_BIG; bf16_t* BIGb = (bf16_t*)BIG; float* STATS = (float*)((unsigned char*)P.out() + OUT_STATS);
    GJob g = mkgemm(YH, DM, YH, DM, YH, DM, 256, 256, 256, 0, 0);
    int up_layer = -1, down_layer = -1, rows = RT;
    switch (ph) {
        case 2: case 27: { const int j = ph == 2 ? 0 : 1; rows = ph == 2 ? RT : RL;
            g = mkgemm(YH, DM, (const bf16_t*)(ws + WS_AWINT) + (size_t)j * 4096 * 1024, DM, BIGb, 4096, rows, 4096, 1024, 1, 0); g.stats = STATS; g.stats_pn0 = 8; break; }
        case 4: case 29: { const int j = ph == 4 ? 0 : 1; rows = ph == 4 ? RT : RL;
            g = mkgemm(BIGb, 4096, (const bf16_t*)(ws + WS_AWOUTT) + (size_t)j * 1024 * 2048, 2048, YH, DM, rows, 1024, 2048, 0, 0); break; }
        case 6: up_layer = 0; rows = RT; break;
        case 7: down_layer = 0; rows = RT; break;
        case 16: up_layer = 1; rows = RT; break;
        case 17: down_layer = 1; rows = RT; break;
        case 24: up_layer = 2; rows = RL; break;
        case 25: down_layer = 2; rows = RL; break;
        case 31: up_layer = 3; rows = RL; break;
        case 32: down_layer = 3; rows = RL; break;
        case 10: { g = mkgemm((const bf16_t*)(ws + WS_CC), 256, (const bf16_t*)(BIG + BIG_Z), DM, BIG + BIG_RT, ZJ, 256, ZJ, 256, 0, 0);
            g.A2 = (const bf16_t*)(ws + WS_SC); g.a2mask = 0x1FE00u; g.nB = 32; g.bdiv = 4; g.b_bs_hi = ZJ * DM; g.b_bs_lo = 256; g.c_bs = 256 * ZJ; break; }
        case 11: { g = mkgemm((const bf16_t*)(ws + WS_CC), 256, YH + (size_t)RL * DM, DM, BIG + BIG_RTC, 512, 256, 512, 256, 0, 0);
            g.A2 = (const bf16_t*)(ws + WS_SC); g.a2mask = 0x2u; g.nB = 32; g.bdiv = 4; g.b_bs_hi = CTXL * DM; g.b_bs_lo = 256; g.b_pn_mod = 1; g.c_bs = 256 * 512; break; }
        case 12: { g = mkgemm((const bf16_t*)(BIG + BIG_DFTL), ZJ, (const bf16_t*)(BIG + BIG_RT), ZJ, BIG + BIG_Y2, DM, SEQ / 2, 1024, ZJ, 0, 0);
            g.nB = 16; g.bdiv = 2; g.b_bs_hi = 1024 * ZJ; g.b_bs_lo = KF; g.c_bs = (SEQ / 2) * DM; g.kf = KF; break; }
        case 13: { g = mkgemm((const bf16_t*)(ws + WS_DFTC), 512, (const bf16_t*)(BIG + BIG_RTC), 512, YH + (size_t)RL * DM, DM, CTXL, 1024, 512, 0, 0);
            g.nB = 8; g.b_bs_hi = 1024 * 512; g.c_bs = CTXL * DM; g.scale = 1.0f / 256.0f; break; }
        case 14: g = mkgemm(YH, DM, (const bf16_t*)(ws + WS_BWOUTT), DM, BIG + BIG_Y2, DM, RT, 1024, 1024, 0, 0); break;
        case 19: g = mkgemm(YH, DM, (const bf16_t*)(ws + WS_QKVT), DM, BIG + BIG_RAW, 1536, RT, 1536, 1024, 0, 0); break;
        case 22: g = mkgemm((const bf16_t*)(BIG + BIG_O), DM, (const bf16_t*)(ws + WS_WOT), DM, YH, DM, RL, 1024, 1024, 0, 0); break;
        default: break;
    }
    if (down_layer >= 0 && rows == RT) {   }
    if (up_layer >= 0) g = mkgemm(YH, DM, (const bf16_t*)(ws + WS_W1T) + (size_t)up_layer * 4096 * 1024, DM, BIGb, 4096, rows, 4096, 1024, 2, 0);
    if (down_layer >= 0) g = mkgemm(BIGb, 4096, (const bf16_t*)(ws + WS_W2T) + (size_t)down_layer * 1024 * 4096, 4096, YH, DM, rows, 1024, 4096, 0, 0);
    if (ph == 4 || ph == 7 || ph == 14 || ph == 17) { g.part = (float*)((unsigned char*)P.out() + OUT_PART); g.split_pm0 = RL / 256; g.ksplit = 4; }
    {
        int layer = -1, which = 0;
        switch (ph) { case 4: layer = 0; which = 1; break; case 7: layer = 0; which = 2; break; case 14: layer = 1; which = 1; break; case 17: layer = 1; which = 2; break;
                      case 22: layer = 2; which = 1; break; case 25: layer = 2; which = 2; break; case 29: layer = 3; which = 1; break; case 32: layer = 3; which = 2; break; default: break; }
        if (layer >= 0) {
            const float* norm_g = P.in(6); const float* MOD = (const float*)(ws + WS_MOD); float* out = P.out();
            g.fused = 1; g.modL = MOD + (size_t)layer * 9 * 6144; g.gn_post = norm_g + (layer * 4 + (which == 1 ? 1 : 3)) * DM; g.gate_off = (which == 1 ? 2 : 5) * DM;
            const bool firstu = (layer == 0 && which == 1), lastu = (layer == 3 && which == 2);
            g.xsrc = (const float*)(ws + WS_X16); g.xdst = lastu ? out : (float*)(ws + WS_X16); g.x_mode = (lastu ? 2 : 0); g.Hout = YH; (void)firstu;
            if (which == 1) { g.has_next = 1; g.gn_next = norm_g + (layer * 4 + 2) * DM; g.modN = g.modL; g.shift_off = 3 * DM; g.scale_off = 4 * DM; }
            else { g.has_next = layer < 3; const int nl = layer < 3 ? layer + 1 : layer; g.gn_next = norm_g + (nl * 4 + 0) * DM; g.modN = MOD + (size_t)nl * 9 * 6144; g.shift_off = 0; g.scale_off = DM; }
            g.slot1 = (unsigned*)(ws + WS_XS1); g.slot2 = (unsigned*)(ws + WS_XS2);
            g.cnt1 = (unsigned*)(ws + WS_CNT) + (size_t)(ph * 2 + 0) * 136 * 64; g.cnt2 = (unsigned*)(ws + WS_CNT) + (size_t)(ph * 2 + 1) * 136 * 64;
        }
    }
    return g;
}

__global__ void __launch_bounds__(512) mega_fwd(Params Pk) {
    extern __shared__ __attribute__((aligned(16))) unsigned char lds_raw[];
    cg::grid_group grid = cg::this_grid();
    LAS unsigned char* lds = (LAS unsigned char*)lds_raw;
    const int G = gridDim.x, cidx = blockIdx.x;
    {
        const int t0 = threadIdx.x;
        LAS unsigned long long* par = (LAS unsigned long long*)(lds + LDS_PAR_OFF);
        if (t0 < 19) par[t0] = (unsigned long long)Pk.in[t0];
        if (t0 == 19) par[19] = (unsigned long long)Pk.out;
        if (t0 == 20) par[20] = (unsigned long long)Pk.ws;
        if (t0 == 21) { ((LAS unsigned*)(lds + LDS_BARST_OFF))[0] = 0u; ((LAS unsigned*)(lds + LDS_BARST_OFF))[1] = 0u; }
    }
    __syncthreads();
    if ((Pk.ph_hi - Pk.ph_lo) > 1) (void)xcd_barrier_post((unsigned*)(Pk.ws + WS_BAR), (volatile LAS unsigned*)(lds + LDS_BARST_OFF));
    PView P; P.base = lds + LDS_PAR_OFF;
    LAS GJob* jl = (LAS GJob*)(lds + LDS_JOB_OFF);

    const int ph_lo = Pk.ph_lo, ph_hi = Pk.ph_hi;
    int replayed = 0;
    for (int ph = ph_lo; ph < ph_hi; ++ph) {
        int tid = threadIdx.x; asm volatile("" : "+v"(tid));
        const int wid = __builtin_amdgcn_readfirstlane(tid >> 6), lane = tid & 63;
        const int gw = cidx * 8 + wid, ngw = G * 8;
        int kind, sync, a, rows;
        phase_info(ph, kind, sync, a, rows);
        if (ph == 14 && !replayed && ph_lo == 0) {
            unsigned char* wsx = P.wsp();
            combine_phase((const bf16_t*)(wsx + WS_BIG + BIG_Y2), (const bf16_t*)(wsx + WS_BIG + BIG_RT), (bf16_t*)(wsx + WS_YH), gw, ngw, lane);
            XcdBarrier xbar; xbar.bar = (unsigned*)(wsx + WS_BAR); xbar.x = xb_xcc_id(); xbar.st = (volatile LAS unsigned*)(lds + LDS_BARST_OFF);
            xcd_barrier(xbar);
        }
        if (kind == K_GEMM) {
            if (tid == 0) { GJob g = gemm_job(ph, P); if (REPEAT_MASK != 0ULL && ((REPEAT_MASK >> ph) & 1ULL) && !replayed && DRY_ALL) g.dry = DRY_ALL; const int* src = (const int*)&g; LAS int* dst = (LAS int*)jl;
#pragma unroll
                for (int q = 0; q < (int)(sizeof(GJob) / 4); ++q) dst[q] = src[q]; }
            __syncthreads();
#ifndef NO_GEMM
            pg8::gemm_phase(lds, jl, G, cidx, tid);
#endif
        } else if (kind == K_ROW) {
            unsigned char* ws = P.wsp(); bf16_t* YH = (bf16_t*)(ws + WS_YH);
            const int layer = a == 0 ? 0 : (a - 1) >> 1, which = a == 0 ? 0 : ((a - 1) & 1) + 1;
            const bf16_t* Y = (a == 3) ? (const bf16_t*)(ws + WS_BIG + BIG_Y2) : YH;
            const int nr = (a == 4) ? RT : rows;
            const RowJob r = mkrow(P, layer, which, nr, Y, YH);
#ifndef NO_ROW
            row_phase(r, gw, ngw, lane);
#endif
        } else if (kind == K_PRO) {
#ifndef NO_PRO
            prologue_phase(P, lds, tid);
#endif
        } else if (kind == K_SPATIAL) {
            unsigned char* ws = P.wsp();
            spatial_phase(lds, (bf16_t*)(ws + WS_BIG), (const float*)((unsigned char*)P.out() + OUT_STATS), (const bf16_t*)(ws + WS_AWS) + (size_t)a * 8 * 128 * 128, P.in(10) + a * 2048, P.in(12) + a * 8 * 128, rows / 128, tid);
        } else if (kind == K_FOLD) {
            unsigned char* ws = P.wsp();
            fold_phase((const bf16_t*)(ws + WS_YH), (bf16_t*)(ws + WS_BIG + BIG_Z), (bf16_t*)(ws + WS_BIG + BIG_DFTL), gw, ngw, lane);
        } else if (kind == K_QKVPOST) {
            unsigned char* ws = P.wsp();
            qkvpost_phase((const bf16_t*)(ws + WS_BIG + BIG_RAW), P.in(16), P.in(17), (bf16_t*)(ws + WS_YH), (bf16_t*)(ws + WS_BIG + BIG_K), (bf16_t*)(ws + WS_BIG + BIG_V), gw, ngw, lane);
        } else if (kind == K_ATTN) {
            unsigned char* ws = P.wsp(); unsigned char* BIG = ws + WS_BIG; const bf16_t* YH = (const bf16_t*)(ws + WS_YH);
            const int xcd = cidx & 7, slot = cidx >> 3, per = G >> 3;
            for (int i = 0; ; ++i) {
                const int v = (G % 8 == 0) ? (i * G + xcd * per + slot) : (i * G + cidx);
                if (v >= 1024) break;
                const int qb = v & 15, hh = (v >> 4) & 3, kvh = (v >> 6) & 1, b = v >> 7, h = kvh * 4 + hh;
                const bf16_t* Qb = YH + ((size_t)b * SEQ + qb * 256) * 1024 + h * 128;
                const bf16_t* Kh = (const bf16_t*)(BIG + BIG_K) + (size_t)b * SKV * 256 + kvh * 128;
                const bf16_t* Vh = (const bf16_t*)(BIG + BIG_V) + (size_t)b * SKV * 256 + kvh * 128;
                bf16_t* Ob = (bf16_t*)(BIG + BIG_O) + ((size_t)b * SEQ + qb * 256) * 1024 + h * 128;
#ifndef NO_ATT
                att::attn_dense_body(Qb, Kh, Vh, Ob, SKV, (char*)lds_raw, tid);
#endif
                __syncthreads();
            }
        }
        if (REPEAT_MASK != 0ULL) { if (((REPEAT_MASK >> ph) & 1ULL) && !replayed) { replayed = 1; --ph; __syncthreads(); continue; } replayed = 0; }
        if (sync && ph + 1 < ph_hi) for (int srep = 0; srep < SYNC_REP; ++srep) {
            if (ph == 0) {
                asm volatile("s_waitcnt vmcnt(0) lgkmcnt(0)" ::: "memory");
                __syncthreads();
                if (wid == 0) { __builtin_amdgcn_fence(__ATOMIC_RELEASE, "agent"); asm volatile("s_waitcnt vmcnt(0) lgkmcnt(0)" ::: "memory"); }
                grid.sync();
                if (wid == 0) { __builtin_amdgcn_fence(__ATOMIC_ACQUIRE, "agent"); asm volatile("s_waitcnt vmcnt(0) lgkmcnt(0)" ::: "memory"); }
                __syncthreads();
            } else {
                XcdBarrier xbar; xbar.bar = (unsigned*)(P.wsp() + WS_BAR); xbar.x = xb_xcc_id(); xbar.st = (volatile LAS unsigned*)(lds + LDS_BARST_OFF);
                xcd_barrier(xbar);
            }
        }
    }
}


#ifdef STOP_PH
__global__ void __launch_bounds__(256) dump_kernel(const unsigned char* ws, float* out) {
    const bf16_t* YH = (const bf16_t*)(ws + WS_YH); const bf16_t* BIGb = (const bf16_t*)(ws + WS_BIG);
    for (size_t i = (size_t)blockIdx.x * 256 + threadIdx.x; i < (size_t)RL * DM; i += (size_t)gridDim.x * 256) {
        const size_t r = i >> 10, c = i & 1023;
        float v = __uint_as_float((unsigned)YH[i] << 16);
        for (int k = 0; k < 4; ++k) v += __uint_as_float((unsigned)BIGb[r * 4096 + c + 1024 * k] << 16);
        if (STOP_PH >= 6) v += out[i];
        out[i] = v;
    }
}
#endif
extern "C" void kernel_launch(void* const* d_in, const int* in_sizes, int n_in, void* d_out, int out_size, void* d_ws, size_t ws_size, hipStream_t stream) {
    static int grid = 0;
    if (grid == 0) {
        if (n_in != 19 || out_size != RL * DM || ws_size < WS_END) { fprintf(stderr, "kernel_launch: unexpected shapes (n_in %d out %d ws %zu, need ws >= %zu)\n", n_in, out_size, ws_size, (size_t)WS_END); grid = -1; return; }
        int dev = 0, cus = 0, per_cu = 0;
        (void)hipGetDevice(&dev);
        (void)hipDeviceGetAttribute(&cus, hipDeviceAttributeMultiprocessorCount, dev);
        if (hipFuncSetAttribute((const void*)mega_fwd, hipFuncAttributeMaxDynamicSharedMemorySize, LDS_BYTES) != hipSuccess) { fprintf(stderr, "kernel_launch: hipFuncSetAttribute failed\n"); grid = -1; return; }
        if (hipOccupancyMaxActiveBlocksPerMultiprocessor(&per_cu, (const void*)mega_fwd, 512, LDS_BYTES) != hipSuccess || per_cu < 1) { fprintf(stderr, "kernel_launch: occupancy query gave %d\n", per_cu); per_cu = 1; }
        (void)hipGetLastError();
        grid = cus * per_cu;
        fprintf(stderr, "kernel_launch: grid %d (cus %d x %d)\n", grid, cus, per_cu);
    }
    if (grid < 0) return;
    Params p{};
    for (int i = 0; i < 19; ++i) p.in[i] = (const float*)d_in[i];
    p.out = (float*)d_out; p.ws = (unsigned char*)d_ws;
#ifndef MK_MULTI
#define MK_MULTI 0
#endif
#if MK_MULTI
    static const int cuts[] = {0,1,2,3,4,5,6,7,8,9,10,12,14,15,16,17,18,19,20,21,22,23,24,25,26,27,28,29,30,31,32,33,34};
    hipError_t e = hipSuccess;
    for (int li = 0; li + 1 < (int)(sizeof(cuts) / sizeof(int)); ++li) {
        p.ph_lo = cuts[li]; p.ph_hi = cuts[li + 1];
#ifdef STOP_PH
        if (p.ph_hi > STOP_PH) break;
#endif
        hipLaunchKernelGGL(mega_fwd, dim3(grid), dim3(512), LDS_BYTES, stream, p);
    }
#ifdef STOP_PH
    hipLaunchKernelGGL(dump_kernel, dim3(2048), dim3(256), 0, stream, (const unsigned char*)d_ws, (float*)d_out);
#endif
    e = hipPeekAtLastError();
#else
    p.ph_lo = 0; p.ph_hi = NPH;
    (void)hipMemsetAsync((unsigned char*)d_ws + WS_CNT, 0, CNT_BYTES, stream);
    (void)hipMemsetAsync((unsigned char*)d_ws + WS_BAR, 0, 16384, stream);
    void* args[] = {&p};
    hipError_t e = hipLaunchCooperativeKernel((const void*)mega_fwd, dim3(grid), dim3(512), args, LDS_BYTES, stream);
#endif
    if (e != hipSuccess) fprintf(stderr, "kernel_launch: cooperative launch failed: %s (grid %d)\n", hipGetErrorString(e), grid);
}
```

```cpp
#include <hip/hip_runtime.h>
#ifndef DRY_ALL
#define DRY_ALL 0
#endif
#ifndef NT_STORES
#define NT_STORES 0
#endif
#ifndef SYNC_REP
#define SYNC_REP 1
#endif
#ifndef REPEAT_MASK
#define REPEAT_MASK 0ULL
#endif
#include <hip/hip_cooperative_groups.h>
#include <cstdio>
#include <cstdint>
namespace cg = cooperative_groups;

#define LAS __attribute__((address_space(3)))
typedef unsigned short bf16_t;
typedef short bf16x8 __attribute__((ext_vector_type(8)));
typedef short s16x4 __attribute__((ext_vector_type(4)));
typedef float f32x4 __attribute__((ext_vector_type(4)));
typedef float f32x16 __attribute__((ext_vector_type(16)));
typedef unsigned u32x4 __attribute__((ext_vector_type(4)));
typedef unsigned u32x2 __attribute__((ext_vector_type(2)));

constexpr int DM = 1024, NBATCH = 8, SEQ = 4096, CTXL = 256;
constexpr int RL = NBATCH * SEQ;
constexpr int RC = NBATCH * CTXL;
constexpr int RT = RL + RC;
constexpr int SKV = CTXL + SEQ;
constexpr int ZJ = 4352;
constexpr float NORM_EPS = 1e-6f, LN_EPS = 1e-5f;

constexpr size_t MiB = 1u << 20;
constexpr size_t WS_MOD = 0;
constexpr size_t WS_BAR = 901120;
constexpr size_t WS_XS1 = 1 * MiB;
constexpr size_t WS_XS2 = 2 * MiB;
constexpr size_t WS_CNT = 3 * MiB;
constexpr size_t CNT_BYTES = (size_t)34 * 2 * 136 * 256;
constexpr size_t WS_CC = 10 * MiB;
constexpr size_t WS_SC = WS_CC + 131072;
constexpr size_t WS_DFTC = WS_SC + 131072;
constexpr size_t WS_AWS = 11 * MiB;
constexpr size_t WS_W1T = 12 * MiB;
constexpr size_t WS_W2T = 44 * MiB;
constexpr size_t WS_AWINT = 76 * MiB;
constexpr size_t WS_AWOUTT = 92 * MiB;
constexpr size_t WS_BWOUTT = 100 * MiB;
constexpr size_t WS_QKVT = 102 * MiB;
constexpr size_t WS_WOT = 105 * MiB;
constexpr size_t WS_YH = 107 * MiB;
constexpr size_t WS_BIG = 175 * MiB;
constexpr size_t WS_X16 = 447 * MiB;
constexpr size_t WS_END = 511 * MiB;
constexpr size_t OUT_PART = 0;
constexpr size_t OUT_STATS = 32 * MiB;
constexpr size_t OUT_XC = 41 * MiB;
constexpr size_t BIG_Z = 0;
constexpr size_t BIG_DFTL = 68 * MiB;
constexpr size_t BIG_RT = 102 * MiB;
constexpr size_t BIG_RTC = 170 * MiB;
constexpr size_t BIG_Y2 = 178 * MiB;
constexpr size_t BIG_RAW = 0;
constexpr size_t BIG_K = 204 * MiB;
constexpr size_t BIG_V = 221 * MiB;
constexpr size_t BIG_Q = 0;
constexpr size_t BIG_O = 68 * MiB;

constexpr int LDS_BYTES = 141312;
constexpr int LDS_XP_OFF = 131072 + 1024, LDS_XS_OFF = 131072 + 5120, LDS_XF_OFF = 131072 + 6144;

typedef __bf16 bf16v2_t __attribute__((ext_vector_type(2)));
typedef float f32v2_t __attribute__((ext_vector_type(2)));
__device__ __forceinline__ unsigned cvt_pk_bf16(float lo, float hi) { const f32v2_t v = {lo, hi}; const bf16v2_t b = __builtin_convertvector(v, bf16v2_t); return __builtin_bit_cast(unsigned, b); }
__device__ __forceinline__ bf16_t f2bf(float f) { return (bf16_t)(cvt_pk_bf16(f, 0.f) & 0xffffu); }
__device__ __forceinline__ float bflo(unsigned w) { return __uint_as_float(w << 16); }
__device__ __forceinline__ float bfhi(unsigned w) { return __uint_as_float(w & 0xffff0000u); }
__device__ __forceinline__ float wave_sum(float v) {
#pragma unroll
    for (int o = 1; o < 64; o <<= 1) v += __shfl_xor(v, o);
    return v;
}
__device__ __forceinline__ float gelu_tanh(float x) {
    const float z2 = 1.5957691216057308f * (x + 0.044715f * x * x * x);
    const float e = __builtin_amdgcn_exp2f(-z2 * 1.4426950408889634f);
    return x * __builtin_amdgcn_rcpf(1.0f + e);
}

__device__ __forceinline__ f32x4 gelu_tanh4(f32x4 x) {
    f32x4 t = x * x; t = t * 0.044715f + 1.0f; t = t * x;
    const f32x4 a = t * (-2.3022082f);
    f32x4 e; e[0] = __builtin_amdgcn_exp2f(a[0]); e[1] = __builtin_amdgcn_exp2f(a[1]); e[2] = __builtin_amdgcn_exp2f(a[2]); e[3] = __builtin_amdgcn_exp2f(a[3]);
    const f32x4 d = e + 1.0f;
    f32x4 r; r[0] = __builtin_amdgcn_rcpf(d[0]); r[1] = __builtin_amdgcn_rcpf(d[1]); r[2] = __builtin_amdgcn_rcpf(d[2]); r[3] = __builtin_amdgcn_rcpf(d[3]);
    return x * r;
}
__device__ __forceinline__ f32x4 relu2_4(f32x4 x) {
    f32x4 m; m[0] = fmaxf(x[0], 0.f); m[1] = fmaxf(x[1], 0.f); m[2] = fmaxf(x[2], 0.f); m[3] = fmaxf(x[3], 0.f);
    return x * m;
}

namespace pg8 {
constexpr int BM = 256, BK = 64, HALF = 128, HTB = HALF * BK * 2, STAGE_BYTES = 8 * HTB, NXCD = 8, WGM = 8;
__host__ __device__ __forceinline__ int lds_byte(int r, int c) { const int st = (r >> 4) * 2 + (c >> 5), rr = r & 15, cc = c & 31, ob = rr * 64 + cc * 2; return st * 1024 + (ob ^ (((ob >> 9) & 1) << 5)); }
__host__ __device__ __forceinline__ void stage_rc(int b, int& R, int& C) { const int st = b / 1024, sb = b % 1024, swz = sb ^ (((sb >> 9) & 1) << 5); R = (st >> 1) * 16 + swz / 64; C = (st & 1) * 32 + (swz % 64) / 2; }
__host__ __device__ __forceinline__ int perm32(int rho) { const int n = rho >> 4, i = rho & 15; return 8 * (i >> 2) + 4 * n + (i & 3); }

struct GJob {
    const bf16_t* A; const bf16_t* A2; const bf16_t* B; void* C; float* stats;
    unsigned a2mask; int lda; int b_bs_hi, b_bs_lo, bdiv, b_pn_mod, ldb;
    int c_bs, ldc, out_f32, act; float scale;
    int stats_pn0;
    int nM, nN, nB, K;
    float* part; int split_pm0, ksplit;
    int fused, has_next, gate_off, shift_off, scale_off, x_mode;
    const float* xsrc; float* xdst; bf16_t* Hout; const float* gn_post; const float* gn_next; const float* modL; const float* modN;
    unsigned* slot1; unsigned* slot2; unsigned* cnt1; unsigned* cnt2; int kf; int dry;
    bf16_t* Kd; bf16_t* Vd; const float* qg; const float* kg;
};
#define JI(f) (__builtin_amdgcn_readfirstlane((int)(J->f)))
#define JF32(f) (__int_as_float(__builtin_amdgcn_readfirstlane(__float_as_int(J->f))))
template <class T> __device__ __forceinline__ T* jptr(const LAS void* p) {
    const LAS unsigned* q = (const LAS unsigned*)p; const unsigned lo = (unsigned)__builtin_amdgcn_readfirstlane((int)q[0]), hi = (unsigned)__builtin_amdgcn_readfirstlane((int)q[1]);
    typedef __attribute__((address_space(1))) T GT;
    GT* g = (GT*)(((unsigned long long)hi << 32) | lo); return (T*)g;
}
struct Unit { const char* a; const char* b; int bt, pm, pn, ks, nt; };

#define RFL(x) (UNIFORM ? __builtin_amdgcn_readfirstlane(x) : (x))
template <bool UNIFORM> __device__ __forceinline__ bool unit_next(const LAS GJob* J, int i, int G, int c, Unit& u) {
    const int nMall = JI(nM), nN = JI(nN), split_pm0 = JI(split_pm0), ksplit = JI(ksplit);
    const int nM = split_pm0 < nMall ? split_pm0 : nMall;
    const int per = nM * nN, nreg = per * JI(nB), nsplit = (nMall - nM) * nN * ksplit;
    const long L = (long)i * G + c; if (L >= nreg + nsplit) return false;
    const int lda = JI(lda), ldb = JI(ldb), K = JI(K);
    if (L >= nreg) {
        const int s = (int)L - nreg, ks = RFL(s % ksplit), t = s / ksplit;
        u.pn = RFL(t % nN); u.pm = RFL(nM + t / nN); u.bt = 0; u.ks = ks; u.nt = RFL((K / ksplit) / BK);
        u.a = (const char*)(jptr<const bf16_t>(&J->A) + (long)u.pm * 256 * lda + ks * (K / ksplit));
        u.b = (const char*)(jptr<const bf16_t>(&J->B) + (long)u.pn * 256 * ldb + ks * (K / ksplit));
        return true;
    }
    int wgid = (int)L; { const int nwg = nreg, q = nwg / NXCD, r = nwg % NXCD, xcd = wgid % NXCD, off = wgid / NXCD; wgid = (xcd < r ? xcd * (q + 1) : r * (q + 1) + (xcd - r) * q) + off; }
    const int bt = RFL(wgid / per), w = wgid % per;
    const int nig = WGM * nN, gid = w / nig, fm = gid * WGM, gsz = (nM - fm) < WGM ? (nM - fm) : WGM;
    u.pm = RFL(fm + ((w % nig) % gsz)); u.pn = RFL((w % nig) / gsz); u.bt = bt; u.ks = -1; u.nt = K / BK;
    const bf16_t* Ab = (((unsigned)JI(a2mask) >> u.pn) & 1u) ? jptr<const bf16_t>(&J->A2) : jptr<const bf16_t>(&J->A);
    u.a = (const char*)(Ab + (long)u.pm * 256 * lda);
    { const int kf = JI(kf); if (kf > 0) { const int part = bt & 1; u.a += (size_t)part * kf * 2; u.nt = part ? (K - kf) / BK : kf / BK; } }
    const int bdiv = JI(bdiv);
    const int bhi = RFL(bt / bdiv), blo = RFL(bt % bdiv), pnm = RFL(u.pn % JI(b_pn_mod));
    u.b = (const char*)(jptr<const bf16_t>(&J->B) + (long)bhi * JI(b_bs_hi) + (long)blo * JI(b_bs_lo) + (long)pnm * 256 * ldb);
    return true;
}

#undef RFL
constexpr int UT_MAX = 16, UT_STRIDE = 12;
__device__ __forceinline__ void unit_table_build(LAS unsigned* tab, const LAS GJob* J, int G, int c, int tid) {
    if (tid < UT_MAX) {
        Unit u; u.a = nullptr; u.b = nullptr; u.bt = 0; u.pm = 0; u.pn = 0; u.ks = -1; u.nt = 4;
        const bool ok = unit_next<false>(J, tid, G, c, u);
        LAS unsigned* e = tab + tid * UT_STRIDE;
        const unsigned long long pa = (unsigned long long)u.a, pb = (unsigned long long)u.b;
        e[0] = (unsigned)pa; e[1] = (unsigned)(pa >> 32); e[2] = (unsigned)pb; e[3] = (unsigned)(pb >> 32);
        e[4] = (unsigned)u.bt; e[5] = (unsigned)u.pm; e[6] = (unsigned)u.pn; e[7] = (unsigned)u.ks; e[8] = (unsigned)u.nt; e[9] = ok ? 1u : 0u;
    }
}
__device__ __forceinline__ bool unit_fetch(const LAS unsigned* tab, int i, Unit& u) {
    if (i >= UT_MAX) return false;
    const LAS unsigned* e = tab + i * UT_STRIDE;
    if (__builtin_amdgcn_readfirstlane((int)e[9]) == 0) return false;
    u.a = jptr<const char>(e); u.b = jptr<const char>(e + 2);
    u.bt = __builtin_amdgcn_readfirstlane((int)e[4]); u.pm = __builtin_amdgcn_readfirstlane((int)e[5]); u.pn = __builtin_amdgcn_readfirstlane((int)e[6]);
    u.ks = __builtin_amdgcn_readfirstlane((int)e[7]); u.nt = __builtin_amdgcn_readfirstlane((int)e[8]);
    return true;
}

__device__ __forceinline__ void epilogue(const LAS GJob* J, const f32x4 (&acc)[2][2][4][2], const Unit& u, int wr, int wc, int fr, int fq) {
    asm volatile("" : "+v"(fr), "+v"(fq));
    const int row0 = u.pm * BM + wr * 64 + fr, col0 = u.pn * BM + wc * 32 + 8 * fq;
    float* const stats = jptr<float>(&J->stats); const int stats_pn0 = JI(stats_pn0);
    const bool do_stats = (stats != nullptr) && (u.pn >= stats_pn0);
    const float sc = JF32(scale); const bool has_scale = (sc != 1.0f); const int act = JI(act), out_f32 = JI(out_f32), ldc = JI(ldc); const bool nostore = (REPEAT_MASK != 0ULL) && (JI(dry) == 2);
    char* const Cb = jptr<char>(&J->C) + ((size_t)u.bt * JI(c_bs) << (out_f32 ? 2 : 1));
    if (u.ks >= 0) {
        const int nMall = JI(nM), sp0 = JI(split_pm0);
        float* const part = jptr<float>(&J->part) + (size_t)u.ks * (nMall - sp0) * BM * ldc;
#pragma unroll
        for (int ai = 0; ai < 2; ++ai)
#pragma unroll
            for (int m = 0; m < 4; ++m) {
                const int row = row0 + ai * HALF + m * 16;
#pragma unroll
                for (int bj = 0; bj < 2; ++bj) { float* p = part + (size_t)(row - sp0 * BM) * ldc + col0 + bj * HALF; *(f32x4*)p = acc[ai][bj][m][0]; *(f32x4*)(p + 4) = acc[ai][bj][m][1]; }
            }
        return;
    }
#pragma unroll
    for (int ai = 0; ai < 2; ++ai)
#pragma unroll
        for (int m = 0; m < 4; ++m) {
            const int row = row0 + ai * HALF + m * 16;
            float ssum = 0.f, ssq = 0.f;
#pragma unroll
            for (int bj = 0; bj < 2; ++bj) {
                f32x4 v0 = acc[ai][bj][m][0], v1 = acc[ai][bj][m][1];
                if (has_scale) { v0 = v0 * sc; v1 = v1 * sc; }
                if (act == 1) { v0 = gelu_tanh4(v0); v1 = gelu_tanh4(v1); }
                else if (act == 2) { v0 = relu2_4(v0); v1 = relu2_4(v1); }
                if (do_stats) {
#pragma unroll
                    for (int e = 0; e < 4; ++e) { ssum += v0[e] + v1[e]; ssq += v0[e] * v0[e] + v1[e] * v1[e]; }
                }
                const size_t off = (size_t)row * ldc + col0 + bj * HALF;
                if (out_f32) { float* p = (float*)Cb + off; *(f32x4*)p = v0; *(f32x4*)(p + 4) = v1; }
                else { u32x4 w; w.x = cvt_pk_bf16(v0[0], v0[1]); w.y = cvt_pk_bf16(v0[2], v0[3]); w.z = cvt_pk_bf16(v1[0], v1[1]); w.w = cvt_pk_bf16(v1[2], v1[3]);
                       if (REPEAT_MASK != 0ULL && nostore) { asm volatile("" :: "v"(w.x), "v"(w.y), "v"(w.z), "v"(w.w)); } else
                       if (NT_STORES) __builtin_nontemporal_store(w, (u32x4*)((bf16_t*)Cb + off)); else *(u32x4*)((bf16_t*)Cb + off) = w; }
            }
            if (do_stats) {
                ssum += __shfl_xor(ssum, 16); ssum += __shfl_xor(ssum, 32); ssq += __shfl_xor(ssq, 16); ssq += __shfl_xor(ssq, 32);
                if (fq == 0) { float* s = stats + ((size_t)row * 32 + (u.pn - stats_pn0) * 4 + wc) * 2; s[0] = ssum; s[1] = ssq; }
            }
        }
}

__device__ __forceinline__ void row_exchange(LAS unsigned char* lds, const float (&q)[2][4], unsigned* slot, unsigned* cnt, const Unit& u, int wr, int wc, int fr, int fq, int wid, int lane) {
    LAS float* P = (LAS float*)(lds + 131072 + 1024); LAS float* S = (LAS float*)(lds + 131072 + 5120);
#pragma unroll
    for (int ai = 0; ai < 2; ++ai)
#pragma unroll
        for (int m = 0; m < 4; ++m) { float t = q[ai][m]; t += __shfl_xor(t, 16); t += __shfl_xor(t, 32); if (fq == 0) P[(ai * HALF + wr * 64 + m * 16 + fr) * 4 + wc] = t; }
    asm volatile("s_waitcnt lgkmcnt(0)" ::: "memory"); __builtin_amdgcn_s_barrier(); asm volatile("" ::: "memory");
    const int row = wid * 32 + (lane & 31);
    unsigned* myslot = slot + ((size_t)(u.pm * BM + row) * 4);
    if (lane < 32) { const float t = (P[row * 4 + 0] + P[row * 4 + 1]) + (P[row * 4 + 2] + P[row * 4 + 3]);
        __hip_atomic_store(myslot + u.pn, __float_as_uint(t), __ATOMIC_RELAXED, __HIP_MEMORY_SCOPE_AGENT); }
    asm volatile("s_waitcnt vmcnt(0)" ::: "memory");
    if (lane == 0) __hip_atomic_fetch_add(cnt + 64 * u.pm, 1u, __ATOMIC_RELAXED, __HIP_MEMORY_SCOPE_AGENT);
    if (wid == 0) {
        for (int spin = 0; spin < (1 << 20); ++spin) {
            if ((unsigned)__builtin_amdgcn_readfirstlane((int)__hip_atomic_load(cnt + 64 * u.pm, __ATOMIC_RELAXED, __HIP_MEMORY_SCOPE_AGENT)) >= 32u) break;
            __builtin_amdgcn_s_sleep(2);
        }
        __builtin_amdgcn_fence(__ATOMIC_ACQUIRE, "agent");
    }
    asm volatile("s_waitcnt vmcnt(0) lgkmcnt(0)" ::: "memory"); __builtin_amdgcn_s_barrier(); asm volatile("" ::: "memory");
    if (lane < 32) { float t = 0.f;
#pragma unroll
        for (int k = 0; k < 4; ++k) t += __uint_as_float(__hip_atomic_load(myslot + k, __ATOMIC_RELAXED, __HIP_MEMORY_SCOPE_AGENT));
        S[row] = rsqrtf(t * (1.0f / 1024.0f) + 1e-6f); }
    asm volatile("s_waitcnt lgkmcnt(0)" ::: "memory"); __builtin_amdgcn_s_barrier(); asm volatile("" ::: "memory");
}
__device__ __forceinline__ void epilogue_fused(const LAS GJob* J, f32x4 (&acc)[2][2][4][2], const Unit& u, LAS unsigned char* lds, int wr, int wc, int fr, int fq, int wid, int lane) {
    const int row0 = u.pm * BM + wr * 64 + fr, col0 = u.pn * BM + wc * 32 + 8 * fq;
    const int bidx = (u.pm * BM) >> 12;
    const LAS float* S = (const LAS float*)(lds + 131072 + 5120);
    const unsigned lo4 = (unsigned)(row0 * DM + col0) * 4u, lo2 = (unsigned)(row0 * DM + col0) * 2u;
#define XOFF(ai, m, bj, n) ((unsigned)((((ai) * HALF + (m) * 16) * DM + (bj) * HALF + 4 * (n)) * 4))
    float q[2][4];
#pragma unroll
    for (int ai = 0; ai < 2; ++ai)
#pragma unroll
        for (int m = 0; m < 4; ++m) { float t = 0.f;
#pragma unroll
            for (int bj = 0; bj < 2; ++bj)
#pragma unroll
                for (int n = 0; n < 2; ++n) { const f32x4 y = acc[ai][bj][m][n]; t += (y[0] * y[0] + y[1] * y[1]) + (y[2] * y[2] + y[3] * y[3]); }
            q[ai][m] = t; }
    const char* xs = (const char*)jptr<const float>(&J->xsrc);
    const bool dst32 = (JI(x_mode) & 2) != 0;
    u32x4 xq[2][4];
#define XLOADH(bj) do { _Pragma("unroll") for (int ai = 0; ai < 2; ++ai) _Pragma("unroll") for (int m = 0; m < 4; ++m) xq[ai][m] = *(const u32x4*)(xs + XOFF(ai, m, bj, 0) / 2 + lo2); } while (0)
    XLOADH(0);
    row_exchange(lds, q, jptr<unsigned>(&J->slot1), jptr<unsigned>(&J->cnt1), u, wr, wc, fr, fq, wid, lane);
    {
        const float* gate = jptr<const float>(&J->modL) + bidx * 6144 + JI(gate_off) + col0; const float* gnp = jptr<const float>(&J->gn_post) + col0;
        char* xd = (char*)jptr<float>(&J->xdst);
#pragma unroll
        for (int ai = 0; ai < 2; ++ai)
#pragma unroll
            for (int m = 0; m < 4; ++m) q[ai][m] = 0.f;
#pragma unroll
        for (int bj = 0; bj < 2; ++bj) {
            const f32x4 gt0 = *(const f32x4*)(gate + bj * HALF), gt1 = *(const f32x4*)(gate + bj * HALF + 4), gp0 = *(const f32x4*)(gnp + bj * HALF), gp1 = *(const f32x4*)(gnp + bj * HALF + 4);
#pragma unroll
            for (int ai = 0; ai < 2; ++ai)
#pragma unroll
                for (int m = 0; m < 4; ++m) {
                    const float rs = S[ai * HALF + wr * 64 + m * 16 + fr]; const u32x4 w = xq[ai][m];
                    const f32x4 x0 = (f32x4){bflo(w.x), bfhi(w.x), bflo(w.y), bfhi(w.y)}, x1 = (f32x4){bflo(w.z), bfhi(w.z), bflo(w.w), bfhi(w.w)};
                    const f32x4 xn0 = x0 + gt0 * ((acc[ai][bj][m][0] * rs) * gp0), xn1 = x1 + gt1 * ((acc[ai][bj][m][1] * rs) * gp1);
                    acc[ai][bj][m][0] = xn0; acc[ai][bj][m][1] = xn1;
                    q[ai][m] += ((xn0[0] * xn0[0] + xn0[1] * xn0[1]) + (xn0[2] * xn0[2] + xn0[3] * xn0[3])) + ((xn1[0] * xn1[0] + xn1[1] * xn1[1]) + (xn1[2] * xn1[2] + xn1[3] * xn1[3])); }
            asm volatile("" ::: "memory");
            if (bj == 0) XLOADH(1);
            if (dst32) {
#pragma unroll
                for (int ai = 0; ai < 2; ++ai)
#pragma unroll
                    for (int m = 0; m < 4; ++m) { *(f32x4*)(xd + XOFF(ai, m, bj, 0) + lo4) = acc[ai][bj][m][0]; *(f32x4*)(xd + XOFF(ai, m, bj, 1) + lo4) = acc[ai][bj][m][1]; }
            } else {
#pragma unroll
                for (int ai = 0; ai < 2; ++ai)
#pragma unroll
                    for (int m = 0; m < 4; ++m) { const f32x4 a0 = acc[ai][bj][m][0], a1 = acc[ai][bj][m][1];
                        u32x4 w; w.x = cvt_pk_bf16(a0[0], a0[1]); w.y = cvt_pk_bf16(a0[2], a0[3]); w.z = cvt_pk_bf16(a1[0], a1[1]); w.w = cvt_pk_bf16(a1[2], a1[3]);
                        *(u32x4*)(xd + XOFF(ai, m, bj, 0) / 2 + lo2) = w; }
            }
        }
    }
#undef XLOADH
    if (!JI(has_next)) return;
    row_exchange(lds, q, jptr<unsigned>(&J->slot2), jptr<unsigned>(&J->cnt2), u, wr, wc, fr, fq, wid, lane);
    {
        const float* modN = jptr<const float>(&J->modN) + bidx * 6144 + col0; const float* shp = modN + JI(shift_off); const float* scp = modN + JI(scale_off); const float* gnn = jptr<const float>(&J->gn_next) + col0;
        char* H = (char*)jptr<bf16_t>(&J->Hout);
#pragma unroll
        for (int bj = 0; bj < 2; ++bj) {
            const f32x4 gn0 = *(const f32x4*)(gnn + bj * HALF), gn1 = *(const f32x4*)(gnn + bj * HALF + 4), sh0 = *(const f32x4*)(shp + bj * HALF), sh1 = *(const f32x4*)(shp + bj * HALF + 4);
            const f32x4 sc0 = *(const f32x4*)(scp + bj * HALF) + 1.0f, sc1 = *(const f32x4*)(scp + bj * HALF + 4) + 1.0f;
#pragma unroll
            for (int ai = 0; ai < 2; ++ai)
#pragma unroll
                for (int m = 0; m < 4; ++m) {
                    const float rs = S[ai * HALF + wr * 64 + m * 16 + fr];
                    const f32x4 h0 = ((acc[ai][bj][m][0] * rs) * gn0) * sc0 + sh0, h1 = ((acc[ai][bj][m][1] * rs) * gn1) * sc1 + sh1;
                    u32x4 w; w.x = cvt_pk_bf16(h0[0], h0[1]); w.y = cvt_pk_bf16(h0[2], h0[3]); w.z = cvt_pk_bf16(h1[0], h1[1]); w.w = cvt_pk_bf16(h1[2], h1[3]);
                    *(u32x4*)(H + XOFF(ai, m, bj, 0) / 2 + lo2) = w; }
        }
    }
#undef XOFF
}

__device__ __forceinline__ void epilogue_qkv(const LAS GJob* J, const f32x4 (&acc)[2][2][4][2], const Unit& u, LAS unsigned char* lds, int wr, int wc, int fr, int fq) {
    asm volatile("" : "+v"(fr), "+v"(fq));
    LAS float* P = (LAS float*)(lds + 131072 + 1024);
    const bool is_v = (u.pn == 5), is_k = (u.pn == 4);
    if (!is_v) {
#pragma unroll
        for (int ai = 0; ai < 2; ++ai)
#pragma unroll
            for (int m = 0; m < 4; ++m)
#pragma unroll
                for (int bj = 0; bj < 2; ++bj) { const f32x4 a = acc[ai][bj][m][0], b = acc[ai][bj][m][1];
                    float t = ((a[0] * a[0] + a[1] * a[1]) + (a[2] * a[2] + a[3] * a[3])) + ((b[0] * b[0] + b[1] * b[1]) + (b[2] * b[2] + b[3] * b[3]));
                    t += __shfl_xor(t, 16); t += __shfl_xor(t, 32);
                    if (fq == 0) P[((ai * HALF + wr * 64 + m * 16 + fr) * 2 + bj) * 4 + wc] = t; }
    }
    asm volatile("s_waitcnt lgkmcnt(0)" ::: "memory"); __builtin_amdgcn_s_barrier(); asm volatile("" ::: "memory");
    const int d0 = 16 * wc + 4 * fq;
    bf16_t* const Qd = jptr<bf16_t>(&J->C); bf16_t* const Kd = jptr<bf16_t>(&J->Kd); bf16_t* const Vd = jptr<bf16_t>(&J->Vd);
    const float* g = is_k ? jptr<const float>(&J->kg) : jptr<const float>(&J->qg);
    f32x4 g1 = (f32x4){1.f, 1.f, 1.f, 1.f}, g2 = g1; float inv[4] = {0.f, 0.f, 0.f, 0.f};
    if (!is_v) { g1 = *(const f32x4*)(g + d0); g2 = *(const f32x4*)(g + 64 + d0);
#pragma unroll
        for (int e = 0; e < 4; ++e) inv[e] = exp2f(-(float)((d0 + e) & 31) * (13.287712379549449f / 32.0f)); }
#pragma unroll
    for (int ai = 0; ai < 2; ++ai)
#pragma unroll
        for (int m = 0; m < 4; ++m) {
            const int trow = ai * HALF + wr * 64 + m * 16 + fr, row = u.pm * BM + trow;
            const bool lat = row < RL; const int b = lat ? (row >> 12) : ((row - RL) >> 8), t = lat ? (row & 4095) : ((row - RL) & 255), pos = lat ? (CTXL + t) : t;
            const size_t kvoff = ((size_t)b * SKV + pos) * 256;
            if (is_v) {
#pragma unroll
                for (int bj = 0; bj < 2; ++bj) { const f32x4 a = acc[ai][bj][m][0], c = acc[ai][bj][m][1];
                    u32x4 w; w.x = cvt_pk_bf16(a[0], a[1]); w.y = cvt_pk_bf16(a[2], a[3]); w.z = cvt_pk_bf16(c[0], c[1]); w.w = cvt_pk_bf16(c[2], c[3]);
                    *(u32x4*)(Vd + kvoff + bj * HALF + 32 * wc + 8 * fq) = w; }
            } else {
                f32x4 cs = (f32x4){1.f, 1.f, 1.f, 1.f}, sn = (f32x4){0.f, 0.f, 0.f, 0.f};
                if (lat) { const float p = (d0 < 32) ? (float)(t >> 6) : (float)(t & 63);
#pragma unroll
                    for (int e = 0; e < 4; ++e) { float rev = (p * inv[e]) * 0.15915494309189535f; rev -= floorf(rev); sn[e] = __builtin_amdgcn_sinf(rev); cs[e] = __builtin_amdgcn_cosf(rev); } }
#pragma unroll
                for (int bj = 0; bj < 2; ++bj) {
                    const f32x4 pr = *(const LAS f32x4*)(P + (trow * 2 + bj) * 4);
                    const float rs = rsqrtf(((pr[0] + pr[1]) + (pr[2] + pr[3])) * (1.0f / 128.0f) + NORM_EPS);
                    const f32x4 y1 = (acc[ai][bj][m][0] * rs) * g1, y2 = (acc[ai][bj][m][1] * rs) * g2;
                    const f32x4 o1 = y1 * cs - y2 * sn, o2 = y1 * sn + y2 * cs;
                    u32x2 w1, w2; w1.x = cvt_pk_bf16(o1[0], o1[1]); w1.y = cvt_pk_bf16(o1[2], o1[3]); w2.x = cvt_pk_bf16(o2[0], o2[1]); w2.y = cvt_pk_bf16(o2[2], o2[3]);
                    if (is_k) { bf16_t* d = Kd + kvoff + bj * HALF + d0; *(u32x2*)d = w1; *(u32x2*)(d + 64) = w2; }
                    else if (lat) { bf16_t* d = Qd + (size_t)row * 1024 + (2 * u.pn + bj) * HALF + d0; *(u32x2*)d = w1; *(u32x2*)(d + 64) = w2; }
                }
            }
        }
}

__device__ __forceinline__ void gemm_phase(LAS unsigned char* lds, const LAS GJob* J, int G, int cidx, const int tid) {
    const int wid = __builtin_amdgcn_readfirstlane(tid >> 6), lane = tid & 63, wr = wid >> 2, wc = wid & 3, fr = lane & 15, fq = lane >> 4;
    const int lda = JI(lda), ldb = JI(ldb);
    unsigned voffA[2], voffB[2];
#pragma unroll
    for (int i = 0; i < 2; ++i) { int R, C; stage_rc(tid * 16 + i * 8192, R, C); const int Rb = (R & ~31) + perm32(R & 31);
        voffA[i] = (unsigned)(R * lda + C) * 2u; voffB[i] = (unsigned)(Rb * ldb + C) * 2u; }
    const size_t kstep = (size_t)(BK * 2);
    const size_t hsA = (size_t)HALF * lda * 2, hsB = (size_t)HALF * ldb * 2;
    const unsigned ldsw = (unsigned)wid * 1024u;
    const int aoff = lds_byte(wr * 64 + fr, fq * 8), boff = lds_byte(wc * 32 + fr, fq * 8);
#define PG8_SA(b, h) (((b) * 2 + (h)) * HTB)
#define PG8_SB(b, h) ((4 + (b) * 2 + (h)) * HTB)
#define PG8_STAGE(bufoff, gbase, voff) do { _Pragma("unroll") for (int _i = 0; _i < 2; ++_i) \
        __builtin_amdgcn_global_load_lds((const unsigned*)((const char*)(gbase) + (voff)[_i]), (LAS unsigned*)(lds + (bufoff) + ldsw + _i * 8192), 16, 0, 0); } while (0)
#define PG8_LDA(dst, b, h) do { _Pragma("unroll") for (int m = 0; m < 4; ++m) _Pragma("unroll") for (int k = 0; k < 2; ++k) dst[m][k] = *(const LAS bf16x8*)(lds + PG8_SA(b, h) + aoff + m * 2048 + k * 1024); } while (0)
#define PG8_LDB(dst, b, h) do { _Pragma("unroll") for (int n = 0; n < 2; ++n) _Pragma("unroll") for (int k = 0; k < 2; ++k) dst[n][k] = *(const LAS bf16x8*)(lds + PG8_SB(b, h) + boff + n * 2048 + k * 1024); } while (0)
#define PG8_MMA(ai, bj, At, Bt) do { __builtin_amdgcn_s_setprio(1); _Pragma("unroll") for (int m = 0; m < 4; ++m) _Pragma("unroll") for (int n = 0; n < 2; ++n) _Pragma("unroll") for (int k = 0; k < 2; ++k) \
        acc[ai][bj][m][n] = __builtin_amdgcn_mfma_f32_16x16x32_bf16(Bt[n][k], At[m][k], acc[ai][bj][m][n], 0, 0, 0); __builtin_amdgcn_s_setprio(0); } while (0)
#define PG8_WAIT_V(n) asm volatile("s_waitcnt vmcnt(" #n ")" ::: "memory")
#define PG8_WAIT_L(n) asm volatile("s_waitcnt lgkmcnt(" #n ")" ::: "memory")
#define PG8_BAR __builtin_amdgcn_s_barrier()
#define PG8_SCHED __builtin_amdgcn_sched_barrier(0)
    Unit cur, nxt; int ui = 0;
    LAS unsigned* const utab = (LAS unsigned*)(lds + 131072 + 9216);
    unit_table_build(utab, J, G, cidx, tid);
    asm volatile("s_waitcnt lgkmcnt(0)" ::: "memory"); __builtin_amdgcn_s_barrier(); asm volatile("" ::: "memory");
    if (!unit_fetch(utab, 0, cur)) return;
    f32x4 acc[2][2][4][2];
#pragma unroll
    for (int a = 0; a < 2; ++a)
#pragma unroll
        for (int b = 0; b < 2; ++b)
#pragma unroll
            for (int m = 0; m < 4; ++m)
#pragma unroll
                for (int n = 0; n < 2; ++n) acc[a][b][m][n] = (f32x4){0.f, 0.f, 0.f, 0.f};
    bf16x8 At[4][2], B0[2][2], B1[2][2];
    const char* cA = cur.a; const char* cB = cur.b;
    PG8_STAGE(PG8_SB(0, 0), cB, voffB); PG8_STAGE(PG8_SB(0, 1), cB + hsB, voffB); PG8_STAGE(PG8_SA(0, 0), cA, voffA); PG8_STAGE(PG8_SA(0, 1), cA + hsA, voffA);
    if (wr == 1) PG8_BAR;
    PG8_WAIT_V(2); PG8_BAR;
    PG8_STAGE(PG8_SB(1, 0), cB + kstep, voffB); PG8_STAGE(PG8_SA(1, 0), cA + kstep, voffA); PG8_STAGE(PG8_SB(1, 1), cB + hsB + kstep, voffB);
    PG8_WAIT_V(6); PG8_BAR;
    for (;;) {
        const bool has_next = unit_fetch(utab, ui + 1, nxt);
        const char* nA = has_next ? nxt.a : cA; const char* nB = has_next ? nxt.b : cB;
        const int nt = cur.nt;
        for (int t = 0; t < nt; t += 2) {
            const bool last = (t == nt - 2);
            const char* a1 = cA + (size_t)(t + 1) * kstep;
            const char* a2 = last ? nA : cA + (size_t)(t + 2) * kstep; const char* b2 = last ? nB : cB + (size_t)(t + 2) * kstep;
            const char* a3 = a2 + kstep; const char* b3 = b2 + kstep;
            PG8_LDB(B0, 0, 0); PG8_LDB(B1, 0, 1); PG8_SCHED; PG8_LDA(At, 0, 0); PG8_STAGE(PG8_SA(1, 1), a1 + hsA, voffA);
            PG8_WAIT_V(8); PG8_WAIT_L(0); PG8_BAR; PG8_MMA(0, 0, At, B0); PG8_MMA(0, 1, At, B1); PG8_BAR; PG8_SCHED;
            PG8_LDA(At, 0, 1); PG8_STAGE(PG8_SB(0, 0), b2, voffB); PG8_STAGE(PG8_SB(0, 1), b2 + hsB, voffB); PG8_STAGE(PG8_SA(0, 0), a2, voffA);
            PG8_WAIT_V(8); PG8_WAIT_L(0); PG8_BAR; PG8_MMA(1, 0, At, B0); PG8_MMA(1, 1, At, B1); PG8_BAR; PG8_SCHED;
            PG8_LDB(B0, 1, 0); PG8_LDB(B1, 1, 1); PG8_SCHED; PG8_LDA(At, 1, 0); PG8_STAGE(PG8_SA(0, 1), a2 + hsA, voffA);
            PG8_WAIT_V(8); PG8_WAIT_L(0); PG8_BAR; PG8_MMA(0, 0, At, B0); PG8_MMA(0, 1, At, B1); PG8_BAR; PG8_SCHED;
            PG8_LDA(At, 1, 1); PG8_STAGE(PG8_SB(1, 0), b3, voffB); PG8_STAGE(PG8_SB(1, 1), b3 + hsB, voffB); PG8_STAGE(PG8_SA(1, 0), a3, voffA);
            PG8_WAIT_V(8); PG8_WAIT_L(0); PG8_BAR; PG8_MMA(1, 0, At, B0); PG8_MMA(1, 1, At, B1); PG8_BAR; PG8_SCHED;
        }
        if (wr == 0) PG8_BAR;
        if (REPEAT_MASK != 0ULL && JI(dry) == 1) {   } else
#ifndef NO_FUSED
#ifndef NO_FUSEDEPI
        if (JI(fused) && cur.ks < 0) epilogue_fused(J, acc, cur, lds, wr, wc, fr, fq, wid, lane);
        else
#endif
        if (false) {}
        else
#endif
        epilogue(J, acc, cur, wr, wc, fr, fq);
        if (!has_next) break;
#pragma unroll
        for (int a = 0; a < 2; ++a)
#pragma unroll
            for (int b = 0; b < 2; ++b)
#pragma unroll
                for (int m = 0; m < 4; ++m)
#pragma unroll
                    for (int n = 0; n < 2; ++n) acc[a][b][m][n] = (f32x4){0.f, 0.f, 0.f, 0.f};
        cur = nxt; cA = nA; cB = nB; ++ui;
        if (wr == 1) PG8_BAR;
    }
    PG8_WAIT_V(0);
    PG8_BAR;
#undef PG8_SA
#undef PG8_SB
#undef PG8_STAGE
#undef PG8_LDA
#undef PG8_LDB
#undef PG8_MMA
#undef PG8_WAIT_V
#undef PG8_WAIT_L
#undef PG8_BAR
#undef PG8_SCHED
}
}
using pg8::GJob;

namespace att {
constexpr int D = 128, NW = 8, QBLK = 32, KVBLK = 64;
constexpr float SCALE = 0.088388347648318440f;
constexpr float THR = 8.f;
constexpr int LDQ = 1024, LDK = 256, LDO = 1024;
constexpr size_t SHM_V = KVBLK * D * 2, SHM_K = KVBLK * D * 2, SHM_ATTN = 2 * SHM_V + 2 * SHM_K + NW * 64 * 4;
#define KSWZ(row, colB) ((row) * 256 + ((colB) ^ (((row) & 7) << 4)))
#define SBAR() __builtin_amdgcn_sched_barrier(0)
__device__ __forceinline__ int crow(int r, int hi) { return (r & 3) + 8 * (r >> 2) + 4 * hi; }
__device__ __forceinline__ void partialSM(f32x16& p0, f32x16& p1, float& m_reg, float& mn, float& alpha) {
  constexpr float C = SCALE * 1.4426950408889634f;
  float pmax = p0[0]; for (int r = 1; r < 16; ++r) pmax = fmaxf(pmax, p0[r]); for (int r = 0; r < 16; ++r) pmax = fmaxf(pmax, p1[r]);
  { auto rr = __builtin_amdgcn_permlane32_swap(__float_as_uint(pmax), __float_as_uint(pmax), false, false);
    pmax = fmaxf(__uint_as_float(rr[0]), __uint_as_float(rr[1])); }
  if (__builtin_expect(__all(pmax - m_reg <= THR / SCALE), 1)) { mn = m_reg; alpha = 1.f; }
  else { mn = fmaxf(m_reg, pmax); alpha = __builtin_amdgcn_exp2f((m_reg - mn) * C); m_reg = mn; }
  float mnC = -mn * C;
  for (int r = 0; r < 16; ++r) p0[r] = fmaf(p0[r], C, mnC); for (int r = 0; r < 16; ++r) p1[r] = fmaf(p1[r], C, mnC);
  for (int r = 0; r < 16; ++r) p0[r] = __builtin_amdgcn_exp2f(p0[r]);
}
__device__ __forceinline__ void finishSM(f32x16& p0, f32x16& p1, float alpha, float& l_reg, bf16x8& pa0, bf16x8& pa1, bf16x8& pa2, bf16x8& pa3) {
  for (int r = 0; r < 16; ++r) p1[r] = __builtin_amdgcn_exp2f(p1[r]);
  float ps = 0; for (int r = 0; r < 16; ++r) ps += p0[r]; for (int r = 0; r < 16; ++r) ps += p1[r];
  { auto rr = __builtin_amdgcn_permlane32_swap(__float_as_uint(ps), __float_as_uint(ps), false, false);
    ps = __uint_as_float(rr[0]) + __uint_as_float(rr[1]); }
  l_reg = l_reg * alpha + ps;
#define PK4(P, BASE, OUT) do { unsigned a0 = cvt_pk_bf16(P[BASE + 0], P[BASE + 1]), a1 = cvt_pk_bf16(P[BASE + 2], P[BASE + 3]);   \
    unsigned b0 = cvt_pk_bf16(P[BASE + 4], P[BASE + 5]), b1 = cvt_pk_bf16(P[BASE + 6], P[BASE + 7]);                              \
    auto r0 = __builtin_amdgcn_permlane32_swap(a0, b0, false, false); auto r1 = __builtin_amdgcn_permlane32_swap(a1, b1, false, false); \
    u32x4 w = {r0[0], r1[0], r0[1], r1[1]}; OUT = *reinterpret_cast<bf16x8*>(&w); } while (0)
  PK4(p0, 0, pa0); PK4(p0, 8, pa1); PK4(p1, 0, pa2); PK4(p1, 8, pa3);
#undef PK4
}
__device__ __forceinline__ void qkt(f32x16& p0, f32x16& p1, const bf16_t* Ks, const bf16x8* qr, int r32, int hi) {
  p0 = f32x16{}; p1 = f32x16{};
  for (int d0 = 0; d0 < 8; ++d0) { int cb = (d0 * 16 + hi * 8) * 2;
    bf16x8 b0 = *reinterpret_cast<const bf16x8*>((const char*)Ks + KSWZ(r32, cb));
    bf16x8 b1 = *reinterpret_cast<const bf16x8*>((const char*)Ks + KSWZ(32 + r32, cb));
    p0 = __builtin_amdgcn_mfma_f32_32x32x16_bf16(b0, qr[d0], p0, 0, 0, 0);
    p1 = __builtin_amdgcn_mfma_f32_32x32x16_bf16(b1, qr[d0], p1, 0, 0, 0); }
}
__device__ __forceinline__ int v_st(int k, int c) { const int kk = (k & ~0xC) | ((k & 4) << 1) | ((k & 8) >> 1); return ((kk >> 3) * 4 + (c >> 5)) * 512 + ((kk & 7) * 32 + (c & 31)) * 2; }
__device__ __forceinline__ int v_rd_base(int lane) { return ((lane & 3) << 3) | (((lane >> 2) & 3) << 6) | (((lane >> 4) & 1) << 5) | (((lane >> 5) & 1) << 8); }
constexpr int v_rd_off(int d0, int ks, int half) { return d0 * 512 + ks * 4096 + half * 2048; }
template <int OFF> __device__ __forceinline__ s16x4 tr_read(int vb) {
  s16x4 r; asm volatile("ds_read_b64_tr_b16 %0, %1 offset:%2" : "=&v"(r) : "v"(vb), "i"(OFF) : "memory"); return r;
}
template <int D0> __device__ __forceinline__ void pv_one(f32x16& od, int vb, bf16x8 pa0, bf16x8 pa1, bf16x8 pa2, bf16x8 pa3) {
  const s16x4 l0 = tr_read<v_rd_off(D0, 0, 0)>(vb), h0 = tr_read<v_rd_off(D0, 0, 1)>(vb), l1 = tr_read<v_rd_off(D0, 1, 0)>(vb), h1 = tr_read<v_rd_off(D0, 1, 1)>(vb);
  const s16x4 l2 = tr_read<v_rd_off(D0, 2, 0)>(vb), h2 = tr_read<v_rd_off(D0, 2, 1)>(vb), l3 = tr_read<v_rd_off(D0, 3, 0)>(vb), h3 = tr_read<v_rd_off(D0, 3, 1)>(vb);
  asm volatile("s_waitcnt lgkmcnt(0)" ::: "memory"); SBAR();
#define PK(L, H) (bf16x8){L[0], L[1], L[2], L[3], H[0], H[1], H[2], H[3]}
  od = __builtin_amdgcn_mfma_f32_32x32x16_bf16(pa0, PK(l0, h0), od, 0, 0, 0);
  od = __builtin_amdgcn_mfma_f32_32x32x16_bf16(pa1, PK(l1, h1), od, 0, 0, 0);
  od = __builtin_amdgcn_mfma_f32_32x32x16_bf16(pa2, PK(l2, h2), od, 0, 0, 0);
  od = __builtin_amdgcn_mfma_f32_32x32x16_bf16(pa3, PK(l3, h3), od, 0, 0, 0);
#undef PK
}
__device__ __forceinline__ void pv_d0(f32x16* o, int vb, bf16x8 pa0, bf16x8 pa1, bf16x8 pa2, bf16x8 pa3) {
  pv_one<0>(o[0], vb, pa0, pa1, pa2, pa3); pv_one<1>(o[1], vb, pa0, pa1, pa2, pa3); pv_one<2>(o[2], vb, pa0, pa1, pa2, pa3); pv_one<3>(o[3], vb, pa0, pa1, pa2, pa3);
}
__device__ __forceinline__ void attn_dense_body(const bf16_t* __restrict__ Qb, const bf16_t* __restrict__ Kh, const bf16_t* __restrict__ Vh,
                                                bf16_t* __restrict__ Ob, int seq, char* lds, const int tid) {
  constexpr int SDEPTH = 2;
  const int wid = tid >> 6, lane = tid & 63, r32 = lane & 31, hi = lane >> 5;
  bf16_t* V_lds = (bf16_t*)lds; bf16_t* K_lds = (bf16_t*)(lds + 2 * SHM_V);
  float* ws = (float*)(lds + 2 * SHM_V + 2 * SHM_K) + wid * 64; float* li_l = ws; float* al_l = ws + 32;
  float m_reg = -1e30f, l_reg = 0; f32x16 o[4] = {}; bf16x8 qr[8];
  const bf16_t* Qw = Qb + (long)(wid * QBLK + r32) * LDQ + hi * 8;
#pragma unroll
  for (int d0 = 0; d0 < 8; ++d0) qr[d0] = *reinterpret_cast<const bf16x8*>(Qw + d0 * 16);
  const int sr = tid >> 4, sc = (tid & 15) * 8, vst0 = v_st(sr, sc), vst1 = v_st(32 + sr, sc);
  const int vb0 = (int)(uintptr_t)V_lds + v_rd_base(lane);
  struct { bf16x8 vs0, vs1, ks0, ks1; } sr_[SDEPTH];
#define LD8(p) (*reinterpret_cast<const bf16x8*>(p))
  const unsigned kvoff = (unsigned)((sr * LDK + sc) * 2);
#define SLOAD(i, k0) do { const char* vb_ = (const char*)Vh + (size_t)(k0) * (LDK * 2); const char* kb_ = (const char*)Kh + (size_t)(k0) * (LDK * 2); \
    sr_[i].vs0 = LD8(vb_ + kvoff); sr_[i].vs1 = LD8(vb_ + 32 * LDK * 2 + kvoff); \
    sr_[i].ks0 = LD8(kb_ + kvoff); sr_[i].ks1 = LD8(kb_ + 32 * LDK * 2 + kvoff); } while (0)
#define SWRITE(b, i) do { *(bf16x8*)((char*)V_lds + (b) * SHM_V + vst0) = sr_[i].vs0;          \
    *(bf16x8*)((char*)V_lds + (b) * SHM_V + vst1) = sr_[i].vs1; int kc = sc * 2;               \
    *(bf16x8*)((char*)K_lds + (b) * SHM_K + KSWZ(sr, kc)) = sr_[i].ks0;                       \
    *(bf16x8*)((char*)K_lds + (b) * SHM_K + KSWZ(32 + sr, kc)) = sr_[i].ks1; } while (0)
#define SWAIT() do { if constexpr (SDEPTH == 2) asm volatile("s_waitcnt vmcnt(4)" ::: "memory"); else asm volatile("s_waitcnt vmcnt(0)" ::: "memory"); } while (0)
#define RESC(a) do { if (__any((a) < 1.f)) { if (hi == 0) al_l[r32] = (a); asm volatile("s_waitcnt lgkmcnt(0)" ::: "memory"); \
    for (int d = 0; d < 4; ++d) for (int r = 0; r < 16; ++r) o[d][r] *= al_l[crow(r, hi)]; } } while (0)
  f32x16 pA0, pA1, pB0, pB1; float mnA, mnB, alA, alB; bf16x8 pa0, pa1, pa2, pa3; const int NT = seq / KVBLK;
  constexpr int SE = 0, SO = SDEPTH - 1;
  SLOAD(SE, 0); asm volatile("s_waitcnt vmcnt(0)" ::: "memory"); SWRITE(0, SE); __syncthreads();
  qkt(pA0, pA1, K_lds, qr, r32, hi); partialSM(pA0, pA1, m_reg, mnA, alA);
  SLOAD(SO, KVBLK); if constexpr (SDEPTH == 2) { if (2 < NT) SLOAD(SE, 2 * KVBLK); }
  SWAIT(); SWRITE(1, SO); __syncthreads();
  for (int j = 1; j + 1 < NT; j += 2) {
    SBAR(); qkt(pB0, pB1, (bf16_t*)((char*)K_lds + SHM_K), qr, r32, hi);
    finishSM(pA0, pA1, alA, l_reg, pa0, pa1, pa2, pa3); SBAR();
    SLOAD(SO, (j + SDEPTH) * KVBLK); SBAR();
    pv_d0(o, vb0, pa0, pa1, pa2, pa3); partialSM(pB0, pB1, m_reg, mnB, alB);
    __syncthreads(); SWAIT(); SWRITE(0, SE);
    RESC(alB); __syncthreads();
    SBAR(); qkt(pA0, pA1, K_lds, qr, r32, hi);
    finishSM(pB0, pB1, alB, l_reg, pa0, pa1, pa2, pa3); SBAR();
    if (SDEPTH == 1 || j + 3 < NT) SLOAD(SE, (j + 1 + SDEPTH) * KVBLK); SBAR();
    pv_d0(o, vb0 + (int)SHM_V, pa0, pa1, pa2, pa3); partialSM(pA0, pA1, m_reg, mnA, alA);
    __syncthreads(); SWAIT(); SWRITE(1, SO);
    RESC(alA); __syncthreads();
  }
  SBAR(); qkt(pB0, pB1, (bf16_t*)((char*)K_lds + SHM_K), qr, r32, hi);
  finishSM(pA0, pA1, alA, l_reg, pa0, pa1, pa2, pa3); SBAR();
  pv_d0(o, vb0, pa0, pa1, pa2, pa3); partialSM(pB0, pB1, m_reg, mnB, alB);
  __syncthreads(); RESC(alB);
  finishSM(pB0, pB1, alB, l_reg, pa0, pa1, pa2, pa3); SBAR();
  pv_d0(o, vb0 + (int)SHM_V, pa0, pa1, pa2, pa3);
  if (hi == 0) li_l[r32] = l_reg; asm volatile("s_waitcnt lgkmcnt(0)" ::: "memory");
  float rli[16];
#pragma unroll
  for (int r = 0; r < 16; ++r) rli[r] = __builtin_amdgcn_rcpf(li_l[crow(r, hi)]);
  bf16_t* Ow = Ob + (long)(wid * QBLK) * LDO;
#pragma unroll
  for (int r = 0; r < 16; ++r) { int orow = crow(r, hi);
#pragma unroll
    for (int d0 = 0; d0 < 4; ++d0) Ow[(long)orow * LDO + d0 * 32 + r32] = f2bf(o[d0][r] * rli[r]); }
#undef LD8
#undef SLOAD
#undef SWRITE
#undef SWAIT
#undef RESC
}
}

struct RowJob {
    int row0, nrows, has_y, has_next, ldy;
    const bf16_t* Y; const float* gn_post; const float* modL; int gate_off;
    const float* xsrc_lat; const float* xsrc_ctx; float* xdst_lat; float* xdst_ctx;
    const float* gn_next; const float* modN; int shift_off, scale_off; bf16_t* H;
    const float* ypart;
    bf16_t* x16;
};
constexpr int RPW = 2;
__device__ __forceinline__ void wave_sumR(float (&v)[RPW]) {
#pragma unroll
    for (int o = 1; o < 64; o <<= 1) {
#pragma unroll
        for (int r = 0; r < RPW; ++r) v[r] += __shfl_xor(v[r], o);
    }
}
__device__ __forceinline__ void row_phase(const RowJob& J, int gw, int ngw, int lane) {
    const int has_y = J.has_y, has_next = J.has_next;
    f32x4 gnp[4], gnn[4];
#pragma unroll
    for (int j = 0; j < 4; ++j) { gnp[j] = *(const f32x4*)(J.gn_post + 4 * lane + 256 * j); gnn[j] = *(const f32x4*)(J.gn_next + 4 * lane + 256 * j); }
    for (int base = J.row0 + gw * RPW; base < J.nrows; base += ngw * RPW) {
        const bool lat = base < RL; const int bidx = lat ? (base >> 12) : 8;
        const float* xs = lat ? J.xsrc_lat + (size_t)base * DM : J.xsrc_ctx + (size_t)(base - RL) * DM;
        float* xd = lat ? J.xdst_lat + (size_t)base * DM : J.xdst_ctx + (size_t)(base - RL) * DM;
        f32x4 x[RPW][4]; u32x2 yw[RPW][4];
#pragma unroll
        for (int r = 0; r < RPW; ++r)
#pragma unroll
            for (int j = 0; j < 4; ++j) x[r][j] = *(const f32x4*)(xs + (size_t)r * DM + 4 * lane + 256 * j);
        if (has_y) {
            if (!lat && J.ypart != nullptr) {
                const float* pr = J.ypart + (size_t)(base - RL) * DM;
#pragma unroll
                for (int r = 0; r < RPW; ++r)
#pragma unroll
                    for (int j = 0; j < 4; ++j) { f32x4 a = *(const f32x4*)(pr + (size_t)r * DM + 4 * lane + 256 * j);
#pragma unroll
                        for (int k2 = 1; k2 < 4; ++k2) a = a + *(const f32x4*)(pr + ((size_t)k2 * RC + r) * DM + 4 * lane + 256 * j);
                        yw[r][j].x = cvt_pk_bf16(a[0], a[1]); yw[r][j].y = cvt_pk_bf16(a[2], a[3]); }
            } else {
                const bf16_t* yr = J.Y + (size_t)base * J.ldy;
#pragma unroll
                for (int r = 0; r < RPW; ++r)
#pragma unroll
                    for (int j = 0; j < 4; ++j) yw[r][j] = *(const u32x2*)(yr + (size_t)r * J.ldy + 4 * lane + 256 * j);
            }
        }
        f32x4 gt[4], sh[4], sc[4];
        {
            const float* gate = J.modL + bidx * 6144 + J.gate_off; const float* shp = J.modN + bidx * 6144 + J.shift_off; const float* scp = J.modN + bidx * 6144 + J.scale_off;
#pragma unroll
            for (int j = 0; j < 4; ++j) { gt[j] = *(const f32x4*)(gate + 4 * lane + 256 * j); sh[j] = *(const f32x4*)(shp + 4 * lane + 256 * j); sc[j] = *(const f32x4*)(scp + 4 * lane + 256 * j); }
        }
        if (has_y) {
            float ss[RPW];
#pragma unroll
            for (int r = 0; r < RPW; ++r) { float a = 0.f;
#pragma unroll
                for (int j = 0; j < 4; ++j) { const float y0 = bflo(yw[r][j].x), y1 = bfhi(yw[r][j].x), y2 = bflo(yw[r][j].y), y3 = bfhi(yw[r][j].y); a += (y0 * y0 + y1 * y1) + (y2 * y2 + y3 * y3); }
                ss[r] = a; }
            wave_sumR(ss);
#pragma unroll
            for (int r = 0; r < RPW; ++r) { const float rs = rsqrtf(ss[r] * (1.0f / DM) + NORM_EPS);
#pragma unroll
                for (int j = 0; j < 4; ++j) { const f32x4 y = (f32x4){bflo(yw[r][j].x), bfhi(yw[r][j].x), bflo(yw[r][j].y), bfhi(yw[r][j].y)};
                    x[r][j] = x[r][j] + gt[j] * ((y * rs) * gnp[j]); *(f32x4*)(xd + (size_t)r * DM + 4 * lane + 256 * j) = x[r][j]; } }
        }
        if (J.x16 != nullptr && lat) {
#pragma unroll
            for (int r = 0; r < RPW; ++r)
#pragma unroll
                for (int j = 0; j < 4; ++j) { u32x2 w; w.x = cvt_pk_bf16(x[r][j][0], x[r][j][1]); w.y = cvt_pk_bf16(x[r][j][2], x[r][j][3]); *(u32x2*)(J.x16 + (size_t)(base + r) * DM + 4 * lane + 256 * j) = w; }
        }
        if (has_next) {
            float ss[RPW];
#pragma unroll
            for (int r = 0; r < RPW; ++r) { float a = 0.f;
#pragma unroll
                for (int j = 0; j < 4; ++j) a += (x[r][j][0] * x[r][j][0] + x[r][j][1] * x[r][j][1]) + (x[r][j][2] * x[r][j][2] + x[r][j][3] * x[r][j][3]);
                ss[r] = a; }
            wave_sumR(ss);
            bf16_t* hr = J.H + (size_t)base * DM;
#pragma unroll
            for (int r = 0; r < RPW; ++r) { const float rs = rsqrtf(ss[r] * (1.0f / DM) + NORM_EPS);
#pragma unroll
                for (int j = 0; j < 4; ++j) { const f32x4 h = ((x[r][j] * rs) * gnn[j]) * (sc[j] + 1.0f) + sh[j]; u32x2 w; w.x = cvt_pk_bf16(h[0], h[1]); w.y = cvt_pk_bf16(h[2], h[3]);
                    *(u32x2*)(hr + (size_t)r * DM + 4 * lane + 256 * j) = w; } }
        }
    }
}

__device__ __forceinline__ void qkvpost_phase(const bf16_t* raw, const float* qg, const float* kg, bf16_t* Q, bf16_t* Kb, bf16_t* Vb, int gw, int ngw, int lane) {
    const int l32 = lane & 31, d0 = 4 * l32; const bool lower = l32 < 16;
    const f32x4 qgv = *(const f32x4*)(qg + d0), kgv = *(const f32x4*)(kg + d0);
    f32x4 inv;
#pragma unroll
    for (int e = 0; e < 4; ++e) inv[e] = exp2f(-(float)((d0 + e) & 31) * (13.287712379549449f / 32.0f));
    const bool rowfreq = ((d0 & 63) < 32);
    for (int base = gw * 2; base < RT; base += ngw * 2) {
        const bool lat = base < RL;
        u32x2 qw[2][4], kw[2], vw[2];
#pragma unroll
        for (int r = 0; r < 2; ++r) { const bf16_t* rr = raw + (size_t)(base + r) * 1536 + 4 * lane;
            if (lat) {
#pragma unroll
                for (int c = 0; c < 4; ++c) qw[r][c] = *(const u32x2*)(rr + c * 256);
            }
            kw[r] = *(const u32x2*)(rr + 1024); vw[r] = *(const u32x2*)(rr + 1280); }
        f32x4 xv[2][5]; float ss[2][5];
#pragma unroll
        for (int r = 0; r < 2; ++r)
#pragma unroll
            for (int c = 0; c < 5; ++c) { const u32x2 w = (c < 4) ? qw[r][c] : kw[r];
                xv[r][c] = (f32x4){bflo(w.x), bfhi(w.x), bflo(w.y), bfhi(w.y)};
                ss[r][c] = (xv[r][c][0] * xv[r][c][0] + xv[r][c][1] * xv[r][c][1]) + (xv[r][c][2] * xv[r][c][2] + xv[r][c][3] * xv[r][c][3]); }
#pragma unroll
        for (int o = 1; o < 32; o <<= 1)
#pragma unroll
            for (int r = 0; r < 2; ++r)
#pragma unroll
                for (int c = 0; c < 5; ++c) if (c == 4 || lat) ss[r][c] += __shfl_xor(ss[r][c], o);
        const f32x4 sgn = lower ? (f32x4){-1.f, -1.f, -1.f, -1.f} : (f32x4){1.f, 1.f, 1.f, 1.f};
#pragma unroll
        for (int r = 0; r < 2; ++r) {
            const int row = base + r; const int b = lat ? (row >> 12) : ((row - RL) >> 8); const int t = lat ? (row & 4095) : ((row - RL) & 255);
            const int pos = lat ? (CTXL + t) : t;
            f32x4 cs = (f32x4){1.f, 1.f, 1.f, 1.f}, sn = (f32x4){0.f, 0.f, 0.f, 0.f};
            if (lat) { const float p = rowfreq ? (float)(t >> 6) : (float)(t & 63);
#pragma unroll
                for (int e = 0; e < 4; ++e) { float rev = (p * inv[e]) * 0.15915494309189535f; rev -= floorf(rev); sn[e] = __builtin_amdgcn_sinf(rev); cs[e] = __builtin_amdgcn_cosf(rev); } }
            f32x4 y[5], pr[5];
#pragma unroll
            for (int c = 0; c < 5; ++c) { const float rs = rsqrtf(ss[r][c] * (1.0f / 128.0f) + NORM_EPS); y[c] = (xv[r][c] * rs) * (c < 4 ? qgv : kgv); }
#pragma unroll
            for (int c = 0; c < 5; ++c) if (c == 4 || lat) {
#pragma unroll
                for (int e = 0; e < 4; ++e) pr[c][e] = __shfl_xor(y[c][e], 16); }
            const size_t kvoff = ((size_t)b * SKV + pos) * 256 + 4 * lane;
#pragma unroll
            for (int c = 0; c < 5; ++c) if (c == 4 || lat) {
                const f32x4 o4 = y[c] * cs + (pr[c] * sn) * sgn;
                u32x2 ow; ow.x = cvt_pk_bf16(o4[0], o4[1]); ow.y = cvt_pk_bf16(o4[2], o4[3]);
                if (c < 4) *(u32x2*)(Q + (size_t)row * 1024 + c * 256 + 4 * lane) = ow; else *(u32x2*)(Kb + kvoff) = ow; }
            *(u32x2*)(Vb + kvoff) = vw[r];
        }
    }
}

constexpr int KF = 2304;
__device__ __forceinline__ void fold_phase(const bf16_t* H, bf16_t* Z, bf16_t* DFTL, int gw, int ngw, int lane) {
    for (int zr = gw; zr < NBATCH * ZJ; zr += ngw) {
        const int b = zr / ZJ, j = zr % ZJ;
        int n1 = -1, n2 = -1; float sgn = 1.f;
        if (j < 2048) { n1 = j; if (j > 0) n2 = SEQ - j; }
        else if (j == 2048) { n1 = 2048; }
        else if (j >= KF) { const int n = j - KF; if (n > 0) { n1 = n; n2 = SEQ - n; sgn = -1.f; } }
#pragma unroll
        for (int q = 0; q < 2; ++q) {
            const int col = 8 * lane + 512 * q; unsigned z0; asm volatile("v_mov_b32 %0, 0" : "=v"(z0)); u32x4 o = (u32x4){z0, z0, z0, z0};
            if (n1 >= 0) {
                const u32x4 a = *(const u32x4*)(H + ((size_t)b * SEQ + n1) * DM + col);
                if (n2 >= 0) { const u32x4 c = *(const u32x4*)(H + ((size_t)b * SEQ + n2) * DM + col);
#pragma unroll
                    for (int e = 0; e < 4; ++e) o[e] = cvt_pk_bf16(bflo(a[e]) + sgn * bflo(c[e]), bfhi(a[e]) + sgn * bfhi(c[e])); }
                else o = a;
            }
            *(u32x4*)(Z + (size_t)zr * DM + col) = o;
        }
    }
    for (int k = gw; k < SEQ / 2; k += ngw) {
        for (int jb = lane; jb < ZJ / 8; jb += 64) {
            float v[8];
#pragma unroll
            for (int e = 0; e < 8; ++e) { const int j = jb * 8 + e; float val;
                if (j < 2048) val = __builtin_amdgcn_cosf((float)((k * j) & 4095) * (1.0f / 4096.0f));
                else if (j == 2048) val = (k & 1) ? -1.f : 1.f;
                else if (j < KF) val = 0.f;
                else val = __builtin_amdgcn_sinf((float)((k * (j - KF)) & 4095) * (1.0f / 4096.0f));
                v[e] = val; }
            u32x4 o; o.x = cvt_pk_bf16(v[0], v[1]); o.y = cvt_pk_bf16(v[2], v[3]); o.z = cvt_pk_bf16(v[4], v[5]); o.w = cvt_pk_bf16(v[6], v[7]);
            *(u32x4*)(DFTL + (size_t)k * ZJ + jb * 8) = o;
        }
    }
}
__device__ __forceinline__ void combine_phase(const bf16_t* PAB, const bf16_t* RTp, bf16_t* Yf, int gw, int ngw, int lane) {
    const float sc = 1.0f / 1024.0f;
    for (int r = gw; r < NBATCH * 2048; r += ngw) {
        const int b = r >> 11, k = r & 2047;
        const bf16_t* pa = PAB + ((size_t)(b * 2 + 0) * 2048 + k) * DM; const bf16_t* pb = PAB + ((size_t)(b * 2 + 1) * 2048 + k) * DM;
        bf16_t* y0 = Yf + ((size_t)b * SEQ + k) * DM; bf16_t* y1 = Yf + ((size_t)b * SEQ + (SEQ - k)) * DM;
#pragma unroll
        for (int q = 0; q < 2; ++q) { const int col = 8 * lane + 512 * q;
            const u32x4 a = *(const u32x4*)(pa + col), c = *(const u32x4*)(pb + col); u32x4 om, op;
#pragma unroll
            for (int e = 0; e < 4; ++e) { const float a0 = bflo(a[e]), a1 = bfhi(a[e]), c0 = bflo(c[e]), c1 = bfhi(c[e]);
                om[e] = cvt_pk_bf16((a0 - c0) * sc, (a1 - c1) * sc); op[e] = cvt_pk_bf16((a0 + c0) * sc, (a1 + c1) * sc); }
            *(u32x4*)(y0 + col) = om; if (k > 0) *(u32x4*)(y1 + col) = op; }
    }
    for (int t = gw; t < NBATCH * 1024; t += ngw) {
        const int b = t >> 10, m = t & 1023; const bf16_t* rr = RTp + ((size_t)b * 1024 + m) * ZJ; float s = 0.f;
#pragma unroll
        for (int c4 = 0; c4 < 4; ++c4) { const u32x4 w = *(const u32x4*)(rr + (c4 * 64 + lane) * 8);
#pragma unroll
            for (int e = 0; e < 4; ++e) s += bflo(w[e]) - bfhi(w[e]); }
        s = wave_sum(s);
        if (lane == 0) { const float ny = __uint_as_float((unsigned)rr[2048] << 16); Yf[((size_t)b * SEQ + 2048) * DM + m] = f2bf((s + ny) * sc); }
    }
}

__device__ __forceinline__ void spatial_phase(LAS unsigned char* lds, bf16_t* BIGp, const float* stats, const bf16_t* aws, const float* ln_g, const float* b_s, int nchunks, const int tid) {
    const int wid = tid >> 6, lane = tid & 63, fr = lane & 15, fq = lane >> 4;
    constexpr int LDP = 136;
    LAS bf16_t* Wl = (LAS bf16_t*)lds;
    LAS bf16_t* Vt = (LAS bf16_t*)(lds + 128 * LDP * 2);
    LAS float* St = (LAS float*)(lds + (128 + 256) * LDP * 2);
    const int G = gridDim.x, c = blockIdx.x;
    const bool fixed_g = (G % 8) == 0;
    const int per_g = fixed_g ? G / 8 : 1;
    int gcur = -1;
    bf16x8 af[4]; float bias = 0.f;
    for (int i = 0; ; ++i) {
        int ch, g;
        if (fixed_g) { g = c & 7; ch = (c >> 3) + per_g * i; if (ch >= nchunks) break; }
        else { const int u = c + G * i; if (u >= nchunks * 8) break; ch = u >> 3; g = u & 7; }
        u32x4 vw[8];
#pragma unroll
        for (int it = 0; it < 8; ++it) { const int id = it * 512 + tid, ql = id & 15, cb = (id >> 4) & 31, q = (id >> 9) * 16 + ql;
            vw[it] = *(const u32x4*)(BIGp + (size_t)(ch * 128 + q) * 4096 + 2048 + g * 256 + cb * 8); }
        const int prow = ch * 128 + 16 * wid + fr;
        bf16_t* const ubase = BIGp + (size_t)prow * 4096 + g * 256 + 8 * fq;
        u32x4 uw[8];
#pragma unroll
        for (int j = 0; j < 8; ++j) uw[j] = *(const u32x4*)(ubase + 32 * j);
        if (g != gcur) {
#pragma unroll
            for (int it = 0; it < 4; ++it) { const int id = it * 512 + tid, p = id >> 4, kc = id & 15;
                *(LAS u32x4*)(Wl + p * LDP + kc * 8) = *(const u32x4*)(aws + ((size_t)g * 128 + p) * 128 + kc * 8); }
        }
        if (tid < 128) { const float* sp = stats + (size_t)(ch * 128 + tid) * 64; float a = 0.f, q = 0.f;
#pragma unroll
            for (int k2 = 0; k2 < 32; ++k2) { a += sp[2 * k2]; q += sp[2 * k2 + 1]; }
            const float mu = a * (1.0f / 2048.0f); const float var = q * (1.0f / 2048.0f) - mu * mu;
            St[2 * tid] = mu; St[2 * tid + 1] = rsqrtf(fmaxf(var, 0.f) + LN_EPS); }
        __syncthreads();
        if (g != gcur) {
#pragma unroll
            for (int ks = 0; ks < 4; ++ks) af[ks] = *(const LAS bf16x8*)(Wl + (16 * wid + fr) * LDP + 32 * ks + 8 * fq);
            bias = b_s[g * 128 + 16 * wid + fr]; gcur = g;
        }
#pragma unroll
        for (int it = 0; it < 8; ++it) { const int id = it * 512 + tid, ql = id & 15, cb = (id >> 4) & 31, q = (id >> 9) * 16 + ql, c0 = cb * 8;
            const u32x4 w = vw[it];
            const float mu = St[2 * q], rs = St[2 * q + 1];
            const f32x4 g0 = *(const f32x4*)(ln_g + g * 256 + c0), g1 = *(const f32x4*)(ln_g + g * 256 + c0 + 4);
            const float v[8] = {bflo(w.x), bfhi(w.x), bflo(w.y), bfhi(w.y), bflo(w.z), bfhi(w.z), bflo(w.w), bfhi(w.w)};
#pragma unroll
            for (int e = 0; e < 8; ++e) { const float gg = e < 4 ? g0[e] : g1[e - 4]; Vt[(c0 + e) * LDP + q] = f2bf((v[e] - mu) * rs * gg); } }
        __syncthreads();
#pragma unroll
        for (int j = 0; j < 8; ++j) {
            f32x4 a0 = (f32x4){0.f, 0.f, 0.f, 0.f}, a1 = a0;
            const int cr = 32 * j + 8 * (fr >> 2) + (fr & 3);
#pragma unroll
            for (int ks = 0; ks < 4; ++ks) {
                const bf16x8 b0 = *(const LAS bf16x8*)(Vt + cr * LDP + 32 * ks + 8 * fq), b1 = *(const LAS bf16x8*)(Vt + (cr + 4) * LDP + 32 * ks + 8 * fq);
                a0 = __builtin_amdgcn_mfma_f32_16x16x32_bf16(b0, af[ks], a0, 0, 0, 0); a1 = __builtin_amdgcn_mfma_f32_16x16x32_bf16(b1, af[ks], a1, 0, 0, 0); }
            const u32x4 u4 = uw[j];
            u32x4 o;
            o.x = cvt_pk_bf16(bflo(u4.x) * (a0[0] + bias), bfhi(u4.x) * (a0[1] + bias)); o.y = cvt_pk_bf16(bflo(u4.y) * (a0[2] + bias), bfhi(u4.y) * (a0[3] + bias));
            o.z = cvt_pk_bf16(bflo(u4.z) * (a1[0] + bias), bfhi(u4.z) * (a1[1] + bias)); o.w = cvt_pk_bf16(bflo(u4.w) * (a1[2] + bias), bfhi(u4.w) * (a1[3] + bias));
            *(u32x4*)(ubase + 32 * j) = o;
        }
        __syncthreads();
    }
}

template <bool QKPERM> __device__ __forceinline__ void p0_transpose_item(const float* W, int K, int N, bf16_t* WT, LAS float* scr, int item, int lane) {
    const int nblk = N / 32, kb = item / nblk, nb = item % nblk, k0 = 64 * kb, n0 = 32 * nb;
    {
        const int kr = lane >> 3, nc = (lane & 7) * 4; f32x4 v[8];
        int src = n0 + nc;
        if (QKPERM && src < 1280) { const int p = src & 127; src = (src & ~127) + 16 * (p >> 5) + 4 * ((p >> 3) & 3) + 64 * ((p >> 2) & 1); }
#pragma unroll
        for (int i = 0; i < 8; ++i) v[i] = *(const f32x4*)(W + (size_t)(k0 + 8 * i + kr) * N + src);
#pragma unroll
        for (int i = 0; i < 8; ++i) {
#pragma unroll
            for (int e = 0; e < 4; ++e) scr[(8 * i + kr) * 33 + nc + e] = v[i][e]; }
    }
    asm volatile("s_waitcnt lgkmcnt(0)" ::: "memory");
    const int c = lane & 7;
#pragma unroll
    for (int j = 0; j < 4; ++j) { const int n = (lane >> 3) + 8 * j; const LAS float* s = scr + (8 * c) * 33 + n;
        u32x4 o; o.x = cvt_pk_bf16(s[0 * 33], s[1 * 33]); o.y = cvt_pk_bf16(s[2 * 33], s[3 * 33]); o.z = cvt_pk_bf16(s[4 * 33], s[5 * 33]); o.w = cvt_pk_bf16(s[6 * 33], s[7 * 33]);
        *(u32x4*)(WT + (size_t)(n0 + n) * K + k0 + 8 * c) = o; }
    asm volatile("s_waitcnt lgkmcnt(0)" ::: "memory");
}

struct Params { const float* in[19]; float* out; unsigned char* ws; int ph_lo, ph_hi; };
constexpr int LDS_PAR_OFF = 131072, LDS_BARST_OFF = 131072 + 256, LDS_JOB_OFF = 131072 + 320;
struct PView {
    LAS const unsigned char* base;
    __device__ __forceinline__ const float* in(int i) const { return pg8::jptr<const float>(base + 8 * i); }
    __device__ __forceinline__ float* out() const { return pg8::jptr<float>(base + 8 * 19); }
    __device__ __forceinline__ unsigned char* wsp() const { return pg8::jptr<unsigned char>(base + 8 * 20); }
};

__device__ __forceinline__ void prologue_phase(const PView& P, LAS unsigned char* lds, const int tid) {
    const int wid = tid >> 6, lane = tid & 63;
    unsigned char* ws = P.wsp();
    {
        LAS float* sl = (LAS float*)lds;
        LAS float* red = (LAS float*)(lds + 36864);
        float* MOD = (float*)(ws + WS_MOD);
        for (int item = blockIdx.x; item < 192; item += gridDim.x) {
            const int layer = item / 48, col0 = (item % 48) * 128;
            for (int idx = tid; idx < 9216; idx += 512) { const int r = idx >> 10, k = idx & 1023; const float v = r < 8 ? P.in(1)[r * 1024 + k] : P.in(3)[k]; sl[idx] = v / (1.0f + __expf(-v)); }
            __syncthreads();
            const int ks = tid >> 5, c4 = tid & 31;
            const float* w = P.in(4) + ((size_t)layer * 1024 + ks * 64) * 6144 + col0 + c4 * 4;
            f32x4 acc[9];
#pragma unroll
            for (int r = 0; r < 9; ++r) acc[r] = (f32x4){0.f, 0.f, 0.f, 0.f};
#pragma unroll 16
            for (int kk = 0; kk < 64; ++kk) { const f32x4 wv = *(const f32x4*)(w + (size_t)kk * 6144);
#pragma unroll
                for (int r = 0; r < 9; ++r) acc[r] = acc[r] + wv * sl[r * 1024 + ks * 64 + kk]; }
#pragma unroll
            for (int r = 0; r < 9; ++r) *(LAS f32x4*)(red + (ks * 9 + r) * 128 + c4 * 4) = acc[r];
            __syncthreads();
            for (int idx = tid; idx < 9 * 128; idx += 512) { const int r = idx >> 7, cc = idx & 127; float s = P.in(5)[layer * 6144 + col0 + cc];
#pragma unroll
                for (int k2 = 0; k2 < 16; ++k2) s += red[(k2 * 9 + r) * 128 + cc];
                MOD[(size_t)(layer * 9 + r) * 6144 + col0 + cc] = s; }
            __syncthreads();
        }
    }
    {
        LAS float* scr = (LAS float*)(lds + wid * 8448);
        const int gw = blockIdx.x * 8 + wid, ngw = gridDim.x * 8;
        constexpr int I_W1 = 16 * 128, I_W2 = 64 * 32, I_AIN = 16 * 128, I_AOUT = 32 * 32, I_BO = 16 * 32, I_QKV = 16 * 48, I_WO = 16 * 32;
        constexpr int NITEMS = 4 * I_W1 + 4 * I_W2 + 2 * I_AIN + 2 * I_AOUT + I_BO + I_QKV + I_WO;
        for (int it = gw; it < NITEMS; it += ngw) {
            int r = it;
            if (r < 4 * I_W1) { const int l = r / I_W1; p0_transpose_item<false>(P.in(7) + (size_t)l * 1024 * 4096, 1024, 4096, (bf16_t*)(ws + WS_W1T) + (size_t)l * 4096 * 1024, scr, r % I_W1, lane); continue; } r -= 4 * I_W1;
            if (r < 4 * I_W2) { const int l = r / I_W2; p0_transpose_item<false>(P.in(8) + (size_t)l * 4096 * 1024, 4096, 1024, (bf16_t*)(ws + WS_W2T) + (size_t)l * 1024 * 4096, scr, r % I_W2, lane); continue; } r -= 4 * I_W2;
            if (r < 2 * I_AIN) { const int l = r / I_AIN; p0_transpose_item<false>(P.in(9) + (size_t)l * 1024 * 4096, 1024, 4096, (bf16_t*)(ws + WS_AWINT) + (size_t)l * 4096 * 1024, scr, r % I_AIN, lane); continue; } r -= 2 * I_AIN;
            if (r < 2 * I_AOUT) { const int l = r / I_AOUT; p0_transpose_item<false>(P.in(13) + (size_t)l * 2048 * 1024, 2048, 1024, (bf16_t*)(ws + WS_AWOUTT) + (size_t)l * 1024 * 2048, scr, r % I_AOUT, lane); continue; } r -= 2 * I_AOUT;
            if (r < I_BO) { p0_transpose_item<false>(P.in(14), 1024, 1024, (bf16_t*)(ws + WS_BWOUTT), scr, r, lane); continue; } r -= I_BO;
            if (r < I_QKV) { p0_transpose_item<false>(P.in(15), 1024, 1536, (bf16_t*)(ws + WS_QKVT), scr, r, lane); continue; } r -= I_QKV;
            p0_transpose_item<false>(P.in(18), 1024, 1024, (bf16_t*)(ws + WS_WOT), scr, r, lane);
        }
    }
    {
        const int gt = blockIdx.x * 512 + tid, ngt = gridDim.x * 512;
        bf16_t* aws = (bf16_t*)(ws + WS_AWS);
        for (int i = gt; i < 2 * 8 * 128 * 128 / 8; i += ngt) { const f32x4 a = *(const f32x4*)(P.in(11) + (size_t)i * 8), b = *(const f32x4*)(P.in(11) + (size_t)i * 8 + 4);
            u32x4 o; o.x = cvt_pk_bf16(a[0], a[1]); o.y = cvt_pk_bf16(a[2], a[3]); o.z = cvt_pk_bf16(b[0], b[1]); o.w = cvt_pk_bf16(b[2], b[3]); *(u32x4*)(aws + (size_t)i * 8) = o; }
        bf16_t* cc = (bf16_t*)(ws + WS_CC); bf16_t* scm = (bf16_t*)(ws + WS_SC); bf16_t* dc = (bf16_t*)(ws + WS_DFTC);
        for (int i = gt; i < 65536; i += ngt) { const int m = i >> 8, c = i & 255; const float rev = (float)((m * c) & 255) * (1.0f / 256.0f);
            cc[i] = f2bf(__builtin_amdgcn_cosf(rev)); scm[i] = f2bf(__builtin_amdgcn_sinf(rev)); }
        for (int i = gt; i < 131072; i += ngt) { const int k = i >> 9, j = i & 511; const int n = j & 255; const float rev = (float)((k * n) & 255) * (1.0f / 256.0f);
            dc[i] = f2bf(j < 256 ? __builtin_amdgcn_cosf(rev) : -__builtin_amdgcn_sinf(rev)); }
    }
}


#define XB_TMO      128
#define XB_XCNT(j)  (256  + 64 * (j))
#define XB_XSUB(j)  (1280 + 64 * (j))
#define XB_XGEN(j)  (2304 + 64 * (j))
#define XB_TOP      3328
#define XB_TOPGEN   3392
#define XCD_BAR_WORDS 3456
#define XB_SPIN_CAP (1u << 18)
__device__ __forceinline__ unsigned xb_ld(unsigned* p)              { return __hip_atomic_load(p, __ATOMIC_RELAXED, __HIP_MEMORY_SCOPE_AGENT); }
__device__ __forceinline__ unsigned xb_add(unsigned* p, unsigned v) { return __hip_atomic_fetch_add(p, v, __ATOMIC_RELAXED, __HIP_MEMORY_SCOPE_AGENT); }
__device__ __forceinline__ unsigned xb_xcc_id() { return (unsigned)__builtin_amdgcn_s_getreg((3 << 11) | 20) & 0xFu; }
#define XB_SPIN(cond, bar) do { unsigned _sp = 0; while (cond) { __builtin_amdgcn_s_sleep(1); \
    if ((++_sp & 255u) == 0u) { if (xb_ld(&(bar)[XB_TMO])) break; if (_sp > XB_SPIN_CAP) { atomicAdd(&(bar)[XB_TMO], 1u); break; } } } } while (0)
struct XcdBarrier { unsigned* bar; unsigned x; volatile LAS unsigned* st; };
__device__ __forceinline__ XcdBarrier xcd_barrier_post(unsigned* bar, volatile LAS unsigned* st) {
    XcdBarrier b; b.bar = bar; b.x = xb_xcc_id(); b.st = st;
    if (threadIdx.x == 0) (void)xb_add(&bar[XB_XCNT(b.x)], 1u);
    return b;
}
__device__ __forceinline__ void xcd_barrier_complete(unsigned* bar, unsigned x, unsigned& nloc, unsigned& nx) {
    const unsigned G = gridDim.x * gridDim.y * gridDim.z;
    unsigned sum, cnt, mine, sp = 0u;
    for (;;) {
        sum = 0u; cnt = 0u; mine = 0u;
#pragma unroll
        for (unsigned j = 0; j < 16; ++j) { const unsigned c = xb_ld(&bar[XB_XCNT(j)]); sum += c; cnt += (c > 0u) ? 1u : 0u; mine = (j == x) ? c : mine; }
        if (sum == G) break;
        __builtin_amdgcn_s_sleep(1);
        if ((++sp & 255u) == 0u) { if (xb_ld(&bar[XB_TMO])) break; if (sp > XB_SPIN_CAP) { atomicAdd(&bar[XB_TMO], 1u); break; } }
    }
    nloc = mine > 0u ? mine : 1u; nx = cnt > 0u ? cnt : 1u;
}
__device__ __forceinline__ void xcd_barrier(const XcdBarrier& b) {
    asm volatile("s_waitcnt vmcnt(0)" ::: "memory");
    __syncthreads();
    if (threadIdx.x == 0) {
        unsigned* bar = b.bar;
        __builtin_amdgcn_s_waitcnt(0);
        unsigned nloc = b.st[0], nx = b.st[1];
        if (nloc == 0u) { xcd_barrier_complete(bar, b.x, nloc, nx); b.st[0] = nloc; b.st[1] = nx; }
        const unsigned old = xb_add(&bar[XB_XSUB(b.x)], 1u);
        const unsigned gen = old / nloc;
        if (old + 1u == (gen + 1u) * nloc) {
            __builtin_amdgcn_fence(__ATOMIC_RELEASE, "agent");
            asm volatile("s_waitcnt vmcnt(0)" ::: "memory");
            const unsigned og = xb_add(&bar[XB_TOP], 1u);
            const unsigned tg = og / nx;
            if (og + 1u == (tg + 1u) * nx) xb_add(&bar[XB_TOPGEN], 1u);
            else XB_SPIN(xb_ld(&bar[XB_TOPGEN]) == tg, bar);
            xb_add(&bar[XB_XGEN(b.x)], 1u);
            __builtin_amdgcn_fence(__ATOMIC_ACQUIRE, "agent");
            asm volatile("s_waitcnt vmcnt(0)" ::: "memory");
        } else {
            XB_SPIN(xb_ld(&bar[XB_XGEN(b.x)]) == gen, bar);
            __builtin_amdgcn_fence(__ATOMIC_ACQUIRE, "agent");
            asm volatile("s_waitcnt vmcnt(0)" ::: "memory");
        }
    }
    __syncthreads();
}

enum { K_PRO = 0, K_ROW, K_GEMM, K_SPATIAL, K_FOLD, K_QKVPOST, K_ATTN, K_NONE };
constexpr int NPH = 34;

__device__ __forceinline__ GJob mkgemm(const bf16_t* A, int lda, const bf16_t* B, int ldb, void* C, int ldc, int M, int N, int K, int act, int out_f32) {
    int z; asm volatile("v_mov_b32 %0, 0" : "=v"(z));
    GJob g; g.A = A; g.A2 = A; g.a2mask = (unsigned)z; g.lda = lda; g.B = B; g.b_bs_hi = z; g.b_bs_lo = z; g.bdiv = 1; g.b_pn_mod = 1 << 20; g.ldb = ldb;
    g.C = C; g.c_bs = z; g.ldc = ldc; g.out_f32 = out_f32; g.act = act; g.scale = 1.0f; g.stats = (float*)(size_t)z; g.stats_pn0 = z; g.nM = M / 256; g.nN = N / 256; g.nB = 1; g.K = K; g.part = (float*)(size_t)z; g.split_pm0 = 1 << 20; g.ksplit = 1; g.fused = z; g.has_next = z; g.gate_off = z; g.shift_off = z; g.scale_off = z; g.x_mode = z;
    g.xsrc = (const float*)(size_t)z; g.xdst = (float*)(size_t)z; g.Hout = (bf16_t*)(size_t)z; g.gn_post = g.xsrc; g.gn_next = g.xsrc; g.modL = g.xsrc; g.modN = g.xsrc; g.slot1 = (unsigned*)(size_t)z; g.slot2 = g.slot1; g.cnt1 = g.slot1; g.cnt2 = g.slot1; g.kf = z; g.dry = z; g.Kd = g.Hout; g.Vd = g.Hout; g.qg = g.xsrc; g.kg = g.xsrc; return g;
}
__device__ __forceinline__ RowJob mkrow(const PView& P, int layer, int which, int nrows, const bf16_t* Y, bf16_t* H) {
    unsigned char* ws = P.wsp();
    const float* norm_g = P.in(6); const float* MOD = (const float*)(ws + WS_MOD); float* out = P.out(); float* XC = (float*)((unsigned char*)out + OUT_XC);
    RowJob r; r.row0 = (which != 0) ? RL : 0; r.nrows = nrows; r.has_y = which != 0; r.ldy = DM; r.Y = Y; r.H = H;
    r.ypart = (which != 0 && layer <= 1) ? (const float*)((unsigned char*)out + OUT_PART) : nullptr;
    r.x16 = (which == 0) ? (bf16_t*)(ws + WS_X16) : nullptr;
    r.modL = MOD + (size_t)layer * 9 * 6144; r.gn_post = norm_g + (layer * 4 + (which == 1 ? 1 : 3)) * DM; r.gate_off = (which == 1 ? 2 : 5) * DM;
    const bool first = (layer == 0 && which <= 1);
    r.xsrc_lat = first ? P.in(0) : out; r.xsrc_ctx = first ? P.in(2) : XC; r.xdst_lat = out; r.xdst_ctx = XC;
    if (which == 0) { r.has_next = 1; r.gn_next = norm_g + (layer * 4 + 0) * DM; r.modN = r.modL; r.shift_off = 0; r.scale_off = DM; }
    else if (which == 1) { r.has_next = 1; r.gn_next = norm_g + (layer * 4 + 2) * DM; r.modN = r.modL; r.shift_off = 3 * DM; r.scale_off = 4 * DM; }
    else { r.has_next = layer < 3; const int nl = layer < 3 ? layer + 1 : layer; r.gn_next = norm_g + (nl * 4 + 0) * DM; r.modN = MOD + (size_t)nl * 9 * 6144; r.shift_off = 0; r.scale_off = DM; }
    return r;
}

__device__ __forceinline__ void phase_info(int ph, int& kind, int& sync, int& a, int& rows) {
    kind = K_GEMM; sync = 1; a = 0; rows = RT;
    switch (ph) {
        case 0: kind = K_PRO; break;
        case 1: kind = K_ROW; a = 0; break;
        case 3: kind = K_SPATIAL; a = 0; rows = RT; break;
        case 28: kind = K_SPATIAL; a = 1; rows = RL; break;
        case 5: kind = K_ROW; a = 1; break;
        case 8: kind = K_ROW; a = 2; sync = 0; break;
        case 9: kind = K_FOLD; break;
        case 10: sync = 0; break;
        case 12: sync = 0; break;
        case 15: kind = K_ROW; a = 3; break;
        case 18: kind = K_ROW; a = 4; break;
        case 20: kind = K_QKVPOST; break;
        case 21: kind = K_ATTN; break;
        case 23: case 26: case 30: case 33: kind = K_NONE; sync = 0; break;
        case 32: sync = 0; break;
        default: break;
    }
}
__device__ __forceinline__ GJob gemm_job(int ph, const PView& P) {
    unsigned char* ws = P.wsp();
    bf16_t* YH = (bf16_t*)(ws + WS_YH); unsigned char* BIG = ws + WS_BIG; bf16_t* BIGb = (bf16_t*)BIG; float* STATS = (float*)((unsigned char*)P.out() + OUT_STATS);
    GJob g = mkgemm(YH, DM, YH, DM, YH, DM, 256, 256, 256, 0, 0);
    int up_layer = -1, down_layer = -1, rows = RT;
    switch (ph) {
        case 2: case 27: { const int j = ph == 2 ? 0 : 1; rows = ph == 2 ? RT : RL;
            g = mkgemm(YH, DM, (const bf16_t*)(ws + WS_AWINT) + (size_t)j * 4096 * 1024, DM, BIGb, 4096, rows, 4096, 1024, 1, 0); g.stats = STATS; g.stats_pn0 = 8; break; }
        case 4: case 29: { const int j = ph == 4 ? 0 : 1; rows = ph == 4 ? RT : RL;
            g = mkgemm(BIGb, 4096, (const bf16_t*)(ws + WS_AWOUTT) + (size_t)j * 1024 * 2048, 2048, YH, DM, rows, 1024, 2048, 0, 0); break; }
        case 6: up_layer = 0; rows = RT; break;
        case 7: down_layer = 0; rows = RT; break;
        case 16: up_layer = 1; rows = RT; break;
        case 17: down_layer = 1; rows = RT; break;
        case 24: up_layer = 2; rows = RL; break;
        case 25: down_layer = 2; rows = RL; break;
        case 31: up_layer = 3; rows = RL; break;
        case 32: down_layer = 3; rows = RL; break;
        case 10: { g = mkgemm((const bf16_t*)(ws + WS_CC), 256, (const bf16_t*)(BIG + BIG_Z), DM, BIG + BIG_RT, ZJ, 256, ZJ, 256, 0, 0);
            g.A2 = (const bf16_t*)(ws + WS_SC); g.a2mask = 0x1FE00u; g.nB = 32; g.bdiv = 4; g.b_bs_hi = ZJ * DM; g.b_bs_lo = 256; g.c_bs = 256 * ZJ; break; }
        case 11: { g = mkgemm((const bf16_t*)(ws + WS_CC), 256, YH + (size_t)RL * DM, DM, BIG + BIG_RTC, 512, 256, 512, 256, 0, 0);
            g.A2 = (const bf16_t*)(ws + WS_SC); g.a2mask = 0x2u; g.nB = 32; g.bdiv = 4; g.b_bs_hi = CTXL * DM; g.b_bs_lo = 256; g.b_pn_mod = 1; g.c_bs = 256 * 512; break; }
        case 12: { g = mkgemm((const bf16_t*)(BIG + BIG_DFTL), ZJ, (const bf16_t*)(BIG + BIG_RT), ZJ, BIG + BIG_Y2, DM, SEQ / 2, 1024, ZJ, 0, 0);
            g.nB = 16; g.bdiv = 2; g.b_bs_hi = 1024 * ZJ; g.b_bs_lo = KF; g.c_bs = (SEQ / 2) * DM; g.kf = KF; break; }
        case 13: { g = mkgemm((const bf16_t*)(ws + WS_DFTC), 512, (const bf16_t*)(BIG + BIG_RTC), 512, YH + (size_t)RL * DM, DM, CTXL, 1024, 512, 0, 0);
            g.nB = 8; g.b_bs_hi = 1024 * 512; g.c_bs = CTXL * DM; g.scale = 1.0f / 256.0f; break; }
        case 14: g = mkgemm(YH, DM, (const bf16_t*)(ws + WS_BWOUTT), DM, BIG + BIG_Y2, DM, RT, 1024, 1024, 0, 0); break;
        case 19: g = mkgemm(YH, DM, (const bf16_t*)(ws + WS_QKVT), DM, BIG + BIG_RAW, 1536, RT, 1536, 1024, 0, 0); break;
        case 22: g = mkgemm((const bf16_t*)(BIG + BIG_O), DM, (const bf16_t*)(ws + WS_WOT), DM, YH, DM, RL, 1024, 1024, 0, 0); break;
        default: break;
    }
    if (down_layer >= 0 && rows == RT) {   }
    if (up_layer >= 0) g = mkgemm(YH, DM, (const bf16_t*)(ws + WS_W1T) + (size_t)up_layer * 4096 * 1024, DM, BIGb, 4096, rows, 4096, 1024, 2, 0);
    if (down_layer >= 0) g = mkgemm(BIGb, 4096, (const bf16_t*)(ws + WS_W2T) + (size_t)down_layer * 1024 * 4096, 4096, YH, DM, rows, 1024, 4096, 0, 0);
    if (ph == 4 || ph == 7 || ph == 14 || ph == 17) { g.part = (float*)((unsigned char*)P.out() + OUT_PART); g.split_pm0 = RL / 256; g.ksplit = 4; }
    {
        int layer = -1, which = 0;
        switch (ph) { case 4: layer = 0; which = 1; break; case 7: layer = 0; which = 2; break; case 14: layer = 1; which = 1; break; case 17: layer = 1; which = 2; break;
                      case 22: layer = 2; which = 1; break; case 25: layer = 2; which = 2; break; case 29: layer = 3; which = 1; break; case 32: layer = 3; which = 2; break; default: break; }
        if (layer >= 0) {
            const float* norm_g = P.in(6); const float* MOD = (const float*)(ws + WS_MOD); float* out = P.out();
            g.fused = 1; g.modL = MOD + (size_t)layer * 9 * 6144; g.gn_post = norm_g + (layer * 4 + (which == 1 ? 1 : 3)) * DM; g.gate_off = (which == 1 ? 2 : 5) * DM;
            const bool firstu = (layer == 0 && which == 1), lastu = (layer == 3 && which == 2);
            g.xsrc = (const float*)(ws + WS_X16); g.xdst = lastu ? out : (float*)(ws + WS_X16); g.x_mode = (lastu ? 2 : 0); g.Hout = YH; (void)firstu;
            if (which == 1) { g.has_next = 1; g.gn_next = norm_g + (layer * 4 + 2) * DM; g.modN = g.modL; g.shift_off = 3 * DM; g.scale_off = 4 * DM; }
            else { g.has_next = layer < 3; const int nl = layer < 3 ? layer + 1 : layer; g.gn_next = norm_g + (nl * 4 + 0) * DM; g.modN = MOD + (size_t)nl * 9 * 6144; g.shift_off = 0; g.scale_off = DM; }
            g.slot1 = (unsigned*)(ws + WS_XS1); g.slot2 = (unsigned*)(ws + WS_XS2);
            g.cnt1 = (unsigned*)(ws + WS_CNT) + (size_t)(ph * 2 + 0) * 136 * 64; g.cnt2 = (unsigned*)(ws + WS_CNT) + (size_t)(ph * 2 + 1) * 136 * 64;
        }
    }
    return g;
}

__global__ void __launch_bounds__(512) mega_fwd(Params Pk) {
    extern __shared__ __attribute__((aligned(16))) unsigned char lds_raw[];
    cg::grid_group grid = cg::this_grid();
    LAS unsigned char* lds = (LAS unsigned char*)lds_raw;
    const int G = gridDim.x, cidx = blockIdx.x;
    {
        const int t0 = threadIdx.x;
        LAS unsigned long long* par = (LAS unsigned long long*)(lds + LDS_PAR_OFF);
        if (t0 < 19) par[t0] = (unsigned long long)Pk.in[t0];
        if (t0 == 19) par[19] = (unsigned long long)Pk.out;
        if (t0 == 20) par[20] = (unsigned long long)Pk.ws;
        if (t0 == 21) { ((LAS unsigned*)(lds + LDS_BARST_OFF))[0] = 0u; ((LAS unsigned*)(lds + LDS_BARST_OFF))[1] = 0u; }
    }
    __syncthreads();
    if ((Pk.ph_hi - Pk.ph_lo) > 1) (void)xcd_barrier_post((unsigned*)(Pk.ws + WS_BAR), (volatile LAS unsigned*)(lds + LDS_BARST_OFF));
    PView P; P.base = lds + LDS_PAR_OFF;
    LAS GJob* jl = (LAS GJob*)(lds + LDS_JOB_OFF);

    const int ph_lo = Pk.ph_lo, ph_hi = Pk.ph_hi;
    int replayed = 0;
    for (int ph = ph_lo; ph < ph_hi; ++ph) {
        int tid = threadIdx.x; asm volatile("" : "+v"(tid));
        const int wid = __builtin_amdgcn_readfirstlane(tid >> 6), lane = tid & 63;
        const int gw = cidx * 8 + wid, ngw = G * 8;
        int kind, sync, a, rows;
        phase_info(ph, kind, sync, a, rows);
        if (ph == 14 && !replayed && ph_lo == 0) {
            unsigned char* wsx = P.wsp();
            combine_phase((const bf16_t*)(wsx + WS_BIG + BIG_Y2), (const bf16_t*)(wsx + WS_BIG + BIG_RT), (bf16_t*)(wsx + WS_YH), gw, ngw, lane);
            XcdBarrier xbar; xbar.bar = (unsigned*)(wsx + WS_BAR); xbar.x = xb_xcc_id(); xbar.st = (volatile LAS unsigned*)(lds + LDS_BARST_OFF);
            xcd_barrier(xbar);
        }
        if (kind == K_GEMM) {
            if (tid == 0) { GJob g = gemm_job(ph, P); if (REPEAT_MASK != 0ULL && ((REPEAT_MASK >> ph) & 1ULL) && !replayed && DRY_ALL) g.dry = DRY_ALL; const int* src = (const int*)&g; LAS int* dst = (LAS int*)jl;
#pragma unroll
                for (int q = 0; q < (int)(sizeof(GJob) / 4); ++q) dst[q] = src[q]; }
            __syncthreads();
#ifndef NO_GEMM
            pg8::gemm_phase(lds, jl, G, cidx, tid);
#endif
        } else if (kind == K_ROW) {
            unsigned char* ws = P.wsp(); bf16_t* YH = (bf16_t*)(ws + WS_YH);
            const int layer = a == 0 ? 0 : (a - 1) >> 1, which = a == 0 ? 0 : ((a - 1) & 1) + 1;
            const bf16_t* Y = (a == 3) ? (const bf16_t*)(ws + WS_BIG + BIG_Y2) : YH;
            const int nr = (a == 4) ? RT : rows;
            const RowJob r = mkrow(P, layer, which, nr, Y, YH);
#ifndef NO_ROW
            row_phase(r, gw, ngw, lane);
#endif
        } else if (kind == K_PRO) {
#ifndef NO_PRO
            prologue_phase(P, lds, tid);
#endif
        } else if (kind == K_SPATIAL) {
            unsigned char* ws = P.wsp();
            spatial_phase(lds, (bf16_t*)(ws + WS_BIG), (const float*)((unsigned char*)P.out() + OUT_STATS), (const bf16_t*)(ws + WS_AWS) + (size_t)a * 8 * 128 * 128, P.in(10) + a * 2048, P.in(12) + a * 8 * 128, rows / 128, tid);
        } else if (kind == K_FOLD) {
            unsigned char* ws = P.wsp();
            fold_phase((const bf16_t*)(ws + WS_YH), (bf16_t*)(ws + WS_BIG + BIG_Z), (bf16_t*)(ws + WS_BIG + BIG_DFTL), gw, ngw, lane);
        } else if (kind == K_QKVPOST) {
            unsigned char* ws = P.wsp();
            qkvpost_phase((const bf16_t*)(ws + WS_BIG + BIG_RAW), P.in(16), P.in(17), (bf16_t*)(ws + WS_YH), (bf16_t*)(ws + WS_BIG + BIG_K), (bf16_t*)(ws + WS_BIG + BIG_V), gw, ngw, lane);
        } else if (kind == K_ATTN) {
            unsigned char* ws = P.wsp(); unsigned char* BIG = ws + WS_BIG; const bf16_t* YH = (const bf16_t*)(ws + WS_YH);
            const int xcd = cidx & 7, slot = cidx >> 3, per = G >> 3;
            for (int i = 0; ; ++i) {
                const int v = (G % 8 == 0) ? (i * G + xcd * per + slot) : (i * G + cidx);
                if (v >= 1024) break;
                const int qb = v & 15, hh = (v >> 4) & 3, kvh = (v >> 6) & 1, b = v >> 7, h = kvh * 4 + hh;
                const bf16_t* Qb = YH + ((size_t)b * SEQ + qb * 256) * 1024 + h * 128;
                const bf16_t* Kh = (const bf16_t*)(BIG + BIG_K) + (size_t)b * SKV * 256 + kvh * 128;
                const bf16_t* Vh = (const bf16_t*)(BIG + BIG_V) + (size_t)b * SKV * 256 + kvh * 128;
                bf16_t* Ob = (bf16_t*)(BIG + BIG_O) + ((size_t)b * SEQ + qb * 256) * 1024 + h * 128;
#ifndef NO_ATT
                att::attn_dense_body(Qb, Kh, Vh, Ob, SKV, (char*)lds_raw, tid);
#endif
                __syncthreads();
            }
        }
        if (REPEAT_MASK != 0ULL) { if (((REPEAT_MASK >> ph) & 1ULL) && !replayed) { replayed = 1; --ph; __syncthreads(); continue; } replayed = 0; }
        if (sync && ph + 1 < ph_hi) for (int srep = 0; srep < SYNC_REP; ++srep) {
            if (ph == 0) {
                asm volatile("s_waitcnt vmcnt(0) lgkmcnt(0)" ::: "memory");
                __syncthreads();
                if (wid == 0) { __builtin_amdgcn_fence(__ATOMIC_RELEASE, "agent"); asm volatile("s_waitcnt vmcnt(0) lgkmcnt(0)" ::: "memory"); }
                grid.sync();
                if (wid == 0) { __builtin_amdgcn_fence(__ATOMIC_ACQUIRE, "agent"); asm volatile("s_waitcnt vmcnt(0) lgkmcnt(0)" ::: "memory"); }
                __syncthreads();
            } else {
                XcdBarrier xbar; xbar.bar = (unsigned*)(P.wsp() + WS_BAR); xbar.x = xb_xcc_id(); xbar.st = (volatile LAS unsigned*)(lds + LDS_BARST_OFF);
                xcd_barrier(xbar);
            }
        }
    }
}


#ifdef STOP_PH
__global__ void __launch_bounds__(256) dump_kernel(const unsigned char* ws, float* out) {
    const bf16_t* YH = (const bf16_t*)(ws + WS_YH); const bf16_t* BIGb = (const bf16_t*)(ws + WS_BIG);
    for (size_t i = (size_t)blockIdx.x * 256 + threadIdx.x; i < (size_t)RL * DM; i += (size_t)gridDim.x * 256) {
        const size_t r = i >> 10, c = i & 1023;
        float v = __uint_as_float((unsigned)YH[i] << 16);
        for (int k = 0; k < 4; ++k) v += __uint_as_float((unsigned)BIGb[r * 4096 + c + 1024 * k] << 16);
        if (STOP_PH >= 6) v += out[i];
        out[i] = v;
    }
}
#endif
extern "C" void kernel_launch(void* const* d_in, const int* in_sizes, int n_in, void* d_out, int out_size, void* d_ws, size_t ws_size, hipStream_t stream) {
    static int grid = 0;
    if (grid == 0) {
        if (n_in != 19 || out_size != RL * DM || ws_size < WS_END) { fprintf(stderr, "kernel_launch: unexpected shapes (n_in %d out %d ws %zu, need ws >= %zu)\n", n_in, out_size, ws_size, (size_t)WS_END); grid = -1; return; }
        int dev = 0, cus = 0, per_cu = 0;
        (void)hipGetDevice(&dev);
        (void)hipDeviceGetAttribute(&cus, hipDeviceAttributeMultiprocessorCount, dev);
        if (hipFuncSetAttribute((const void*)mega_fwd, hipFuncAttributeMaxDynamicSharedMemorySize, LDS_BYTES) != hipSuccess) { fprintf(stderr, "kernel_launch: hipFuncSetAttribute failed\n"); grid = -1; return; }
        if (hipOccupancyMaxActiveBlocksPerMultiprocessor(&per_cu, (const void*)mega_fwd, 512, LDS_BYTES) != hipSuccess || per_cu < 1) { fprintf(stderr, "kernel_launch: occupancy query gave %d\n", per_cu); per_cu = 1; }
        (void)hipGetLastError();
        grid = cus * per_cu;
        fprintf(stderr, "kernel_launch: grid %d (cus %d x %d)\n", grid, cus, per_cu);
    }
    if (grid < 0) return;
    Params p{};
    for (int i = 0; i < 19; ++i) p.in[i] = (const float*)d_in[i];
    p.out = (float*)d_out; p.ws = (unsigned char*)d_ws;
#ifndef MK_MULTI
#define MK_MULTI 0
#endif
#if MK_MULTI
    static const int cuts[] = {0,1,2,3,4,5,6,7,8,9,10,12,14,15,16,17,18,19,20,21,22,23,24,25,26,27,28,29,30,31,32,33,34};
    hipError_t e = hipSuccess;
    for (int li = 0; li + 1 < (int)(sizeof(cuts) / sizeof(int)); ++li) {
        p.ph_lo = cuts[li]; p.ph_hi = cuts[li + 1];
#ifdef STOP_PH
        if (p.ph_hi > STOP_PH) break;
#endif
        hipLaunchKernelGGL(mega_fwd, dim3(grid), dim3(512), LDS_BYTES, stream, p);
    }
#ifdef STOP_PH
    hipLaunchKernelGGL(dump_kernel, dim3(2048), dim3(256), 0, stream, (const unsigned char*)d_ws, (float*)d_out);
#endif
    e = hipPeekAtLastError();
#else
    p.ph_lo = 0; p.ph_hi = NPH;
    (void)hipMemsetAsync((unsigned char*)d_ws + WS_CNT, 0, CNT_BYTES, stream);
    (void)hipMemsetAsync((unsigned char*)d_ws + WS_BAR, 0, 16384, stream);
    void* args[] = {&p};
    hipError_t e = hipLaunchCooperativeKernel((const void*)mega_fwd, dim3(grid), dim3(512), args, LDS_BYTES, stream);
#endif
    if (e != hipSuccess) fprintf(stderr, "kernel_launch: cooperative launch failed: %s (grid %d)\n", hipGetErrorString(e), grid);
}
```

```cpp
#include <hip/hip_runtime.h>
#ifndef DRY_ALL
#define DRY_ALL 0
#endif
#ifndef NT_STORES
#define NT_STORES 0
#endif
#ifndef SYNC_REP
#define SYNC_REP 1
#endif
#ifndef REPEAT_MASK
#define REPEAT_MASK 0ULL
#endif
#include <hip/hip_cooperative_groups.h>
#include <cstdio>
#include <cstdint>
namespace cg = cooperative_groups;

#define LAS __attribute__((address_space(3)))
typedef unsigned short bf16_t;
typedef short bf16x8 __attribute__((ext_vector_type(8)));
typedef short s16x4 __attribute__((ext_vector_type(4)));
typedef float f32x4 __attribute__((ext_vector_type(4)));
typedef float f32x16 __attribute__((ext_vector_type(16)));
typedef unsigned u32x4 __attribute__((ext_vector_type(4)));
typedef unsigned u32x2 __attribute__((ext_vector_type(2)));

constexpr int DM = 1024, NBATCH = 8, SEQ = 4096, CTXL = 256;
constexpr int RL = NBATCH * SEQ;
constexpr int RC = NBATCH * CTXL;
constexpr int RT = RL + RC;
constexpr int SKV = CTXL + SEQ;
constexpr int ZJ = 4352;
constexpr float NORM_EPS = 1e-6f, LN_EPS = 1e-5f;

constexpr size_t MiB = 1u << 20;
constexpr size_t WS_MOD = 0;
constexpr size_t WS_BAR = 901120;
constexpr size_t WS_XS1 = 1 * MiB;
constexpr size_t WS_XS2 = 2 * MiB;
constexpr size_t WS_CNT = 3 * MiB;
constexpr size_t CNT_BYTES = (size_t)34 * 2 * 136 * 256;
constexpr size_t WS_CC = 10 * MiB;
constexpr size_t WS_SC = WS_CC + 131072;
constexpr size_t WS_DFTC = WS_SC + 131072;
constexpr size_t WS_AWS = 11 * MiB;
constexpr size_t WS_W1T = 12 * MiB;
constexpr size_t WS_W2T = 44 * MiB;
constexpr size_t WS_AWINT = 76 * MiB;
constexpr size_t WS_AWOUTT = 92 * MiB;
constexpr size_t WS_BWOUTT = 100 * MiB;
constexpr size_t WS_QKVT = 102 * MiB;
constexpr size_t WS_WOT = 105 * MiB;
constexpr size_t WS_YH = 107 * MiB;
constexpr size_t WS_BIG = 175 * MiB;
constexpr size_t WS_X16 = 447 * MiB;
constexpr size_t WS_END = 511 * MiB;
constexpr size_t OUT_PART = 0;
constexpr size_t OUT_STATS = 32 * MiB;
constexpr size_t OUT_XC = 41 * MiB;
constexpr size_t BIG_Z = 0;
constexpr size_t BIG_DFTL = 68 * MiB;
constexpr size_t BIG_RT = 102 * MiB;
constexpr size_t BIG_RTC = 170 * MiB;
constexpr size_t BIG_Y2 = 178 * MiB;
constexpr size_t BIG_RAW = 0;
constexpr size_t BIG_K = 204 * MiB;
constexpr size_t BIG_V = 221 * MiB;
constexpr size_t BIG_Q = 0;
constexpr size_t BIG_O = 68 * MiB;

constexpr int LDS_BYTES = 141312;
constexpr int LDS_XP_OFF = 131072 + 1024, LDS_XS_OFF = 131072 + 5120, LDS_XF_OFF = 131072 + 6144;

typedef __bf16 bf16v2_t __attribute__((ext_vector_type(2)));
typedef float f32v2_t __attribute__((ext_vector_type(2)));
__device__ __forceinline__ unsigned cvt_pk_bf16(float lo, float hi) { const f32v2_t v = {lo, hi}; const bf16v2_t b = __builtin_convertvector(v, bf16v2_t); return __builtin_bit_cast(unsigned, b); }
__device__ __forceinline__ bf16_t f2bf(float f) { return (bf16_t)(cvt_pk_bf16(f, 0.f) & 0xffffu); }
__device__ __forceinline__ float bflo(unsigned w) { return __uint_as_float(w << 16); }
__device__ __forceinline__ float bfhi(unsigned w) { return __uint_as_float(w & 0xffff0000u); }
__device__ __forceinline__ float wave_sum(float v) {
#pragma unroll
    for (int o = 1; o < 64; o <<= 1) v += __shfl_xor(v, o);
    return v;
}
__device__ __forceinline__ float gelu_tanh(float x) {
    const float z2 = 1.5957691216057308f * (x + 0.044715f * x * x * x);
    const float e = __builtin_amdgcn_exp2f(-z2 * 1.4426950408889634f);
    return x * __builtin_amdgcn_rcpf(1.0f + e);
}

__device__ __forceinline__ f32x4 gelu_tanh4(f32x4 x) {
    f32x4 t = x * x; t = t * 0.044715f + 1.0f; t = t * x;
    const f32x4 a = t * (-2.3022082f);
    f32x4 e; e[0] = __builtin_amdgcn_exp2f(a[0]); e[1] = __builtin_amdgcn_exp2f(a[1]); e[2] = __builtin_amdgcn_exp2f(a[2]); e[3] = __builtin_amdgcn_exp2f(a[3]);
    const f32x4 d = e + 1.0f;
    f32x4 r; r[0] = __builtin_amdgcn_rcpf(d[0]); r[1] = __builtin_amdgcn_rcpf(d[1]); r[2] = __builtin_amdgcn_rcpf(d[2]); r[3] = __builtin_amdgcn_rcpf(d[3]);
    return x * r;
}
__device__ __forceinline__ f32x4 relu2_4(f32x4 x) {
    f32x4 m; m[0] = fmaxf(x[0], 0.f); m[1] = fmaxf(x[1], 0.f); m[2] = fmaxf(x[2], 0.f); m[3] = fmaxf(x[3], 0.f);
    return x * m;
}

namespace pg8 {
constexpr int BM = 256, BK = 64, HALF = 128, HTB = HALF * BK * 2, STAGE_BYTES = 8 * HTB, NXCD = 8, WGM = 8;
__host__ __device__ __forceinline__ int lds_byte(int r, int c) { const int st = (r >> 4) * 2 + (c >> 5), rr = r & 15, cc = c & 31, ob = rr * 64 + cc * 2; return st * 1024 + (ob ^ (((ob >> 9) & 1) << 5)); }
__host__ __device__ __forceinline__ void stage_rc(int b, int& R, int& C) { const int st = b / 1024, sb = b % 1024, swz = sb ^ (((sb >> 9) & 1) << 5); R = (st >> 1) * 16 + swz / 64; C = (st & 1) * 32 + (swz % 64) / 2; }
__host__ __device__ __forceinline__ int perm32(int rho) { const int n = rho >> 4, i = rho & 15; return 8 * (i >> 2) + 4 * n + (i & 3); }

struct GJob {
    const bf16_t* A; const bf16_t* A2; const bf16_t* B; void* C; float* stats;
    unsigned a2mask; int lda; int b_bs_hi, b_bs_lo, bdiv, b_pn_mod, ldb;
    int c_bs, ldc, out_f32, act; float scale;
    int stats_pn0;
    int nM, nN, nB, K;
    float* part; int split_pm0, ksplit;
    int fused, has_next, gate_off, shift_off, scale_off, x_mode;
    const float* xsrc; float* xdst; bf16_t* Hout; const float* gn_post; const float* gn_next; const float* modL; const float* modN;
    unsigned* slot1; unsigned* slot2; unsigned* cnt1; unsigned* cnt2; int kf; int dry;
    bf16_t* Kd; bf16_t* Vd; const float* qg; const float* kg;
};
#define JI(f) (__builtin_amdgcn_readfirstlane((int)(J->f)))
#define JF32(f) (__int_as_float(__builtin_amdgcn_readfirstlane(__float_as_int(J->f))))
template <class T> __device__ __forceinline__ T* jptr(const LAS void* p) {
    const LAS unsigned* q = (const LAS unsigned*)p; const unsigned lo = (unsigned)__builtin_amdgcn_readfirstlane((int)q[0]), hi = (unsigned)__builtin_amdgcn_readfirstlane((int)q[1]);
    typedef __attribute__((address_space(1))) T GT;
    GT* g = (GT*)(((unsigned long long)hi << 32) | lo); return (T*)g;
}
struct Unit { const char* a; const char* b; int bt, pm, pn, ks, nt; };

#define RFL(x) (UNIFORM ? __builtin_amdgcn_readfirstlane(x) : (x))
template <bool UNIFORM> __device__ __forceinline__ bool unit_next(const LAS GJob* J, int i, int G, int c, Unit& u) {
    const int nMall = JI(nM), nN = JI(nN), split_pm0 = JI(split_pm0), ksplit = JI(ksplit);
    const int nM = split_pm0 < nMall ? split_pm0 : nMall;
    const int per = nM * nN, nreg = per * JI(nB), nsplit = (nMall - nM) * nN * ksplit;
    const long L = (long)i * G + c; if (L >= nreg + nsplit) return false;
    const int lda = JI(lda), ldb = JI(ldb), K = JI(K);
    if (L >= nreg) {
        const int s = (int)L - nreg, ks = RFL(s % ksplit), t = s / ksplit;
        u.pn = RFL(t % nN); u.pm = RFL(nM + t / nN); u.bt = 0; u.ks = ks; u.nt = RFL((K / ksplit) / BK);
        u.a = (const char*)(jptr<const bf16_t>(&J->A) + (long)u.pm * 256 * lda + ks * (K / ksplit));
        u.b = (const char*)(jptr<const bf16_t>(&J->B) + (long)u.pn * 256 * ldb + ks * (K / ksplit));
        return true;
    }
    int wgid = (int)L; { const int nwg = nreg, q = nwg / NXCD, r = nwg % NXCD, xcd = wgid % NXCD, off = wgid / NXCD; wgid = (xcd < r ? xcd * (q + 1) : r * (q + 1) + (xcd - r) * q) + off; }
    const int bt = RFL(wgid / per), w = wgid % per;
    const int nig = WGM * nN, gid = w / nig, fm = gid * WGM, gsz = (nM - fm) < WGM ? (nM - fm) : WGM;
    u.pm = RFL(fm + ((w % nig) % gsz)); u.pn = RFL((w % nig) / gsz); u.bt = bt; u.ks = -1; u.nt = K / BK;
    const bf16_t* Ab = (((unsigned)JI(a2mask) >> u.pn) & 1u) ? jptr<const bf16_t>(&J->A2) : jptr<const bf16_t>(&J->A);
    u.a = (const char*)(Ab + (long)u.pm * 256 * lda);
    { const int kf = JI(kf); if (kf > 0) { const int part = bt & 1; u.a += (size_t)part * kf * 2; u.nt = part ? (K - kf) / BK : kf / BK; } }
    const int bdiv = JI(bdiv);
    const int bhi = RFL(bt / bdiv), blo = RFL(bt % bdiv), pnm = RFL(u.pn % JI(b_pn_mod));
    u.b = (const char*)(jptr<const bf16_t>(&J->B) + (long)bhi * JI(b_bs_hi) + (long)blo * JI(b_bs_lo) + (long)pnm * 256 * ldb);
    return true;
}

#undef RFL
constexpr int UT_MAX = 16, UT_STRIDE = 12;
__device__ __forceinline__ void unit_table_build(LAS unsigned* tab, const LAS GJob* J, int G, int c, int tid) {
    if (tid < UT_MAX) {
        Unit u; u.a = nullptr; u.b = nullptr; u.bt = 0; u.pm = 0; u.pn = 0; u.ks = -1; u.nt = 4;
        const bool ok = unit_next<false>(J, tid, G, c, u);
        LAS unsigned* e = tab + tid * UT_STRIDE;
        const unsigned long long pa = (unsigned long long)u.a, pb = (unsigned long long)u.b;
        e[0] = (unsigned)pa; e[1] = (unsigned)(pa >> 32); e[2] = (unsigned)pb; e[3] = (unsigned)(pb >> 32);
        e[4] = (unsigned)u.bt; e[5] = (unsigned)u.pm; e[6] = (unsigned)u.pn; e[7] = (unsigned)u.ks; e[8] = (unsigned)u.nt; e[9] = ok ? 1u : 0u;
    }
}
__device__ __forceinline__ bool unit_fetch(const LAS unsigned* tab, int i, Unit& u) {
    if (i >= UT_MAX) return false;
    const LAS unsigned* e = tab + i * UT_STRIDE;
    if (__builtin_amdgcn_readfirstlane((int)e[9]) == 0) return false;
    u.a = jptr<const char>(e); u.b = jptr<const char>(e + 2);
    u.bt = __builtin_amdgcn_readfirstlane((int)e[4]); u.pm = __builtin_amdgcn_readfirstlane((int)e[5]); u.pn = __builtin_amdgcn_readfirstlane((int)e[6]);
    u.ks = __builtin_amdgcn_readfirstlane((int)e[7]); u.nt = __builtin_amdgcn_readfirstlane((int)e[8]);
    return true;
}

__device__ __forceinline__ void epilogue(const LAS GJob* J, const f32x4 (&acc)[2][2][4][2], const Unit& u, int wr, int wc, int fr, int fq) {
    asm volatile("" : "+v"(fr), "+v"(fq));
    const int row0 = u.pm * BM + wr * 64 + fr, col0 = u.pn * BM + wc * 32 + 8 * fq;
    float* const stats = jptr<float>(&J->stats); const int stats_pn0 = JI(stats_pn0);
    const bool do_stats = (stats != nullptr) && (u.pn >= stats_pn0);
    const float sc = JF32(scale); const bool has_scale = (sc != 1.0f); const int act = JI(act), out_f32 = JI(out_f32), ldc = JI(ldc); const bool nostore = (REPEAT_MASK != 0ULL) && (JI(dry) == 2);
    char* const Cb = jptr<char>(&J->C) + ((size_t)u.bt * JI(c_bs) << (out_f32 ? 2 : 1));
    if (u.ks >= 0) {
        const int nMall = JI(nM), sp0 = JI(split_pm0);
        float* const part = jptr<float>(&J->part) + (size_t)u.ks * (nMall - sp0) * BM * ldc;
#pragma unroll
        for (int ai = 0; ai < 2; ++ai)
#pragma unroll
            for (int m = 0; m < 4; ++m) {
                const int row = row0 + ai * HALF + m * 16;
#pragma unroll
                for (int bj = 0; bj < 2; ++bj) { float* p = part + (size_t)(row - sp0 * BM) * ldc + col0 + bj * HALF; *(f32x4*)p = acc[ai][bj][m][0]; *(f32x4*)(p + 4) = acc[ai][bj][m][1]; }
            }
        return;
    }
#pragma unroll
    for (int ai = 0; ai < 2; ++ai)
#pragma unroll
        for (int m = 0; m < 4; ++m) {
            const int row = row0 + ai * HALF + m * 16;
            float ssum = 0.f, ssq = 0.f;
#pragma unroll
            for (int bj = 0; bj < 2; ++bj) {
                f32x4 v0 = acc[ai][bj][m][0], v1 = acc[ai][bj][m][1];
                if (has_scale) { v0 = v0 * sc; v1 = v1 * sc; }
                if (act == 1) { v0 = gelu_tanh4(v0); v1 = gelu_tanh4(v1); }
                else if (act == 2) { v0 = relu2_4(v0); v1 = relu2_4(v1); }
                if (do_stats) {
#pragma unroll
                    for (int e = 0; e < 4; ++e) { ssum += v0[e] + v1[e]; ssq += v0[e] * v0[e] + v1[e] * v1[e]; }
                }
                const size_t off = (size_t)row * ldc + col0 + bj * HALF;
                if (out_f32) { float* p = (float*)Cb + off; *(f32x4*)p = v0; *(f32x4*)(p + 4) = v1; }
                else { u32x4 w; w.x = cvt_pk_bf16(v0[0], v0[1]); w.y = cvt_pk_bf16(v0[2], v0[3]); w.z = cvt_pk_bf16(v1[0], v1[1]); w.w = cvt_pk_bf16(v1[2], v1[3]);
                       if (REPEAT_MASK != 0ULL && nostore) { asm volatile("" :: "v"(w.x), "v"(w.y), "v"(w.z), "v"(w.w)); } else
                       if (NT_STORES) __builtin_nontemporal_store(w, (u32x4*)((bf16_t*)Cb + off)); else *(u32x4*)((bf16_t*)Cb + off) = w; }
            }
            if (do_stats) {
                ssum += __shfl_xor(ssum, 16); ssum += __shfl_xor(ssum, 32); ssq += __shfl_xor(ssq, 16); ssq += __shfl_xor(ssq, 32);
                if (fq == 0) { float* s = stats + ((size_t)row * 32 + (u.pn - stats_pn0) * 4 + wc) * 2; s[0] = ssum; s[1] = ssq; }
            }
        }
}

__device__ __forceinline__ void row_exchange(LAS unsigned char* lds, const float (&q)[2][4], unsigned* slot, unsigned* cnt, const Unit& u, int wr, int wc, int fr, int fq, int wid, int lane) {
    LAS float* P = (LAS float*)(lds + 131072 + 1024); LAS float* S = (LAS float*)(lds + 131072 + 5120);
#pragma unroll
    for (int ai = 0; ai < 2; ++ai)
#pragma unroll
        for (int m = 0; m < 4; ++m) { float t = q[ai][m]; t += __shfl_xor(t, 16); t += __shfl_xor(t, 32); if (fq == 0) P[(ai * HALF + wr * 64 + m * 16 + fr) * 4 + wc] = t; }
    asm volatile("s_waitcnt lgkmcnt(0)" ::: "memory"); __builtin_amdgcn_s_barrier(); asm volatile("" ::: "memory");
    const int row = wid * 32 + (lane & 31);
    unsigned* myslot = slot + ((size_t)(u.pm * BM + row) * 4);
    if (lane < 32) { const float t = (P[row * 4 + 0] + P[row * 4 + 1]) + (P[row * 4 + 2] + P[row * 4 + 3]);
        __hip_atomic_store(myslot + u.pn, __float_as_uint(t), __ATOMIC_RELAXED, __HIP_MEMORY_SCOPE_AGENT); }
    asm volatile("s_waitcnt vmcnt(0)" ::: "memory");
    if (lane == 0) __hip_atomic_fetch_add(cnt + 64 * u.pm, 1u, __ATOMIC_RELAXED, __HIP_MEMORY_SCOPE_AGENT);
    if (wid == 0) {
        for (int spin = 0; spin < (1 << 20); ++spin) {
            if ((unsigned)__builtin_amdgcn_readfirstlane((int)__hip_atomic_load(cnt + 64 * u.pm, __ATOMIC_RELAXED, __HIP_MEMORY_SCOPE_AGENT)) >= 32u) break;
            __builtin_amdgcn_s_sleep(2);
        }
        __builtin_amdgcn_fence(__ATOMIC_ACQUIRE, "agent");
    }
    asm volatile("s_waitcnt vmcnt(0) lgkmcnt(0)" ::: "memory"); __builtin_amdgcn_s_barrier(); asm volatile("" ::: "memory");
    if (lane < 32) { float t = 0.f;
#pragma unroll
        for (int k = 0; k < 4; ++k) t += __uint_as_float(__hip_atomic_load(myslot + k, __ATOMIC_RELAXED, __HIP_MEMORY_SCOPE_AGENT));
        S[row] = rsqrtf(t * (1.0f / 1024.0f) + 1e-6f); }
    asm volatile("s_waitcnt lgkmcnt(0)" ::: "memory"); __builtin_amdgcn_s_barrier(); asm volatile("" ::: "memory");
}
__device__ __forceinline__ void epilogue_fused(const LAS GJob* J, f32x4 (&acc)[2][2][4][2], const Unit& u, LAS unsigned char* lds, int wr, int wc, int fr, int fq, int wid, int lane) {
    const int row0 = u.pm * BM + wr * 64 + fr, col0 = u.pn * BM + wc * 32 + 8 * fq;
    const int bidx = (u.pm * BM) >> 12;
    const LAS float* S = (const LAS float*)(lds + 131072 + 5120);
    const unsigned lo4 = (unsigned)(row0 * DM + col0) * 4u, lo2 = (unsigned)(row0 * DM + col0) * 2u;
#define XOFF(ai, m, bj, n) ((unsigned)((((ai) * HALF + (m) * 16) * DM + (bj) * HALF + 4 * (n)) * 4))
    float q[2][4];
#pragma unroll
    for (int ai = 0; ai < 2; ++ai)
#pragma unroll
        for (int m = 0; m < 4; ++m) { float t = 0.f;
#pragma unroll
            for (int bj = 0; bj < 2; ++bj)
#pragma unroll
                for (int n = 0; n < 2; ++n) { const f32x4 y = acc[ai][bj][m][n]; t += (y[0] * y[0] + y[1] * y[1]) + (y[2] * y[2] + y[3] * y[3]); }
            q[ai][m] = t; }
    const char* xs = (const char*)jptr<const float>(&J->xsrc);
    const bool dst32 = (JI(x_mode) & 2) != 0;
    u32x4 xq[2][4];
#define XLOADH(bj) do { _Pragma("unroll") for (int ai = 0; ai < 2; ++ai) _Pragma("unroll") for (int m = 0; m < 4; ++m) xq[ai][m] = *(const u32x4*)(xs + XOFF(ai, m, bj, 0) / 2 + lo2); } while (0)
    XLOADH(0);
    row_exchange(lds, q, jptr<unsigned>(&J->slot1), jptr<unsigned>(&J->cnt1), u, wr, wc, fr, fq, wid, lane);
    {
        const float* gate = jptr<const float>(&J->modL) + bidx * 6144 + JI(gate_off) + col0; const float* gnp = jptr<const float>(&J->gn_post) + col0;
        char* xd = (char*)jptr<float>(&J->xdst);
#pragma unroll
        for (int ai = 0; ai < 2; ++ai)
#pragma unroll
            for (int m = 0; m < 4; ++m) q[ai][m] = 0.f;
#pragma unroll
        for (int bj = 0; bj < 2; ++bj) {
            const f32x4 gt0 = *(const f32x4*)(gate + bj * HALF), gt1 = *(const f32x4*)(gate + bj * HALF + 4), gp0 = *(const f32x4*)(gnp + bj * HALF), gp1 = *(const f32x4*)(gnp + bj * HALF + 4);
#pragma unroll
            for (int ai = 0; ai < 2; ++ai)
#pragma unroll
                for (int m = 0; m < 4; ++m) {
                    const float rs = S[ai * HALF + wr * 64 + m * 16 + fr]; const u32x4 w = xq[ai][m];
                    const f32x4 x0 = (f32x4){bflo(w.x), bfhi(w.x), bflo(w.y), bfhi(w.y)}, x1 = (f32x4){bflo(w.z), bfhi(w.z), bflo(w.w), bfhi(w.w)};
                    const f32x4 xn0 = x0 + gt0 * ((acc[ai][bj][m][0] * rs) * gp0), xn1 = x1 + gt1 * ((acc[ai][bj][m][1] * rs) * gp1);
                    acc[ai][bj][m][0] = xn0; acc[ai][bj][m][1] = xn1;
                    q[ai][m] += ((xn0[0] * xn0[0] + xn0[1] * xn0[1]) + (xn0[2] * xn0[2] + xn0[3] * xn0[3])) + ((xn1[0] * xn1[0] + xn1[1] * xn1[1]) + (xn1[2] * xn1[2] + xn1[3] * xn1[3])); }
            asm volatile("" ::: "memory");
            if (bj == 0) XLOADH(1);
            if (dst32) {
#pragma unroll
                for (int ai = 0; ai < 2; ++ai)
#pragma unroll
                    for (int m = 0; m < 4; ++m) { *(f32x4*)(xd + XOFF(ai, m, bj, 0) + lo4) = acc[ai][bj][m][0]; *(f32x4*)(xd + XOFF(ai, m, bj, 1) + lo4) = acc[ai][bj][m][1]; }
            } else {
#pragma unroll
                for (int ai = 0; ai < 2; ++ai)
#pragma unroll
                    for (int m = 0; m < 4; ++m) { const f32x4 a0 = acc[ai][bj][m][0], a1 = acc[ai][bj][m][1];
                        u32x4 w; w.x = cvt_pk_bf16(a0[0], a0[1]); w.y = cvt_pk_bf16(a0[2], a0[3]); w.z = cvt_pk_bf16(a1[0], a1[1]); w.w = cvt_pk_bf16(a1[2], a1[3]);
                        *(u32x4*)(xd + XOFF(ai, m, bj, 0) / 2 + lo2) = w; }
            }
        }
    }
#undef XLOADH
    if (!JI(has_next)) return;
    row_exchange(lds, q, jptr<unsigned>(&J->slot2), jptr<unsigned>(&J->cnt2), u, wr, wc, fr, fq, wid, lane);
    {
        const float* modN = jptr<const float>(&J->modN) + bidx * 6144 + col0; const float* shp = modN + JI(shift_off); const float* scp = modN + JI(scale_off); const float* gnn = jptr<const float>(&J->gn_next) + col0;
        char* H = (char*)jptr<bf16_t>(&J->Hout);
#pragma unroll
        for (int bj = 0; bj < 2; ++bj) {
            const f32x4 gn0 = *(const f32x4*)(gnn + bj * HALF), gn1 = *(const f32x4*)(gnn + bj * HALF + 4), sh0 = *(const f32x4*)(shp + bj * HALF), sh1 = *(const f32x4*)(shp + bj * HALF + 4);
            const f32x4 sc0 = *(const f32x4*)(scp + bj * HALF) + 1.0f, sc1 = *(const f32x4*)(scp + bj * HALF + 4) + 1.0f;
#pragma unroll
            for (int ai = 0; ai < 2; ++ai)
#pragma unroll
                for (int m = 0; m < 4; ++m) {
                    const float rs = S[ai * HALF + wr * 64 + m * 16 + fr];
                    const f32x4 h0 = ((acc[ai][bj][m][0] * rs) * gn0) * sc0 + sh0, h1 = ((acc[ai][bj][m][1] * rs) * gn1) * sc1 + sh1;
                    u32x4 w; w.x = cvt_pk_bf16(h0[0], h0[1]); w.y = cvt_pk_bf16(h0[2], h0[3]); w.z = cvt_pk_bf16(h1[0], h1[1]); w.w = cvt_pk_bf16(h1[2], h1[3]);
                    *(u32x4*)(H + XOFF(ai, m, bj, 0) / 2 + lo2) = w; }
        }
    }
#undef XOFF
}

__device__ __forceinline__ void epilogue_qkv(const LAS GJob* J, const f32x4 (&acc)[2][2][4][2], const Unit& u, LAS unsigned char* lds, int wr, int wc, int fr, int fq) {
    asm volatile("" : "+v"(fr), "+v"(fq));
    LAS float* P = (LAS float*)(lds + 131072 + 1024);
    const bool is_v = (u.pn == 5), is_k = (u.pn == 4);
    if (!is_v) {
#pragma unroll
        for (int ai = 0; ai < 2; ++ai)
#pragma unroll
            for (int m = 0; m < 4; ++m)
#pragma unroll
                for (int bj = 0; bj < 2; ++bj) { const f32x4 a = acc[ai][bj][m][0], b = acc[ai][bj][m][1];
                    float t = ((a[0] * a[0] + a[1] * a[1]) + (a[2] * a[2] + a[3] * a[3])) + ((b[0] * b[0] + b[1] * b[1]) + (b[2] * b[2] + b[3] * b[3]));
                    t += __shfl_xor(t, 16); t += __shfl_xor(t, 32);
                    if (fq == 0) P[((ai * HALF + wr * 64 + m * 16 + fr) * 2 + bj) * 4 + wc] = t; }
    }
    asm volatile("s_waitcnt lgkmcnt(0)" ::: "memory"); __builtin_amdgcn_s_barrier(); asm volatile("" ::: "memory");
    const int d0 = 16 * wc + 4 * fq;
    bf16_t* const Qd = jptr<bf16_t>(&J->C); bf16_t* const Kd = jptr<bf16_t>(&J->Kd); bf16_t* const Vd = jptr<bf16_t>(&J->Vd);
    const float* g = is_k ? jptr<const float>(&J->kg) : jptr<const float>(&J->qg);
    f32x4 g1 = (f32x4){1.f, 1.f, 1.f, 1.f}, g2 = g1; float inv[4] = {0.f, 0.f, 0.f, 0.f};
    if (!is_v) { g1 = *(const f32x4*)(g + d0); g2 = *(const f32x4*)(g + 64 + d0);
#pragma unroll
        for (int e = 0; e < 4; ++e) inv[e] = exp2f(-(float)((d0 + e) & 31) * (13.287712379549449f / 32.0f)); }
#pragma unroll
    for (int ai = 0; ai < 2; ++ai)
#pragma unroll
        for (int m = 0; m < 4; ++m) {
            const int trow = ai * HALF + wr * 64 + m * 16 + fr, row = u.pm * BM + trow;
            const bool lat = row < RL; const int b = lat ? (row >> 12) : ((row - RL) >> 8), t = lat ? (row & 4095) : ((row - RL) & 255), pos = lat ? (CTXL + t) : t;
            const size_t kvoff = ((size_t)b * SKV + pos) * 256;
            if (is_v) {
#pragma unroll
                for (int bj = 0; bj < 2; ++bj) { const f32x4 a = acc[ai][bj][m][0], c = acc[ai][bj][m][1];
                    u32x4 w; w.x = cvt_pk_bf16(a[0], a[1]); w.y = cvt_pk_bf16(a[2], a[3]); w.z = cvt_pk_bf16(c[0], c[1]); w.w = cvt_pk_bf16(c[2], c[3]);
                    *(u32x4*)(Vd + kvoff + bj * HALF + 32 * wc + 8 * fq) = w; }
            } else {
                f32x4 cs = (f32x4){1.f, 1.f, 1.f, 1.f}, sn = (f32x4){0.f, 0.f, 0.f, 0.f};
                if (lat) { const float p = (d0 < 32) ? (float)(t >> 6) : (float)(t & 63);
#pragma unroll
                    for (int e = 0; e < 4; ++e) { float rev = (p * inv[e]) * 0.15915494309189535f; rev -= floorf(rev); sn[e] = __builtin_amdgcn_sinf(rev); cs[e] = __builtin_amdgcn_cosf(rev); } }
#pragma unroll
                for (int bj = 0; bj < 2; ++bj) {
                    const f32x4 pr = *(const LAS f32x4*)(P + (trow * 2 + bj) * 4);
                    const float rs = rsqrtf(((pr[0] + pr[1]) + (pr[2] + pr[3])) * (1.0f / 128.0f) + NORM_EPS);
                    const f32x4 y1 = (acc[ai][bj][m][0] * rs) * g1, y2 = (acc[ai][bj][m][1] * rs) * g2;
                    const f32x4 o1 = y1 * cs - y2 * sn, o2 = y1 * sn + y2 * cs;
                    u32x2 w1, w2; w1.x = cvt_pk_bf16(o1[0], o1[1]); w1.y = cvt_pk_bf16(o1[2], o1[3]); w2.x = cvt_pk_bf16(o2[0], o2[1]); w2.y = cvt_pk_bf16(o2[2], o2[3]);
                    if (is_k) { bf16_t* d = Kd + kvoff + bj * HALF + d0; *(u32x2*)d = w1; *(u32x2*)(d + 64) = w2; }
                    else if (lat) { bf16_t* d = Qd + (size_t)row * 1024 + (2 * u.pn + bj) * HALF + d0; *(u32x2*)d = w1; *(u32x2*)(d + 64) = w2; }
                }
            }
        }
}

__device__ __forceinline__ void gemm_phase(LAS unsigned char* lds, const LAS GJob* J, int G, int cidx, const int tid) {
    const int wid = __builtin_amdgcn_readfirstlane(tid >> 6), lane = tid & 63, wr = wid >> 2, wc = wid & 3, fr = lane & 15, fq = lane >> 4;
    const int lda = JI(lda), ldb = JI(ldb);
    unsigned voffA[2], voffB[2];
#pragma unroll
    for (int i = 0; i < 2; ++i) { int R, C; stage_rc(tid * 16 + i * 8192, R, C); const int Rb = (R & ~31) + perm32(R & 31);
        voffA[i] = (unsigned)(R * lda + C) * 2u; voffB[i] = (unsigned)(Rb * ldb + C) * 2u; }
    const size_t kstep = (size_t)(BK * 2);
    const size_t hsA = (size_t)HALF * lda * 2, hsB = (size_t)HALF * ldb * 2;
    const unsigned ldsw = (unsigned)wid * 1024u;
    const int aoff = lds_byte(wr * 64 + fr, fq * 8), boff = lds_byte(wc * 32 + fr, fq * 8);
#define PG8_SA(b, h) (((b) * 2 + (h)) * HTB)
#define PG8_SB(b, h) ((4 + (b) * 2 + (h)) * HTB)
#define PG8_STAGE(bufoff, gbase, voff) do { _Pragma("unroll") for (int _i = 0; _i < 2; ++_i) \
        __builtin_amdgcn_global_load_lds((const unsigned*)((const char*)(gbase) + (voff)[_i]), (LAS unsigned*)(lds + (bufoff) + ldsw + _i * 8192), 16, 0, 0); } while (0)
#define PG8_LDA(dst, b, h) do { _Pragma("unroll") for (int m = 0; m < 4; ++m) _Pragma("unroll") for (int k = 0; k < 2; ++k) dst[m][k] = *(const LAS bf16x8*)(lds + PG8_SA(b, h) + aoff + m * 2048 + k * 1024); } while (0)
#define PG8_LDB(dst, b, h) do { _Pragma("unroll") for (int n = 0; n < 2; ++n) _Pragma("unroll") for (int k = 0; k < 2; ++k) dst[n][k] = *(const LAS bf16x8*)(lds + PG8_SB(b, h) + boff + n * 2048 + k * 1024); } while (0)
#define PG8_MMA(ai, bj, At, Bt) do { __builtin_amdgcn_s_setprio(1); _Pragma("unroll") for (int m = 0; m < 4; ++m) _Pragma("unroll") for (int n = 0; n < 2; ++n) _Pragma("unroll") for (int k = 0; k < 2; ++k) \
        acc[ai][bj][m][n] = __builtin_amdgcn_mfma_f32_16x16x32_bf16(Bt[n][k], At[m][k], acc[ai][bj][m][n], 0, 0, 0); __builtin_amdgcn_s_setprio(0); } while (0)
#define PG8_WAIT_V(n) asm volatile("s_waitcnt vmcnt(" #n ")" ::: "memory")
#define PG8_WAIT_L(n) asm volatile("s_waitcnt lgkmcnt(" #n ")" ::: "memory")
#define PG8_BAR __builtin_amdgcn_s_barrier()
#define PG8_SCHED __builtin_amdgcn_sched_barrier(0)
    Unit cur, nxt; int ui = 0;
    LAS unsigned* const utab = (LAS unsigned*)(lds + 131072 + 9216);
    unit_table_build(utab, J, G, cidx, tid);
    asm volatile("s_waitcnt lgkmcnt(0)" ::: "memory"); __builtin_amdgcn_s_barrier(); asm volatile("" ::: "memory");
    if (!unit_fetch(utab, 0, cur)) return;
    f32x4 acc[2][2][4][2];
#pragma unroll
    for (int a = 0; a < 2; ++a)
#pragma unroll
        for (int b = 0; b < 2; ++b)
#pragma unroll
            for (int m = 0; m < 4; ++m)
#pragma unroll
                for (int n = 0; n < 2; ++n) acc[a][b][m][n] = (f32x4){0.f, 0.f, 0.f, 0.f};
    bf16x8 At[4][2], B0[2][2], B1[2][2];
    const char* cA = cur.a; const char* cB = cur.b;
    PG8_STAGE(PG8_SB(0, 0), cB, voffB); PG8_STAGE(PG8_SB(0, 1), cB + hsB, voffB); PG8_STAGE(PG8_SA(0, 0), cA, voffA); PG8_STAGE(PG8_SA(0, 1), cA + hsA, voffA);
    if (wr == 1) PG8_BAR;
    PG8_WAIT_V(2); PG8_BAR;
    PG8_STAGE(PG8_SB(1, 0), cB + kstep, voffB); PG8_STAGE(PG8_SA(1, 0), cA + kstep, voffA); PG8_STAGE(PG8_SB(1, 1), cB + hsB + kstep, voffB);
    PG8_WAIT_V(6); PG8_BAR;
    for (;;) {
        const bool has_next = unit_fetch(utab, ui + 1, nxt);
        const char* nA = has_next ? nxt.a : cA; const char* nB = has_next ? nxt.b : cB;
        const int nt = cur.nt;
        for (int t = 0; t < nt; t += 2) {
            const bool last = (t == nt - 2);
            const char* a1 = cA + (size_t)(t + 1) * kstep;
            const char* a2 = last ? nA : cA + (size_t)(t + 2) * kstep; const char* b2 = last ? nB : cB + (size_t)(t + 2) * kstep;
            const char* a3 = a2 + kstep; const char* b3 = b2 + kstep;
            PG8_LDB(B0, 0, 0); PG8_LDB(B1, 0, 1); PG8_SCHED; PG8_LDA(At, 0, 0); PG8_STAGE(PG8_SA(1, 1), a1 + hsA, voffA);
            PG8_WAIT_V(8); PG8_WAIT_L(0); PG8_BAR; PG8_MMA(0, 0, At, B0); PG8_MMA(0, 1, At, B1); PG8_BAR; PG8_SCHED;
            PG8_LDA(At, 0, 1); PG8_STAGE(PG8_SB(0, 0), b2, voffB); PG8_STAGE(PG8_SB(0, 1), b2 + hsB, voffB); PG8_STAGE(PG8_SA(0, 0), a2, voffA);
            PG8_WAIT_V(8); PG8_WAIT_L(0); PG8_BAR; PG8_MMA(1, 0, At, B0); PG8_MMA(1, 1, At, B1); PG8_BAR; PG8_SCHED;
            PG8_LDB(B0, 1, 0); PG8_LDB(B1, 1, 1); PG8_SCHED; PG8_LDA(At, 1, 0); PG8_STAGE(PG8_SA(0, 1), a2 + hsA, voffA);
            PG8_WAIT_V(8); PG8_WAIT_L(0); PG8_BAR; PG8_MMA(0, 0, At, B0); PG8_MMA(0, 1, At, B1); PG8_BAR; PG8_SCHED;
            PG8_LDA(At, 1, 1); PG8_STAGE(PG8_SB(1, 0), b3, voffB); PG8_STAGE(PG8_SB(1, 1), b3 + hsB, voffB); PG8_STAGE(PG8_SA(1, 0), a3, voffA);
            PG8_WAIT_V(8); PG8_WAIT_L(0); PG8_BAR; PG8_MMA(1, 0, At, B0); PG8_MMA(1, 1, At, B1); PG8_BAR; PG8_SCHED;
        }
        if (wr == 0) PG8_BAR;
        if (REPEAT_MASK != 0ULL && JI(dry) == 1) {   } else
#ifndef NO_FUSED
#ifndef NO_FUSEDEPI
        if (JI(fused) && cur.ks < 0) epilogue_fused(J, acc, cur, lds, wr, wc, fr, fq, wid, lane);
        else
#endif
        if (false) {}
        else
#endif
        epilogue(J, acc, cur, wr, wc, fr, fq);
        if (!has_next) break;
#pragma unroll
        for (int a = 0; a < 2; ++a)
#pragma unroll
            for (int b = 0; b < 2; ++b)
#pragma unroll
                for (int m = 0; m < 4; ++m)
#pragma unroll
                    for (int n = 0; n < 2; ++n) acc[a][b][m][n] = (f32x4){0.f, 0.f, 0.f, 0.f};
        cur = nxt; cA = nA; cB = nB; ++ui;
        if (wr == 1) PG8_BAR;
    }
    PG8_WAIT_V(0);
    PG8_BAR;
#undef PG8_SA
#undef PG8_SB
#undef PG8_STAGE
#undef PG8_LDA
#undef PG8_LDB
#undef PG8_MMA
#undef PG8_WAIT_V
#undef PG8_WAIT_L
#undef PG8_BAR
#undef PG8_SCHED
}
}
using pg8::GJob;

namespace att {
constexpr int D = 128, NW = 8, QBLK = 32, KVBLK = 64;
constexpr float SCALE = 0.088388347648318440f;
constexpr float THR = 8.f;
constexpr int LDQ = 1024, LDK = 256, LDO = 1024;
constexpr size_t SHM_V = KVBLK * D * 2, SHM_K = KVBLK * D * 2, SHM_ATTN = 2 * SHM_V + 2 * SHM_K + NW * 64 * 4;
#define KSWZ(row, colB) ((row) * 256 + ((colB) ^ (((row) & 7) << 4)))
#define SBAR() __builtin_amdgcn_sched_barrier(0)
__device__ __forceinline__ int crow(int r, int hi) { return (r & 3) + 8 * (r >> 2) + 4 * hi; }
__device__ __forceinline__ void partialSM(f32x16& p0, f32x16& p1, float& m_reg, float& mn, float& alpha) {
  constexpr float C = SCALE * 1.4426950408889634f;
  float pmax = p0[0]; for (int r = 1; r < 16; ++r) pmax = fmaxf(pmax, p0[r]); for (int r = 0; r < 16; ++r) pmax = fmaxf(pmax, p1[r]);
  { auto rr = __builtin_amdgcn_permlane32_swap(__float_as_uint(pmax), __float_as_uint(pmax), false, false);
    pmax = fmaxf(__uint_as_float(rr[0]), __uint_as_float(rr[1])); }
  if (__builtin_expect(__all(pmax - m_reg <= THR / SCALE), 1)) { mn = m_reg; alpha = 1.f; }
  else { mn = fmaxf(m_reg, pmax); alpha = __builtin_amdgcn_exp2f((m_reg - mn) * C); m_reg = mn; }
  float mnC = -mn * C;
  for (int r = 0; r < 16; ++r) p0[r] = fmaf(p0[r], C, mnC); for (int r = 0; r < 16; ++r) p1[r] = fmaf(p1[r], C, mnC);
  for (int r = 0; r < 16; ++r) p0[r] = __builtin_amdgcn_exp2f(p0[r]);
}
__device__ __forceinline__ void finishSM(f32x16& p0, f32x16& p1, float alpha, float& l_reg, bf16x8& pa0, bf16x8& pa1, bf16x8& pa2, bf16x8& pa3) {
  for (int r = 0; r < 16; ++r) p1[r] = __builtin_amdgcn_exp2f(p1[r]);
  float ps = 0; for (int r = 0; r < 16; ++r) ps += p0[r]; for (int r = 0; r < 16; ++r) ps += p1[r];
  { auto rr = __builtin_amdgcn_permlane32_swap(__float_as_uint(ps), __float_as_uint(ps), false, false);
    ps = __uint_as_float(rr[0]) + __uint_as_float(rr[1]); }
  l_reg = l_reg * alpha + ps;
#define PK4(P, BASE, OUT) do { unsigned a0 = cvt_pk_bf16(P[BASE + 0], P[BASE + 1]), a1 = cvt_pk_bf16(P[BASE + 2], P[BASE + 3]);   \
    unsigned b0 = cvt_pk_bf16(P[BASE + 4], P[BASE + 5]), b1 = cvt_pk_bf16(P[BASE + 6], P[BASE + 7]);                              \
    auto r0 = __builtin_amdgcn_permlane32_swap(a0, b0, false, false); auto r1 = __builtin_amdgcn_permlane32_swap(a1, b1, false, false); \
    u32x4 w = {r0[0], r1[0], r0[1], r1[1]}; OUT = *reinterpret_cast<bf16x8*>(&w); } while (0)
  PK4(p0, 0, pa0); PK4(p0, 8, pa1); PK4(p1, 0, pa2); PK4(p1, 8, pa3);
#undef PK4
}
__device__ __forceinline__ void qkt(f32x16& p0, f32x16& p1, const bf16_t* Ks, const bf16x8* qr, int r32, int hi) {
  p0 = f32x16{}; p1 = f32x16{};
  for (int d0 = 0; d0 < 8; ++d0) { int cb = (d0 * 16 + hi * 8) * 2;
    bf16x8 b0 = *reinterpret_cast<const bf16x8*>((const char*)Ks + KSWZ(r32, cb));
    bf16x8 b1 = *reinterpret_cast<const bf16x8*>((const char*)Ks + KSWZ(32 + r32, cb));
    p0 = __builtin_amdgcn_mfma_f32_32x32x16_bf16(b0, qr[d0], p0, 0, 0, 0);
    p1 = __builtin_amdgcn_mfma_f32_32x32x16_bf16(b1, qr[d0], p1, 0, 0, 0); }
}
__device__ __forceinline__ int v_st(int k, int c) { const int kk = (k & ~0xC) | ((k & 4) << 1) | ((k & 8) >> 1); return ((kk >> 3) * 4 + (c >> 5)) * 512 + ((kk & 7) * 32 + (c & 31)) * 2; }
__device__ __forceinline__ int v_rd_base(int lane) { return ((lane & 3) << 3) | (((lane >> 2) & 3) << 6) | (((lane >> 4) & 1) << 5) | (((lane >> 5) & 1) << 8); }
constexpr int v_rd_off(int d0, int ks, int half) { return d0 * 512 + ks * 4096 + half * 2048; }
template <int OFF> __device__ __forceinline__ s16x4 tr_read(int vb) {
  s16x4 r; asm volatile("ds_read_b64_tr_b16 %0, %1 offset:%2" : "=&v"(r) : "v"(vb), "i"(OFF) : "memory"); return r;
}
template <int D0> __device__ __forceinline__ void pv_one(f32x16& od, int vb, bf16x8 pa0, bf16x8 pa1, bf16x8 pa2, bf16x8 pa3) {
  const s16x4 l0 = tr_read<v_rd_off(D0, 0, 0)>(vb), h0 = tr_read<v_rd_off(D0, 0, 1)>(vb), l1 = tr_read<v_rd_off(D0, 1, 0)>(vb), h1 = tr_read<v_rd_off(D0, 1, 1)>(vb);
  const s16x4 l2 = tr_read<v_rd_off(D0, 2, 0)>(vb), h2 = tr_read<v_rd_off(D0, 2, 1)>(vb), l3 = tr_read<v_rd_off(D0, 3, 0)>(vb), h3 = tr_read<v_rd_off(D0, 3, 1)>(vb);
  asm volatile("s_waitcnt lgkmcnt(0)" ::: "memory"); SBAR();
#define PK(L, H) (bf16x8){L[0], L[1], L[2], L[3], H[0], H[1], H[2], H[3]}
  od = __builtin_amdgcn_mfma_f32_32x32x16_bf16(pa0, PK(l0, h0), od, 0, 0, 0);
  od = __builtin_amdgcn_mfma_f32_32x32x16_bf16(pa1, PK(l1, h1), od, 0, 0, 0);
  od = __builtin_amdgcn_mfma_f32_32x32x16_bf16(pa2, PK(l2, h2), od, 0, 0, 0);
  od = __builtin_amdgcn_mfma_f32_32x32x16_bf16(pa3, PK(l3, h3), od, 0, 0, 0);
#undef PK
}
__device__ __forceinline__ void pv_d0(f32x16* o, int vb, bf16x8 pa0, bf16x8 pa1, bf16x8 pa2, bf16x8 pa3) {
  pv_one<0>(o[0], vb, pa0, pa1, pa2, pa3); pv_one<1>(o[1], vb, pa0, pa1, pa2, pa3); pv_one<2>(o[2], vb, pa0, pa1, pa2, pa3); pv_one<3>(o[3], vb, pa0, pa1, pa2, pa3);
}
__device__ __forceinline__ void attn_dense_body(const bf16_t* __restrict__ Qb, const bf16_t* __restrict__ Kh, const bf16_t* __restrict__ Vh,
                                                bf16_t* __restrict__ Ob, int seq, char* lds, const int tid) {
  constexpr int SDEPTH = 2;
  const int wid = tid >> 6, lane = tid & 63, r32 = lane & 31, hi = lane >> 5;
  bf16_t* V_lds = (bf16_t*)lds; bf16_t* K_lds = (bf16_t*)(lds + 2 * SHM_V);
  float* ws = (float*)(lds + 2 * SHM_V + 2 * SHM_K) + wid * 64; float* li_l = ws; float* al_l = ws + 32;
  float m_reg = -1e30f, l_reg = 0; f32x16 o[4] = {}; bf16x8 qr[8];
  const bf16_t* Qw = Qb + (long)(wid * QBLK + r32) * LDQ + hi * 8;
#pragma unroll
  for (int d0 = 0; d0 < 8; ++d0) qr[d0] = *reinterpret_cast<const bf16x8*>(Qw + d0 * 16);
  const int sr = tid >> 4, sc = (tid & 15) * 8, vst0 = v_st(sr, sc), vst1 = v_st(32 + sr, sc);
  const int vb0 = (int)(uintptr_t)V_lds + v_rd_base(lane);
  struct { bf16x8 vs0, vs1, ks0, ks1; } sr_[SDEPTH];
#define LD8(p) (*reinterpret_cast<const bf16x8*>(p))
  const unsigned kvoff = (unsigned)((sr * LDK + sc) * 2);
#define SLOAD(i, k0) do { const char* vb_ = (const char*)Vh + (size_t)(k0) * (LDK * 2); const char* kb_ = (const char*)Kh + (size_t)(k0) * (LDK * 2); \
    sr_[i].vs0 = LD8(vb_ + kvoff); sr_[i].vs1 = LD8(vb_ + 32 * LDK * 2 + kvoff); \
    sr_[i].ks0 = LD8(kb_ + kvoff); sr_[i].ks1 = LD8(kb_ + 32 * LDK * 2 + kvoff); } while (0)
#define SWRITE(b, i) do { *(bf16x8*)((char*)V_lds + (b) * SHM_V + vst0) = sr_[i].vs0;          \
    *(bf16x8*)((char*)V_lds + (b) * SHM_V + vst1) = sr_[i].vs1; int kc = sc * 2;               \
    *(bf16x8*)((char*)K_lds + (b) * SHM_K + KSWZ(sr, kc)) = sr_[i].ks0;                       \
    *(bf16x8*)((char*)K_lds + (b) * SHM_K + KSWZ(32 + sr, kc)) = sr_[i].ks1; } while (0)
#define SWAIT() do { if constexpr (SDEPTH == 2) asm volatile("s_waitcnt vmcnt(4)" ::: "memory"); else asm volatile("s_waitcnt vmcnt(0)" ::: "memory"); } while (0)
#define RESC(a) do { if (__any((a) < 1.f)) { if (hi == 0) al_l[r32] = (a); asm volatile("s_waitcnt lgkmcnt(0)" ::: "memory"); \
    for (int d = 0; d < 4; ++d) for (int r = 0; r < 16; ++r) o[d][r] *= al_l[crow(r, hi)]; } } while (0)
  f32x16 pA0, pA1, pB0, pB1; float mnA, mnB, alA, alB; bf16x8 pa0, pa1, pa2, pa3; const int NT = seq / KVBLK;
  constexpr int SE = 0, SO = SDEPTH - 1;
  SLOAD(SE, 0); asm volatile("s_waitcnt vmcnt(0)" ::: "memory"); SWRITE(0, SE); __syncthreads();
  qkt(pA0, pA1, K_lds, qr, r32, hi); partialSM(pA0, pA1, m_reg, mnA, alA);
  SLOAD(SO, KVBLK); if constexpr (SDEPTH == 2) { if (2 < NT) SLOAD(SE, 2 * KVBLK); }
  SWAIT(); SWRITE(1, SO); __syncthreads();
  for (int j = 1; j + 1 < NT; j += 2) {
    SBAR(); qkt(pB0, pB1, (bf16_t*)((char*)K_lds + SHM_K), qr, r32, hi);
    finishSM(pA0, pA1, alA, l_reg, pa0, pa1, pa2, pa3); SBAR();
    SLOAD(SO, (j + SDEPTH) * KVBLK); SBAR();
    pv_d0(o, vb0, pa0, pa1, pa2, pa3); partialSM(pB0, pB1, m_reg, mnB, alB);
    __syncthreads(); SWAIT(); SWRITE(0, SE);
    RESC(alB); __syncthreads();
    SBAR(); qkt(pA0, pA1, K_lds, qr, r32, hi);
    finishSM(pB0, pB1, alB, l_reg, pa0, pa1, pa2, pa3); SBAR();
    if (SDEPTH == 1 || j + 3 < NT) SLOAD(SE, (j + 1 + SDEPTH) * KVBLK); SBAR();
    pv_d0(o, vb0 + (int)SHM_V, pa0, pa1, pa2, pa3); partialSM(pA0, pA1, m_reg, mnA, alA);
    __syncthreads(); SWAIT(); SWRITE(1, SO);
    RESC(alA); __syncthreads();
  }
  SBAR(); qkt(pB0, pB1, (bf16_t*)((char*)K_lds + SHM_K), qr, r32, hi);
  finishSM(pA0, pA1, alA, l_reg, pa0, pa1, pa2, pa3); SBAR();
  pv_d0(o, vb0, pa0, pa1, pa2, pa3); partialSM(pB0, pB1, m_reg, mnB, alB);
  __syncthreads(); RESC(alB);
  finishSM(pB0, pB1, alB, l_reg, pa0, pa1, pa2, pa3); SBAR();
  pv_d0(o, vb0 + (int)SHM_V, pa0, pa1, pa2, pa3);
  if (hi == 0) li_l[r32] = l_reg; asm volatile("s_waitcnt lgkmcnt(0)" ::: "memory");
  float rli[16];
#pragma unroll
  for (int r = 0; r < 16; ++r) rli[r] = __builtin_amdgcn_rcpf(li_l[crow(r, hi)]);
  bf16_t* Ow = Ob + (long)(wid * QBLK) * LDO;
#pragma unroll
  for (int r = 0; r < 16; ++r) { int orow = crow(r, hi);
#pragma unroll
    for (int d0 = 0; d0 < 4; ++d0) Ow[(long)orow * LDO + d0 * 32 + r32] = f2bf(o[d0][r] * rli[r]); }
#undef LD8
#undef SLOAD
#undef SWRITE
#undef SWAIT
#undef RESC
}
}

struct RowJob {
    int row0, nrows, has_y, has_next, ldy;
    const bf16_t* Y; const float* gn_post; const float* modL; int gate_off;
    const float* xsrc_lat; const float* xsrc_ctx; float* xdst_lat; float* xdst_ctx;
    const float* gn_next; const float* modN; int shift_off, scale_off; bf16_t* H;
    const float* ypart;
    bf16_t* x16;
};
constexpr int RPW = 2;
__device__ __forceinline__ void wave_sumR(float (&v)[RPW]) {
#pragma unroll
    for (int o = 1; o < 64; o <<= 1) {
#pragma unroll
        for (int r = 0; r < RPW; ++r) v[r] += __shfl_xor(v[r], o);
    }
}
__device__ __forceinline__ void row_phase(const RowJob& J, int gw, int ngw, int lane) {
    const int has_y = J.has_y, has_next = J.has_next;
    f32x4 gnp[4], gnn[4];
#pragma unroll
    for (int j = 0; j < 4; ++j) { gnp[j] = *(const f32x4*)(J.gn_post + 4 * lane + 256 * j); gnn[j] = *(const f32x4*)(J.gn_next + 4 * lane + 256 * j); }
    for (int base = J.row0 + gw * RPW; base < J.nrows; base += ngw * RPW) {
        const bool lat = base < RL; const int bidx = lat ? (base >> 12) : 8;
        const float* xs = lat ? J.xsrc_lat + (size_t)base * DM : J.xsrc_ctx + (size_t)(base - RL) * DM;
        float* xd = lat ? J.xdst_lat + (size_t)base * DM : J.xdst_ctx + (size_t)(base - RL) * DM;
        f32x4 x[RPW][4]; u32x2 yw[RPW][4];
#pragma unroll
        for (int r = 0; r < RPW; ++r)
#pragma unroll
            for (int j = 0; j < 4; ++j) x[r][j] = *(const f32x4*)(xs + (size_t)r * DM + 4 * lane + 256 * j);
        if (has_y) {
            if (!lat && J.ypart != nullptr) {
                const float* pr = J.ypart + (size_t)(base - RL) * DM;
#pragma unroll
                for (int r = 0; r < RPW; ++r)
#pragma unroll
                    for (int j = 0; j < 4; ++j) { f32x4 a = *(const f32x4*)(pr + (size_t)r * DM + 4 * lane + 256 * j);
#pragma unroll
                        for (int k2 = 1; k2 < 4; ++k2) a = a + *(const f32x4*)(pr + ((size_t)k2 * RC + r) * DM + 4 * lane + 256 * j);
                        yw[r][j].x = cvt_pk_bf16(a[0], a[1]); yw[r][j].y = cvt_pk_bf16(a[2], a[3]); }
            } else {
                const bf16_t* yr = J.Y + (size_t)base * J.ldy;
#pragma unroll
                for (int r = 0; r < RPW; ++r)
#pragma unroll
                    for (int j = 0; j < 4; ++j) yw[r][j] = *(const u32x2*)(yr + (size_t)r * J.ldy + 4 * lane + 256 * j);
            }
        }
        f32x4 gt[4], sh[4], sc[4];
        {
            const float* gate = J.modL + bidx * 6144 + J.gate_off; const float* shp = J.modN + bidx * 6144 + J.shift_off; const float* scp = J.modN + bidx * 6144 + J.scale_off;
#pragma unroll
            for (int j = 0; j < 4; ++j) { gt[j] = *(const f32x4*)(gate + 4 * lane + 256 * j); sh[j] = *(const f32x4*)(shp + 4 * lane + 256 * j); sc[j] = *(const f32x4*)(scp + 4 * lane + 256 * j); }
        }
        if (has_y) {
            float ss[RPW];
#pragma unroll
            for (int r = 0; r < RPW; ++r) { float a = 0.f;
#pragma unroll
                for (int j = 0; j < 4; ++j) { const float y0 = bflo(yw[r][j].x), y1 = bfhi(yw[r][j].x), y2 = bflo(yw[r][j].y), y3 = bfhi(yw[r][j].y); a += (y0 * y0 + y1 * y1) + (y2 * y2 + y3 * y3); }
                ss[r] = a; }
            wave_sumR(ss);
#pragma unroll
            for (int r = 0; r < RPW; ++r) { const float rs = rsqrtf(ss[r] * (1.0f / DM) + NORM_EPS);
#pragma unroll
                for (int j = 0; j < 4; ++j) { const f32x4 y = (f32x4){bflo(yw[r][j].x), bfhi(yw[r][j].x), bflo(yw[r][j].y), bfhi(yw[r][j].y)};
                    x[r][j] = x[r][j] + gt[j] * ((y * rs) * gnp[j]); *(f32x4*)(xd + (size_t)r * DM + 4 * lane + 256 * j) = x[r][j]; } }
        }
        if (J.x16 != nullptr && lat) {
#pragma unroll
            for (int r = 0; r < RPW; ++r)
#pragma unroll
                for (int j = 0; j < 4; ++j) { u32x2 w; w.x = cvt_pk_bf16(x[r][j][0], x[r][j][1]); w.y = cvt_pk_bf16(x[r][j][2], x[r][j][3]); *(u32x2*)(J.x16 + (size_t)(base + r) * DM + 4 * lane + 256 * j) = w; }
        }
        if (has_next) {
            float ss[RPW];
#pragma unroll
            for (int r = 0; r < RPW; ++r) { float a = 0.f;
#pragma unroll
                for (int j = 0; j < 4; ++j) a += (x[r][j][0] * x[r][j][0] + x[r][j][1] * x[r][j][1]) + (x[r][j][2] * x[r][j][2] + x[r][j][3] * x[r][j][3]);
                ss[r] = a; }
            wave_sumR(ss);
            bf16_t* hr = J.H + (size_t)base * DM;
#pragma unroll
            for (int r = 0; r < RPW; ++r) { const float rs = rsqrtf(ss[r] * (1.0f / DM) + NORM_EPS);
#pragma unroll
                for (int j = 0; j < 4; ++j) { const f32x4 h = ((x[r][j] * rs) * gnn[j]) * (sc[j] + 1.0f) + sh[j]; u32x2 w; w.x = cvt_pk_bf16(h[0], h[1]); w.y = cvt_pk_bf16(h[2], h[3]);
                    *(u32x2*)(hr + (size_t)r * DM + 4 * lane + 256 * j) = w; } }
        }
    }
}

__device__ __forceinline__ void qkvpost_phase(const bf16_t* raw, const float* qg, const float* kg, bf16_t* Q, bf16_t* Kb, bf16_t* Vb, int gw, int ngw, int lane) {
    const int l32 = lane & 31, d0 = 4 * l32; const bool lower = l32 < 16;
    const f32x4 qgv = *(const f32x4*)(qg + d0), kgv = *(const f32x4*)(kg + d0);
    f32x4 inv;
#pragma unroll
    for (int e = 0; e < 4; ++e) inv[e] = exp2f(-(float)((d0 + e) & 31) * (13.287712379549449f / 32.0f));
    const bool rowfreq = ((d0 & 63) < 32);
    for (int base = gw * 2; base < RT; base += ngw * 2) {
        const bool lat = base < RL;
        u32x2 qw[2][4], kw[2], vw[2];
#pragma unroll
        for (int r = 0; r < 2; ++r) { const bf16_t* rr = raw + (size_t)(base + r) * 1536 + 4 * lane;
            if (lat) {
#pragma unroll
                for (int c = 0; c < 4; ++c) qw[r][c] = *(const u32x2*)(rr + c * 256);
            }
            kw[r] = *(const u32x2*)(rr + 1024); vw[r] = *(const u32x2*)(rr + 1280); }
        f32x4 xv[2][5]; float ss[2][5];
#pragma unroll
        for (int r = 0; r < 2; ++r)
#pragma unroll
            for (int c = 0; c < 5; ++c) { const u32x2 w = (c < 4) ? qw[r][c] : kw[r];
                xv[r][c] = (f32x4){bflo(w.x), bfhi(w.x), bflo(w.y), bfhi(w.y)};
                ss[r][c] = (xv[r][c][0] * xv[r][c][0] + xv[r][c][1] * xv[r][c][1]) + (xv[r][c][2] * xv[r][c][2] + xv[r][c][3] * xv[r][c][3]); }
#pragma unroll
        for (int o = 1; o < 32; o <<= 1)
#pragma unroll
            for (int r = 0; r < 2; ++r)
#pragma unroll
                for (int c = 0; c < 5; ++c) if (c == 4 || lat) ss[r][c] += __shfl_xor(ss[r][c], o);
        const f32x4 sgn = lower ? (f32x4){-1.f, -1.f, -1.f, -1.f} : (f32x4){1.f, 1.f, 1.f, 1.f};
#pragma unroll
        for (int r = 0; r < 2; ++r) {
            const int row = base + r; const int b = lat ? (row >> 12) : ((row - RL) >> 8); const int t = lat ? (row & 4095) : ((row - RL) & 255);
            const int pos = lat ? (CTXL + t) : t;
            f32x4 cs = (f32x4){1.f, 1.f, 1.f, 1.f}, sn = (f32x4){0.f, 0.f, 0.f, 0.f};
            if (lat) { const float p = rowfreq ? (float)(t >> 6) : (float)(t & 63);
#pragma unroll
                for (int e = 0; e < 4; ++e) { float rev = (p * inv[e]) * 0.15915494309189535f; rev -= floorf(rev); sn[e] = __builtin_amdgcn_sinf(rev); cs[e] = __builtin_amdgcn_cosf(rev); } }
            f32x4 y[5], pr[5];
#pragma unroll
            for (int c = 0; c < 5; ++c) { const float rs = rsqrtf(ss[r][c] * (1.0f / 128.0f) + NORM_EPS); y[c] = (xv[r][c] * rs) * (c < 4 ? qgv : kgv); }
#pragma unroll
            for (int c = 0; c < 5; ++c) if (c == 4 || lat) {
#pragma unroll
                for (int e = 0; e < 4; ++e) pr[c][e] = __shfl_xor(y[c][e], 16); }
            const size_t kvoff = ((size_t)b * SKV + pos) * 256 + 4 * lane;
#pragma unroll
            for (int c = 0; c < 5; ++c) if (c == 4 || lat) {
                const f32x4 o4 = y[c] * cs + (pr[c] * sn) * sgn;
                u32x2 ow; ow.x = cvt_pk_bf16(o4[0], o4[1]); ow.y = cvt_pk_bf16(o4[2], o4[3]);
                if (c < 4) *(u32x2*)(Q + (size_t)row * 1024 + c * 256 + 4 * lane) = ow; else *(u32x2*)(Kb + kvoff) = ow; }
            *(u32x2*)(Vb + kvoff) = vw[r];
        }
    }
}

constexpr int KF = 2304;
__device__ __forceinline__ void fold_phase(const bf16_t* H, bf16_t* Z, bf16_t* DFTL, int gw, int ngw, int lane) {
    for (int zr = gw; zr < NBATCH * ZJ; zr += ngw) {
        const int b = zr / ZJ, j = zr % ZJ;
        int n1 = -1, n2 = -1; float sgn = 1.f;
        if (j < 2048) { n1 = j; if (j > 0) n2 = SEQ - j; }
        else if (j == 2048) { n1 = 2048; }
        else if (j >= KF) { const int n = j - KF; if (n > 0) { n1 = n; n2 = SEQ - n; sgn = -1.f; } }
#pragma unroll
        for (int q = 0; q < 2; ++q) {
            const int col = 8 * lane + 512 * q; unsigned z0; asm volatile("v_mov_b32 %0, 0" : "=v"(z0)); u32x4 o = (u32x4){z0, z0, z0, z0};
            if (n1 >= 0) {
                const u32x4 a = *(const u32x4*)(H + ((size_t)b * SEQ + n1) * DM + col);
                if (n2 >= 0) { const u32x4 c = *(const u32x4*)(H + ((size_t)b * SEQ + n2) * DM + col);
#pragma unroll
                    for (int e = 0; e < 4; ++e) o[e] = cvt_pk_bf16(bflo(a[e]) + sgn * bflo(c[e]), bfhi(a[e]) + sgn * bfhi(c[e])); }
                else o = a;
            }
            *(u32x4*)(Z + (size_t)zr * DM + col) = o;
        }
    }
    for (int k = gw; k < SEQ / 2; k += ngw) {
        for (int jb = lane; jb < ZJ / 8; jb += 64) {
            float v[8];
#pragma unroll
            for (int e = 0; e < 8; ++e) { const int j = jb * 8 + e; float val;
                if (j < 2048) val = __builtin_amdgcn_cosf((float)((k * j) & 4095) * (1.0f / 4096.0f));
                else if (j == 2048) val = (k & 1) ? -1.f : 1.f;
                else if (j < KF) val = 0.f;
                else val = __builtin_amdgcn_sinf((float)((k * (j - KF)) & 4095) * (1.0f / 4096.0f));
                v[e] = val; }
            u32x4 o; o.x = cvt_pk_bf16(v[0], v[1]); o.y = cvt_pk_bf16(v[2], v[3]); o.z = cvt_pk_bf16(v[4], v[5]); o.w = cvt_pk_bf16(v[6], v[7]);
            *(u32x4*)(DFTL + (size_t)k * ZJ + jb * 8) = o;
        }
    }
}
__device__ __forceinline__ void combine_phase(const bf16_t* PAB, const bf16_t* RTp, bf16_t* Yf, int gw, int ngw, int lane) {
    const float sc = 1.0f / 1024.0f;
    for (int r = gw; r < NBATCH * 2048; r += ngw) {
        const int b = r >> 11, k = r & 2047;
        const bf16_t* pa = PAB + ((size_t)(b * 2 + 0) * 2048 + k) * DM; const bf16_t* pb = PAB + ((size_t)(b * 2 + 1) * 2048 + k) * DM;
        bf16_t* y0 = Yf + ((size_t)b * SEQ + k) * DM; bf16_t* y1 = Yf + ((size_t)b * SEQ + (SEQ - k)) * DM;
#pragma unroll
        for (int q = 0; q < 2; ++q) { const int col = 8 * lane + 512 * q;
            const u32x4 a = *(const u32x4*)(pa + col), c = *(const u32x4*)(pb + col); u32x4 om, op;
#pragma unroll
            for (int e = 0; e < 4; ++e) { const float a0 = bflo(a[e]), a1 = bfhi(a[e]), c0 = bflo(c[e]), c1 = bfhi(c[e]);
                om[e] = cvt_pk_bf16((a0 - c0) * sc, (a1 - c1) * sc); op[e] = cvt_pk_bf16((a0 + c0) * sc, (a1 + c1) * sc); }
            *(u32x4*)(y0 + col) = om; if (k > 0) *(u32x4*)(y1 + col) = op; }
    }
    for (int t = gw; t < NBATCH * 1024; t += ngw) {
        const int b = t >> 10, m = t & 1023; const bf16_t* rr = RTp + ((size_t)b * 1024 + m) * ZJ; float s = 0.f;
#pragma unroll
        for (int c4 = 0; c4 < 4; ++c4) { const u32x4 w = *(const u32x4*)(rr + (c4 * 64 + lane) * 8);
#pragma unroll
            for (int e = 0; e < 4; ++e) s += bflo(w[e]) - bfhi(w[e]); }
        s = wave_sum(s);
        if (lane == 0) { const float ny = __uint_as_float((unsigned)rr[2048] << 16); Yf[((size_t)b * SEQ + 2048) * DM + m] = f2bf((s + ny) * sc); }
    }
}

__device__ __forceinline__ void spatial_phase(LAS unsigned char* lds, bf16_t* BIGp, const float* stats, const bf16_t* aws, const float* ln_g, const float* b_s, int nchunks, const int tid) {
    const int wid = tid >> 6, lane = tid & 63, fr = lane & 15, fq = lane >> 4;
    constexpr int LDP = 136;
    LAS bf16_t* Wl = (LAS bf16_t*)lds;
    LAS bf16_t* Vt = (LAS bf16_t*)(lds + 128 * LDP * 2);
    LAS float* St = (LAS float*)(lds + (128 + 256) * LDP * 2);
    const int G = gridDim.x, c = blockIdx.x;
    const bool fixed_g = (G % 8) == 0;
    const int per_g = fixed_g ? G / 8 : 1;
    int gcur = -1;
    bf16x8 af[4]; float bias = 0.f;
    for (int i = 0; ; ++i) {
        int ch, g;
        if (fixed_g) { g = c & 7; ch = (c >> 3) + per_g * i; if (ch >= nchunks) break; }
        else { const int u = c + G * i; if (u >= nchunks * 8) break; ch = u >> 3; g = u & 7; }
        u32x4 vw[8];
#pragma unroll
        for (int it = 0; it < 8; ++it) { const int id = it * 512 + tid, ql = id & 15, cb = (id >> 4) & 31, q = (id >> 9) * 16 + ql;
            vw[it] = *(const u32x4*)(BIGp + (size_t)(ch * 128 + q) * 4096 + 2048 + g * 256 + cb * 8); }
        const int prow = ch * 128 + 16 * wid + fr;
        bf16_t* const ubase = BIGp + (size_t)prow * 4096 + g * 256 + 8 * fq;
        u32x4 uw[8];
#pragma unroll
        for (int j = 0; j < 8; ++j) uw[j] = *(const u32x4*)(ubase + 32 * j);
        if (g != gcur) {
#pragma unroll
            for (int it = 0; it < 4; ++it) { const int id = it * 512 + tid, p = id >> 4, kc = id & 15;
                *(LAS u32x4*)(Wl + p * LDP + kc * 8) = *(const u32x4*)(aws + ((size_t)g * 128 + p) * 128 + kc * 8); }
        }
        if (tid < 128) { const float* sp = stats + (size_t)(ch * 128 + tid) * 64; float a = 0.f, q = 0.f;
#pragma unroll
            for (int k2 = 0; k2 < 32; ++k2) { a += sp[2 * k2]; q += sp[2 * k2 + 1]; }
            const float mu = a * (1.0f / 2048.0f); const float var = q * (1.0f / 2048.0f) - mu * mu;
            St[2 * tid] = mu; St[2 * tid + 1] = rsqrtf(fmaxf(var, 0.f) + LN_EPS); }
        __syncthreads();
        if (g != gcur) {
#pragma unroll
            for (int ks = 0; ks < 4; ++ks) af[ks] = *(const LAS bf16x8*)(Wl + (16 * wid + fr) * LDP + 32 * ks + 8 * fq);
            bias = b_s[g * 128 + 16 * wid + fr]; gcur = g;
        }
#pragma unroll
        for (int it = 0; it < 8; ++it) { const int id = it * 512 + tid, ql = id & 15, cb = (id >> 4) & 31, q = (id >> 9) * 16 + ql, c0 = cb * 8;
            const u32x4 w = vw[it];
            const float mu = St[2 * q], rs = St[2 * q + 1];
            const f32x4 g0 = *(const f32x4*)(ln_g + g * 256 + c0), g1 = *(const f32x4*)(ln_g + g * 256 + c0 + 4);
            const float v[8] = {bflo(w.x), bfhi(w.x), bflo(w.y), bfhi(w.y), bflo(w.z), bfhi(w.z), bflo(w.w), bfhi(w.w)};
#pragma unroll
            for (int e = 0; e < 8; ++e) { const float gg = e < 4 ? g0[e] : g1[e - 4]; Vt[(c0 + e) * LDP + q] = f2bf((v[e] - mu) * rs * gg); } }
        __syncthreads();
#pragma unroll
        for (int j = 0; j < 8; ++j) {
            f32x4 a0 = (f32x4){0.f, 0.f, 0.f, 0.f}, a1 = a0;
            const int cr = 32 * j + 8 * (fr >> 2) + (fr & 3);
#pragma unroll
            for (int ks = 0; ks < 4; ++ks) {
                const bf16x8 b0 = *(const LAS bf16x8*)(Vt + cr * LDP + 32 * ks + 8 * fq), b1 = *(const LAS bf16x8*)(Vt + (cr + 4) * LDP + 32 * ks + 8 * fq);
                a0 = __builtin_amdgcn_mfma_f32_16x16x32_bf16(b0, af[ks], a0, 0, 0, 0); a1 = __builtin_amdgcn_mfma_f32_16x16x32_bf16(b1, af[ks], a1, 0, 0, 0); }
            const u32x4 u4 = uw[j];
            u32x4 o;
            o.x = cvt_pk_bf16(bflo(u4.x) * (a0[0] + bias), bfhi(u4.x) * (a0[1] + bias)); o.y = cvt_pk_bf16(bflo(u4.y) * (a0[2] + bias), bfhi(u4.y) * (a0[3] + bias));
            o.z = cvt_pk_bf16(bflo(u4.z) * (a1[0] + bias), bfhi(u4.z) * (a1[1] + bias)); o.w = cvt_pk_bf16(bflo(u4.w) * (a1[2] + bias), bfhi(u4.w) * (a1[3] + bias));
            *(u32x4*)(ubase + 32 * j) = o;
        }
        __syncthreads();
    }
}

template <bool QKPERM> __device__ __forceinline__ void p0_transpose_item(const float* W, int K, int N, bf16_t* WT, LAS float* scr, int item, int lane) {
    const int nblk = N / 32, kb = item / nblk, nb = item % nblk, k0 = 64 * kb, n0 = 32 * nb;
    {
        const int kr = lane >> 3, nc = (lane & 7) * 4; f32x4 v[8];
        int src = n0 + nc;
        if (QKPERM && src < 1280) { const int p = src & 127; src = (src & ~127) + 16 * (p >> 5) + 4 * ((p >> 3) & 3) + 64 * ((p >> 2) & 1); }
#pragma unroll
        for (int i = 0; i < 8; ++i) v[i] = *(const f32x4*)(W + (size_t)(k0 + 8 * i + kr) * N + src);
#pragma unroll
        for (int i = 0; i < 8; ++i) {
#pragma unroll
            for (int e = 0; e < 4; ++e) scr[(8 * i + kr) * 33 + nc + e] = v[i][e]; }
    }
    asm volatile("s_waitcnt lgkmcnt(0)" ::: "memory");
    const int c = lane & 7;
#pragma unroll
    for (int j = 0; j < 4; ++j) { const int n = (lane >> 3) + 8 * j; const LAS float* s = scr + (8 * c) * 33 + n;
        u32x4 o; o.x = cvt_pk_bf16(s[0 * 33], s[1 * 33]); o.y = cvt_pk_bf16(s[2 * 33], s[3 * 33]); o.z = cvt_pk_bf16(s[4 * 33], s[5 * 33]); o.w = cvt_pk_bf16(s[6 * 33], s[7 * 33]);
        *(u32x4*)(WT + (size_t)(n0 + n) * K + k0 + 8 * c) = o; }
    asm volatile("s_waitcnt lgkmcnt(0)" ::: "memory");
}

struct Params { const float* in[19]; float* out; unsigned char* ws; int ph_lo, ph_hi; };
constexpr int LDS_PAR_OFF = 131072, LDS_BARST_OFF = 131072 + 256, LDS_JOB_OFF = 131072 + 320;
struct PView {
    LAS const unsigned char* base;
    __device__ __forceinline__ const float* in(int i) const { return pg8::jptr<const float>(base + 8 * i); }
    __device__ __forceinline__ float* out() const { return pg8::jptr<float>(base + 8 * 19); }
    __device__ __forceinline__ unsigned char* wsp() const { return pg8::jptr<unsigned char>(base + 8 * 20); }
};

__device__ __forceinline__ void prologue_phase(const PView& P, LAS unsigned char* lds, const int tid) {
    const int wid = tid >> 6, lane = tid & 63;
    unsigned char* ws = P.wsp();
    {
        LAS float* sl = (LAS float*)lds;
        LAS float* red = (LAS float*)(lds + 36864);
        float* MOD = (float*)(ws + WS_MOD);
        for (int item = blockIdx.x; item < 192; item += gridDim.x) {
            const int layer = item / 48, col0 = (item % 48) * 128;
            for (int idx = tid; idx < 9216; idx += 512) { const int r = idx >> 10, k = idx & 1023; const float v = r < 8 ? P.in(1)[r * 1024 + k] : P.in(3)[k]; sl[idx] = v / (1.0f + __expf(-v)); }
            __syncthreads();
            const int ks = tid >> 5, c4 = tid & 31;
            const float* w = P.in(4) + ((size_t)layer * 1024 + ks * 64) * 6144 + col0 + c4 * 4;
            f32x4 acc[9];
#pragma unroll
            for (int r = 0; r < 9; ++r) acc[r] = (f32x4){0.f, 0.f, 0.f, 0.f};
#pragma unroll 16
            for (int kk = 0; kk < 64; ++kk) { const f32x4 wv = *(const f32x4*)(w + (size_t)kk * 6144);
#pragma unroll
                for (int r = 0; r < 9; ++r) acc[r] = acc[r] + wv * sl[r * 1024 + ks * 64 + kk]; }
#pragma unroll
            for (int r = 0; r < 9; ++r) *(LAS f32x4*)(red + (ks * 9 + r) * 128 + c4 * 4) = acc[r];
            __syncthreads();
            for (int idx = tid; idx < 9 * 128; idx += 512) { const int r = idx >> 7, cc = idx & 127; float s = P.in(5)[layer * 6144 + col0 + cc];
#pragma unroll
                for (int k2 = 0; k2 < 16; ++k2) s += red[(k2 * 9 + r) * 128 + cc];
                MOD[(size_t)(layer * 9 + r) * 6144 + col0 + cc] = s; }
            __syncthreads();
        }
    }
    {
        LAS float* scr = (LAS float*)(lds + wid * 8448);
        const int gw = blockIdx.x * 8 + wid, ngw = gridDim.x * 8;
        constexpr int I_W1 = 16 * 128, I_W2 = 64 * 32, I_AIN = 16 * 128, I_AOUT = 32 * 32, I_BO = 16 * 32, I_QKV = 16 * 48, I_WO = 16 * 32;
        constexpr int NITEMS = 4 * I_W1 + 4 * I_W2 + 2 * I_AIN + 2 * I_AOUT + I_BO + I_QKV + I_WO;
        for (int it = gw; it < NITEMS; it += ngw) {
            int r = it;
            if (r < 4 * I_W1) { const int l = r / I_W1; p0_transpose_item<false>(P.in(7) + (size_t)l * 1024 * 4096, 1024, 4096, (bf16_t*)(ws + WS_W1T) + (size_t)l * 4096 * 1024, scr, r % I_W1, lane); continue; } r -= 4 * I_W1;
            if (r < 4 * I_W2) { const int l = r / I_W2; p0_transpose_item<false>(P.in(8) + (size_t)l * 4096 * 1024, 4096, 1024, (bf16_t*)(ws + WS_W2T) + (size_t)l * 1024 * 4096, scr, r % I_W2, lane); continue; } r -= 4 * I_W2;
            if (r < 2 * I_AIN) { const int l = r / I_AIN; p0_transpose_item<false>(P.in(9) + (size_t)l * 1024 * 4096, 1024, 4096, (bf16_t*)(ws + WS_AWINT) + (size_t)l * 4096 * 1024, scr, r % I_AIN, lane); continue; } r -= 2 * I_AIN;
            if (r < 2 * I_AOUT) { const int l = r / I_AOUT; p0_transpose_item<false>(P.in(13) + (size_t)l * 2048 * 1024, 2048, 1024, (bf16_t*)(ws + WS_AWOUTT) + (size_t)l * 1024 * 2048, scr, r % I_AOUT, lane); continue; } r -= 2 * I_AOUT;
            if (r < I_BO) { p0_transpose_item<false>(P.in(14), 1024, 1024, (bf16_t*)(ws + WS_BWOUTT), scr, r, lane); continue; } r -= I_BO;
            if (r < I_QKV) { p0_transpose_item<false>(P.in(15), 1024, 1536, (bf16_t*)(ws + WS_QKVT), scr, r, lane); continue; } r -= I_QKV;
            p0_transpose_item<false>(P.in(18), 1024, 1024, (bf16_t*)(ws + WS_WOT), scr, r, lane);
        }
    }
    {
        const int gt = blockIdx.x * 512 + tid, ngt = gridDim.x * 512;
        bf16_t* aws = (bf16_t*)(ws + WS_AWS);
        for (int i = gt; i < 2 * 8 * 128 * 128 / 8; i += ngt) { const f32x4 a = *(const f32x4*)(P.in(11) + (size_t)i * 8), b = *(const f32x4*)(P.in(11) + (size_t)i * 8 + 4);
            u32x4 o; o.x = cvt_pk_bf16(a[0], a[1]); o.y = cvt_pk_bf16(a[2], a[3]); o.z = cvt_pk_bf16(b[0], b[1]); o.w = cvt_pk_bf16(b[2], b[3]); *(u32x4*)(aws + (size_t)i * 8) = o; }
        bf16_t* cc = (bf16_t*)(ws + WS_CC); bf16_t* scm = (bf16_t*)(ws + WS_SC); bf16_t* dc = (bf16_t*)(ws + WS_DFTC);
        for (int i = gt; i < 65536; i += ngt) { const int m = i >> 8, c = i & 255; const float rev = (float)((m * c) & 255) * (1.0f / 256.0f);
            cc[i] = f2bf(__builtin_amdgcn_cosf(rev)); scm[i] = f2bf(__builtin_amdgcn_sinf(rev)); }
        for (int i = gt; i < 131072; i += ngt) { const int k = i >> 9, j = i & 511; const int n = j & 255; const float rev = (float)((k * n) & 255) * (1.0f / 256.0f);
            dc[i] = f2bf(j < 256 ? __builtin_amdgcn_cosf(rev) : -__builtin_amdgcn_sinf(rev)); }
    }
}


#define XB_TMO      128
#define XB_XCNT(j)  (256  + 64 * (j))
#define XB_XSUB(j)  (1280 + 64 * (j))
#define XB_XGEN(j)  (2304 + 64 * (j))
#define XB_TOP      3328
#define XB_TOPGEN   3392
#define XCD_BAR_WORDS 3456
#define XB_SPIN_CAP (1u << 18)
__device__ __forceinline__ unsigned xb_ld(unsigned* p)              { return __hip_atomic_load(p, __ATOMIC_RELAXED, __HIP_MEMORY_SCOPE_AGENT); }
__device__ __forceinline__ unsigned xb_add(unsigned* p, unsigned v) { return __hip_atomic_fetch_add(p, v, __ATOMIC_RELAXED, __HIP_MEMORY_SCOPE_AGENT); }
__device__ __forceinline__ unsigned xb_xcc_id() { return (unsigned)__builtin_amdgcn_s_getreg((3 << 11) | 20) & 0xFu; }
#define XB_SPIN(cond, bar) do { unsigned _sp = 0; while (cond) { __builtin_amdgcn_s_sleep(1); \
    if ((++_sp & 255u) == 0u) { if (xb_ld(&(bar)[XB_TMO])) break; if (_sp > XB_SPIN_CAP) { atomicAdd(&(bar)[XB_TMO], 1u); break; } } } } while (0)
struct XcdBarrier { unsigned* bar; unsigned x; volatile LAS unsigned* st; };
__device__ __forceinline__ XcdBarrier xcd_barrier_post(unsigned* bar, volatile LAS unsigned* st) {
    XcdBarrier b; b.bar = bar; b.x = xb_xcc_id(); b.st = st;
    if (threadIdx.x == 0) (void)xb_add(&bar[XB_XCNT(b.x)], 1u);
    return b;
}
__device__ __forceinline__ void xcd_barrier_complete(unsigned* bar, unsigned x, unsigned& nloc, unsigned& nx) {
    const unsigned G = gridDim.x * gridDim.y * gridDim.z;
    unsigned sum, cnt, mine, sp = 0u;
    for (;;) {
        sum = 0u; cnt = 0u; mine = 0u;
#pragma unroll
        for (unsigned j = 0; j < 16; ++j) { const unsigned c = xb_ld(&bar[XB_XCNT(j)]); sum += c; cnt += (c > 0u) ? 1u : 0u; mine = (j == x) ? c : mine; }
        if (sum == G) break;
        __builtin_amdgcn_s_sleep(1);
        if ((++sp & 255u) == 0u) { if (xb_ld(&bar[XB_TMO])) break; if (sp > XB_SPIN_CAP) { atomicAdd(&bar[XB_TMO], 1u); break; } }
    }
    nloc = mine > 0u ? mine : 1u; nx = cnt > 0u ? cnt : 1u;
}
__device__ __forceinline__ void xcd_barrier(const XcdBarrier& b) {
    asm volatile("s_waitcnt vmcnt(0)" ::: "memory");
    __syncthreads();
    if (threadIdx.x == 0) {
        unsigned* bar = b.bar;
        __builtin_amdgcn_s_waitcnt(0);
        unsigned nloc = b.st[0], nx = b.st[1];
        if (nloc == 0u) { xcd_barrier_complete(bar, b.x, nloc, nx); b.st[0] = nloc; b.st[1] = nx; }
        const unsigned old = xb_add(&bar[XB_XSUB(b.x)], 1u);
        const unsigned gen = old / nloc;
        if (old + 1u == (gen + 1u) * nloc) {
            __builtin_amdgcn_fence(__ATOMIC_RELEASE, "agent");
            asm volatile("s_waitcnt vmcnt(0)" ::: "memory");
            const unsigned og = xb_add(&bar[XB_TOP], 1u);
            const unsigned tg = og / nx;
            if (og + 1u == (tg + 1u) * nx) xb_add(&bar[XB_TOPGEN], 1u);
            else XB_SPIN(xb_ld(&bar[XB_TOPGEN]) == tg, bar);
            xb_add(&bar[XB_XGEN(b.x)], 1u);
            __builtin_amdgcn_fence(__ATOMIC_ACQUIRE, "agent");
            asm volatile("s_waitcnt vmcnt(0)" ::: "memory");
        } else {
            XB_SPIN(xb_ld(&bar[XB_XGEN(b.x)]) == gen, bar);
            __builtin_amdgcn_fence(__ATOMIC_ACQUIRE, "agent");
            asm volatile("s_waitcnt vmcnt(0)" ::: "memory");
        }
    }
    __syncthreads();
}

enum { K_PRO = 0, K_ROW, K_GEMM, K_SPATIAL, K_FOLD, K_QKVPOST, K_ATTN, K_NONE };
constexpr int NPH = 34;

__device__ __forceinline__ GJob mkgemm(const bf16_t* A, int lda, const bf16_t* B, int ldb, void* C, int ldc, int M, int N, int K, int act, int out_f32) {
    int z; asm volatile("v_mov_b32 %0, 0" : "=v"(z));
    GJob g; g.A = A; g.A2 = A; g.a2mask = (unsigned)z; g.lda = lda; g.B = B; g.b_bs_hi = z; g.b_bs_lo = z; g.bdiv = 1; g.b_pn_mod = 1 << 20; g.ldb = ldb;
    g.C = C; g.c_bs = z; g.ldc = ldc; g.out_f32 = out_f32; g.act = act; g.scale = 1.0f; g.stats = (float*)(size_t)z; g.stats_pn0 = z; g.nM = M / 256; g.nN = N / 256; g.nB = 1; g.K = K; g.part = (float*)(size_t)z; g.split_pm0 = 1 << 20; g.ksplit = 1; g.fused = z; g.has_next = z; g.gate_off = z; g.shift_off = z; g.scale_off = z; g.x_mode = z;
    g.xsrc = (const float*)(size_t)z; g.xdst = (float*)(size_t)z; g.Hout = (bf16_t*)(size_t)z; g.gn_post = g.xsrc; g.gn_next = g.xsrc; g.modL = g.xsrc; g.modN = g.xsrc; g.slot1 = (unsigned*)(size_t)z; g.slot2 = g.slot1; g.cnt1 = g.slot1; g.cnt2 = g.slot1; g.kf = z; g.dry = z; g.Kd = g.Hout; g.Vd = g.Hout; g.qg = g.xsrc; g.kg = g.xsrc; return g;
}
__device__ __forceinline__ RowJob mkrow(const PView& P, int layer, int which, int nrows, const bf16_t* Y, bf16_t* H) {
    unsigned char* ws = P.wsp();
    const float* norm_g = P.in(6); const float* MOD = (const float*)(ws + WS_MOD); float* out = P.out(); float* XC = (float*)((unsigned char*)out + OUT_XC);
    RowJob r; r.row0 = (which != 0) ? RL : 0; r.nrows = nrows; r.has_y = which != 0; r.ldy = DM; r.Y = Y; r.H = H;
    r.ypart = (which != 0 && layer <= 1) ? (const float*)((unsigned char*)out + OUT_PART) : nullptr;
    r.x16 = (which == 0) ? (bf16_t*)(ws + WS_X16) : nullptr;
    r.modL = MOD + (size_t)layer * 9 * 6144; r.gn_post = norm_g + (layer * 4 + (which == 1 ? 1 : 3)) * DM; r.gate_off = (which == 1 ? 2 : 5) * DM;
    const bool first = (layer == 0 && which <= 1);
    r.xsrc_lat = first ? P.in(0) : out; r.xsrc_ctx = first ? P.in(2) : XC; r.xdst_lat = out; r.xdst_ctx = XC;
    if (which == 0) { r.has_next = 1; r.gn_next = norm_g + (layer * 4 + 0) * DM; r.modN = r.modL; r.shift_off = 0; r.scale_off = DM; }
    else if (which == 1) { r.has_next = 1; r.gn_next = norm_g + (layer * 4 + 2) * DM; r.modN = r.modL; r.shift_off = 3 * DM; r.scale_off = 4 * DM; }
    else { r.has_next = layer < 3; const int nl = layer < 3 ? layer + 1 : layer; r.gn_next = norm_g + (nl * 4 + 0) * DM; r.modN = MOD + (size_t)nl * 9 * 6144; r.shift_off = 0; r.scale_off = DM; }
    return r;
}

__device__ __forceinline__ void phase_info(int ph, int& kind, int& sync, int& a, int& rows) {
    kind = K_GEMM; sync = 1; a = 0; rows = RT;
    switch (ph) {
        case 0: kind = K_PRO; break;
        case 1: kind = K_ROW; a = 0; break;
        case 3: kind = K_SPATIAL; a = 0; rows = RT; break;
        case 28: kind = K_SPATIAL; a = 1; rows = RL; break;
        case 5: kind = K_ROW; a = 1; break;
        case 8: kind = K_ROW; a = 2; sync = 0; break;
        case 9: kind = K_FOLD; break;
        case 10: sync = 0; break;
        case 12: sync = 0; break;
        case 15: kind = K_ROW; a = 3; break;
        case 18: kind = K_ROW; a = 4; break;
        case 20: kind = K_QKVPOST; break;
        case 21: kind = K_ATTN; break;
        case 23: case 26: case 30: case 33: kind = K_NONE; sync = 0; break;
        case 32: sync = 0; break;
        default: break;
    }
}
__device__ __forceinline__ GJob gemm_job(int ph, const PView& P) {
    unsigned char* ws = P.wsp();
    bf16_t* YH = (bf16_t*)(ws + WS_YH); unsigned char* BIG = ws + WS_BIG; bf16_t* BIGb = (bf16_t*)BIG; float* STATS = (float*)((unsigned char*)P.out() + OUT_STATS);
    GJob g = mkgemm(YH, DM, YH, DM, YH, DM, 256, 256, 256, 0, 0);
    int up_layer = -1, down_layer = -1, rows = RT;
    switch (ph) {
        case 2: case 27: { const int j = ph == 2 ? 0 : 1; rows = ph == 2 ? RT : RL;
            g = mkgemm(YH, DM, (const bf16_t*)(ws + WS_AWINT) + (size_t)j * 4096 * 1024, DM, BIGb, 4096, rows, 4096, 1024, 1, 0); g.stats = STATS; g.stats_pn0 = 8; break; }
        case 4: case 29: { const int j = ph == 4 ? 0 : 1; rows = ph == 4 ? RT : RL;
            g = mkgemm(BIGb, 4096, (const bf16_t*)(ws + WS_AWOUTT) + (size_t)j * 1024 * 2048, 2048, YH, DM, rows, 1024, 2048, 0, 0); break; }
        case 6: up_layer = 0; rows = RT; break;
        case 7: down_layer = 0; rows = RT; break;
        case 16: up_layer = 1; rows = RT; break;
        case 17: down_layer = 1; rows = RT; break;
        case 24: up_layer = 2; rows = RL; break;
        case 25: down_layer = 2; rows = RL; break;
        case 31: up_layer = 3; rows = RL; break;
        case 32: down_layer = 3; rows = RL; break;
        case 10: { g = mkgemm((const bf16_t*)(ws + WS_CC), 256, (const bf16_t*)(BIG + BIG_Z), DM, BIG + BIG_RT, ZJ, 256, ZJ, 256, 0, 0);
            g.A2 = (const bf16_t*)(ws + WS_SC); g.a2mask = 0x1FE00u; g.nB = 32; g.bdiv = 4; g.b_bs_hi = ZJ * DM; g.b_bs_lo = 256; g.c_bs = 256 * ZJ; break; }
        case 11: { g = mkgemm((const bf16_t*)(ws + WS_CC), 256, YH + (size_t)RL * DM, DM, BIG + BIG_RTC, 512, 256, 512, 256, 0, 0);
            g.A2 = (const bf16_t*)(ws + WS_SC); g.a2mask = 0x2u; g.nB = 32; g.bdiv = 4; g.b_bs_hi = CTXL * DM; g.b_bs_lo = 256; g.b_pn_mod = 1; g.c_bs = 256 * 512; break; }
        case 12: { g = mkgemm((const bf16_t*)(BIG + BIG_DFTL), ZJ, (const bf16_t*)(BIG + BIG_RT), ZJ, BIG + BIG_Y2, DM, SEQ / 2, 1024, ZJ, 0, 0);
            g.nB = 16; g.bdiv = 2; g.b_bs_hi = 1024 * ZJ; g.b_bs_lo = KF; g.c_bs = (SEQ / 2) * DM; g.kf = KF; break; }
        case 13: { g = mkgemm((const bf16_t*)(ws + WS_DFTC), 512, (const bf16_t*)(BIG + BIG_RTC), 512, YH + (size_t)RL * DM, DM, CTXL, 1024, 512, 0, 0);
            g.nB = 8; g.b_bs_hi = 1024 * 512; g.c_bs = CTXL * DM; g.scale = 1.0f / 256.0f; break; }
        case 14: g = mkgemm(YH, DM, (const bf16_t*)(ws + WS_BWOUTT), DM, BIG + BIG_Y2, DM, RT, 1024, 1024, 0, 0); break;
        case 19: g = mkgemm(YH, DM, (const bf16_t*)(ws + WS_QKVT), DM, BIG + BIG_RAW, 1536, RT, 1536, 1024, 0, 0); break;
        case 22: g = mkgemm((const bf16_t*)(BIG + BIG_O), DM, (const bf16_t*)(ws + WS_WOT), DM, YH, DM, RL, 1024, 1024, 0, 0); break;
        default: break;
    }
    if (down_layer >= 0 && rows == RT) {   }
    if (up_layer >= 0) g = mkgemm(YH, DM, (const bf16_t*)(ws + WS_W1T) + (size_t)up_layer * 4096 * 1024, DM, BIGb, 4096, rows, 4096, 1024, 2, 0);
    if (down_layer >= 0) g = mkgemm(BIGb, 4096, (const bf16_t*)(ws + WS_W2T) + (size_t)down_layer * 1024 * 4096, 4096, YH, DM, rows, 1024, 4096, 0, 0);
    if (ph == 4 || ph == 7 || ph == 14 || ph == 17) { g.part = (float*)((unsigned char*)P.out() + OUT_PART); g.split_pm0 = RL / 256; g.ksplit = 4; }
    {
        int layer = -1, which = 0;
        switch (ph) { case 4: layer = 0; which = 1; break; case 7: layer = 0; which = 2; break; case 14: layer = 1; which = 1; break; case 17: layer = 1; which = 2; break;
                      case 22: layer = 2; which = 1; break; case 25: layer = 2; which = 2; break; case 29: layer = 3; which = 1; break; case 32: layer = 3; which = 2; break; default: break; }
        if (layer >= 0) {
            const float* norm_g = P.in(6); const float* MOD = (const float*)(ws + WS_MOD); float* out = P.out();
            g.fused = 1; g.modL = MOD + (size_t)layer * 9 * 6144; g.gn_post = norm_g + (layer * 4 + (which == 1 ? 1 : 3)) * DM; g.gate_off = (which == 1 ? 2 : 5) * DM;
            const bool firstu = (layer == 0 && which == 1), lastu = (layer == 3 && which == 2);
            g.xsrc = (const float*)(ws + WS_X16); g.xdst = lastu ? out : (float*)(ws + WS_X16); g.x_mode = (lastu ? 2 : 0); g.Hout = YH; (void)firstu;
            if (which == 1) { g.has_next = 1; g.gn_next = norm_g + (layer * 4 + 2) * DM; g.modN = g.modL; g.shift_off = 3 * DM; g.scale_off = 4 * DM; }
            else { g.has_next = layer < 3; const int nl = layer < 3 ? layer + 1 : layer; g.gn_next = norm_g + (nl * 4 + 0) * DM; g.modN = MOD + (size_t)nl * 9 * 6144; g.shift_off = 0; g.scale_off = DM; }
            g.slot1 = (unsigned*)(ws + WS_XS1); g.slot2 = (unsigned*)(ws + WS_XS2);
            g.cnt1 = (unsigned*)(ws + WS_CNT) + (size_t)(ph * 2 + 0) * 136 * 64; g.cnt2 = (unsigned*)(ws + WS_CNT) + (size_t)(ph * 2 + 1) * 136 * 64;
        }
    }
    return g;
}

__global__ void __launch_bounds__(512) mega_fwd(Params Pk) {
    extern __shared__ __attribute__((aligned(16))) unsigned char lds_raw[];
    cg::grid_group grid = cg::this_grid();
    LAS unsigned char* lds = (LAS unsigned char*)lds_raw;
    const int G = gridDim.x, cidx = blockIdx.x;
    {
        const int t0 = threadIdx.x;
        LAS unsigned long long* par = (LAS unsigned long long*)(lds + LDS_PAR_OFF);
        if (t0 < 19) par[t0] = (unsigned long long)Pk.in[t0];
        if (t0 == 19) par[19] = (unsigned long long)Pk.out;
        if (t0 == 20) par[20] = (unsigned long long)Pk.ws;
        if (t0 == 21) { ((LAS unsigned*)(lds + LDS_BARST_OFF))[0] = 0u; ((LAS unsigned*)(lds + LDS_BARST_OFF))[1] = 0u; }
    }
    __syncthreads();
    if ((Pk.ph_hi - Pk.ph_lo) > 1) (void)xcd_barrier_post((unsigned*)(Pk.ws + WS_BAR), (volatile LAS unsigned*)(lds + LDS_BARST_OFF));
    PView P; P.base = lds + LDS_PAR_OFF;
    LAS GJob* jl = (LAS GJob*)(lds + LDS_JOB_OFF);

    const int ph_lo = Pk.ph_lo, ph_hi = Pk.ph_hi;
    int replayed = 0;
    for (int ph = ph_lo; ph < ph_hi; ++ph) {
        int tid = threadIdx.x; asm volatile("" : "+v"(tid));
        const int wid = __builtin_amdgcn_readfirstlane(tid >> 6), lane = tid & 63;
        const int gw = cidx * 8 + wid, ngw = G * 8;
        int kind, sync, a, rows;
        phase_info(ph, kind, sync, a, rows);
        if (ph == 14 && !replayed && ph_lo == 0) {
            unsigned char* wsx = P.wsp();
            combine_phase((const bf16_t*)(wsx + WS_BIG + BIG_Y2), (const bf16_t*)(wsx + WS_BIG + BIG_RT), (bf16_t*)(wsx + WS_YH), gw, ngw, lane);
            XcdBarrier xbar; xbar.bar = (unsigned*)(wsx + WS_BAR); xbar.x = xb_xcc_id(); xbar.st = (volatile LAS unsigned*)(lds + LDS_BARST_OFF);
            xcd_barrier(xbar);
        }
        if (kind == K_GEMM) {
            if (tid == 0) { GJob g = gemm_job(ph, P); if (REPEAT_MASK != 0ULL && ((REPEAT_MASK >> ph) & 1ULL) && !replayed && DRY_ALL) g.dry = DRY_ALL; const int* src = (const int*)&g; LAS int* dst = (LAS int*)jl;
#pragma unroll
                for (int q = 0; q < (int)(sizeof(GJob) / 4); ++q) dst[q] = src[q]; }
            __syncthreads();
#ifndef NO_GEMM
            pg8::gemm_phase(lds, jl, G, cidx, tid);
#endif
        } else if (kind == K_ROW) {
            unsigned char* ws = P.wsp(); bf16_t* YH = (bf16_t*)(ws + WS_YH);
            const int layer = a == 0 ? 0 : (a - 1) >> 1, which = a == 0 ? 0 : ((a - 1) & 1) + 1;
            const bf16_t* Y = (a == 3) ? (const bf16_t*)(ws + WS_BIG + BIG_Y2) : YH;
            const int nr = (a == 4) ? RT : rows;
            const RowJob r = mkrow(P, layer, which, nr, Y, YH);
#ifndef NO_ROW
            row_phase(r, gw, ngw, lane);
#endif
        } else if (kind == K_PRO) {
#ifndef NO_PRO
            prologue_phase(P, lds, tid);
#endif
        } else if (kind == K_SPATIAL) {
            unsigned char* ws = P.wsp();
            spatial_phase(lds, (bf16_t*)(ws + WS_BIG), (const float*)((unsigned char*)P.out() + OUT_STATS), (const bf16_t*)(ws + WS_AWS) + (size_t)a * 8 * 128 * 128, P.in(10) + a * 2048, P.in(12) + a * 8 * 128, rows / 128, tid);
        } else if (kind == K_FOLD) {
            unsigned char* ws = P.wsp();
            fold_phase((const bf16_t*)(ws + WS_YH), (bf16_t*)(ws + WS_BIG + BIG_Z), (bf16_t*)(ws + WS_BIG + BIG_DFTL), gw, ngw, lane);
        } else if (kind == K_QKVPOST) {
            unsigned char* ws = P.wsp();
            qkvpost_phase((const bf16_t*)(ws + WS_BIG + BIG_RAW), P.in(16), P.in(17), (bf16_t*)(ws + WS_YH), (bf16_t*)(ws + WS_BIG + BIG_K), (bf16_t*)(ws + WS_BIG + BIG_V), gw, ngw, lane);
        } else if (kind == K_ATTN) {
            unsigned char* ws = P.wsp(); unsigned char* BIG = ws + WS_BIG; const bf16_t* YH = (const bf16_t*)(ws + WS_YH);
            const int xcd = cidx & 7, slot = cidx >> 3, per = G >> 3;
            for (int i = 0; ; ++i) {
                const int v = (G % 8 == 0) ? (i * G + xcd * per + slot) : (i * G + cidx);
                if (v >= 1024) break;
                const int qb = v & 15, hh = (v >> 4) & 3, kvh = (v >> 6) & 1, b = v >> 7, h = kvh * 4 + hh;
                const bf16_t* Qb = YH + ((size_t)b * SEQ + qb * 256) * 1024 + h * 128;
                const bf16_t* Kh = (const bf16_t*)(BIG + BIG_K) + (size_t)b * SKV * 256 + kvh * 128;
                const bf16_t* Vh = (const bf16_t*)(BIG + BIG_V) + (size_t)b * SKV * 256 + kvh * 128;
                bf16_t* Ob = (bf16_t*)(BIG + BIG_O) + ((size_t)b * SEQ + qb * 256) * 1024 + h * 128;
#ifndef NO_ATT
                att::attn_dense_body(Qb, Kh, Vh, Ob, SKV, (char*)lds_raw, tid);
#endif
                __syncthreads();
            }
        }
        if (REPEAT_MASK != 0ULL) { if (((REPEAT_MASK >> ph) & 1ULL) && !replayed) { replayed = 1; --ph; __syncthreads(); continue; } replayed = 0; }
        if (sync && ph + 1 < ph_hi) for (int srep = 0; srep < SYNC_REP; ++srep) {
            if (ph == 0 && Pk.ph_hi < 0) {
                asm volatile("s_waitcnt vmcnt(0) lgkmcnt(0)" ::: "memory");
                __syncthreads();
                if (wid == 0) { __builtin_amdgcn_fence(__ATOMIC_RELEASE, "agent"); asm volatile("s_waitcnt vmcnt(0) lgkmcnt(0)" ::: "memory"); }
                grid.sync();
                if (wid == 0) { __builtin_amdgcn_fence(__ATOMIC_ACQUIRE, "agent"); asm volatile("s_waitcnt vmcnt(0) lgkmcnt(0)" ::: "memory"); }
                __syncthreads();
            } else {
                XcdBarrier xbar; xbar.bar = (unsigned*)(P.wsp() + WS_BAR); xbar.x = xb_xcc_id(); xbar.st = (volatile LAS unsigned*)(lds + LDS_BARST_OFF);
                xcd_barrier(xbar);
            }
        }
    }
}


#ifdef STOP_PH
__global__ void __launch_bounds__(256) dump_kernel(const unsigned char* ws, float* out) {
    const bf16_t* YH = (const bf16_t*)(ws + WS_YH); const bf16_t* BIGb = (const bf16_t*)(ws + WS_BIG);
    for (size_t i = (size_t)blockIdx.x * 256 + threadIdx.x; i < (size_t)RL * DM; i += (size_t)gridDim.x * 256) {
        const size_t r = i >> 10, c = i & 1023;
        float v = __uint_as_float((unsigned)YH[i] << 16);
        for (int k = 0; k < 4; ++k) v += __uint_as_float((unsigned)BIGb[r * 4096 + c + 1024 * k] << 16);
        if (STOP_PH >= 6) v += out[i];
        out[i] = v;
    }
}
#endif
extern "C" void kernel_launch(void* const* d_in, const int* in_sizes, int n_in, void* d_out, int out_size, void* d_ws, size_t ws_size, hipStream_t stream) {
    static int grid = 0;
    if (grid == 0) {
        if (n_in != 19 || out_size != RL * DM || ws_size < WS_END) { fprintf(stderr, "kernel_launch: unexpected shapes (n_in %d out %d ws %zu, need ws >= %zu)\n", n_in, out_size, ws_size, (size_t)WS_END); grid = -1; return; }
        int dev = 0, cus = 0, per_cu = 0;
        (void)hipGetDevice(&dev);
        (void)hipDeviceGetAttribute(&cus, hipDeviceAttributeMultiprocessorCount, dev);
        if (hipFuncSetAttribute((const void*)mega_fwd, hipFuncAttributeMaxDynamicSharedMemorySize, LDS_BYTES) != hipSuccess) { fprintf(stderr, "kernel_launch: hipFuncSetAttribute failed\n"); grid = -1; return; }
        if (hipOccupancyMaxActiveBlocksPerMultiprocessor(&per_cu, (const void*)mega_fwd, 512, LDS_BYTES) != hipSuccess || per_cu < 1) { fprintf(stderr, "kernel_launch: occupancy query gave %d\n", per_cu); per_cu = 1; }
        (void)hipGetLastError();
        grid = cus * per_cu;
        fprintf(stderr, "kernel_launch: grid %d (cus %d x %d)\n", grid, cus, per_cu);
    }
    if (grid < 0) return;
    Params p{};
    for (int i = 0; i < 19; ++i) p.in[i] = (const float*)d_in[i];
    p.out = (float*)d_out; p.ws = (unsigned char*)d_ws;
#ifndef MK_MULTI
#define MK_MULTI 0
#endif
#if MK_MULTI
    static const int cuts[] = {0,1,2,3,4,5,6,7,8,9,10,12,14,15,16,17,18,19,20,21,22,23,24,25,26,27,28,29,30,31,32,33,34};
    hipError_t e = hipSuccess;
    for (int li = 0; li + 1 < (int)(sizeof(cuts) / sizeof(int)); ++li) {
        p.ph_lo = cuts[li]; p.ph_hi = cuts[li + 1];
#ifdef STOP_PH
        if (p.ph_hi > STOP_PH) break;
#endif
        hipLaunchKernelGGL(mega_fwd, dim3(grid), dim3(512), LDS_BYTES, stream, p);
    }
#ifdef STOP_PH
    hipLaunchKernelGGL(dump_kernel, dim3(2048), dim3(256), 0, stream, (const unsigned char*)d_ws, (float*)d_out);
#endif
    e = hipPeekAtLastError();
#else
    p.ph_lo = 0; p.ph_hi = NPH;
    (void)hipMemsetAsync((unsigned char*)d_ws + WS_CNT, 0, CNT_BYTES, stream);
    (void)hipMemsetAsync((unsigned char*)d_ws + WS_BAR, 0, 16384, stream);
    void* args[] = {&p};
    hipError_t e = hipLaunchCooperativeKernel((const void*)mega_fwd, dim3(grid), dim3(512), args, LDS_BYTES, stream);
#endif
    if (e != hipSuccess) fprintf(stderr, "kernel_launch: cooperative launch failed: %s (grid %d)\n", hipGetErrorString(e), grid);
}
```
